# Optimizing an MI355X kernel written in HIP

```python
import jax, jax.numpy as jnp
from jax import lax
import numpy as np

D_MODEL = 2048
BATCH = 8
SEQ = 2048
DEPTH = 4
DEC_BATCH = 2
DEC_SEQ = 8192
PAST_LEN = 128

PLE_DIM = 256
FNET_GROUPS = 4
FNET_WIDTH = D_MODEL // 4
FNET_GROUP_DIM = FNET_WIDTH // FNET_GROUPS
POOL_WINDOWS = (2, 4, 8, 16)
POOL_GROUPS = len(POOL_WINDOWS)
POOL_WIDTH = D_MODEL // 2
POOL_GROUP_DIM = POOL_WIDTH // POOL_GROUPS
CONV_WIDTH = D_MODEL // 4
CONV_KERNEL = 31
N_BRANCHES = 3
IN_SPLITS = (FNET_WIDTH, FNET_WIDTH,
             POOL_WIDTH, POOL_WIDTH,
             2 * CONV_WIDTH, CONV_WIDTH,
             N_BRANCHES * D_MODEL)
N_IN = sum(IN_SPLITS)
IN_OFFSETS = tuple(int(o) for o in np.cumsum(IN_SPLITS)[:-1])
DEEPNORM_ALPHA = (2.0 * DEPTH) ** 0.25
DEEPNORM_BETA = (8.0 * DEPTH) ** -0.25
LN_EPS = 1e-5

kernel_name = "hybrid_fnet_pool_conformer_encoder"


def layer_norm(x, g, b):
    x32 = x.astype(jnp.float32)
    mu = jnp.mean(x32, axis=-1, keepdims=True)
    var = jnp.mean(jnp.square(x32 - mu), axis=-1, keepdims=True)
    y = (x32 - mu) * lax.rsqrt(var + LN_EPS) * g.astype(jnp.float32) + b.astype(jnp.float32)
    return y.astype(x.dtype)


def fourier_mix(u):
    bsz, s, _ = u.shape
    ug = u.reshape(bsz, s, FNET_GROUPS, FNET_GROUP_DIM).astype(jnp.float32)
    f = jnp.fft.fftn(ug, axes=(1, 3), norm="ortho").real
    return f.reshape(bsz, s, FNET_WIDTH).astype(u.dtype)


def pool_mix(u, w_grp, b_grp, scale):
    bsz, s, _ = u.shape
    ug = u.reshape(bsz, s, POOL_GROUPS, POOL_GROUP_DIM).astype(jnp.float32)
    csum = jnp.pad(lax.cumsum(ug, axis=1), ((0, 0), (1, 0), (0, 0), (0, 0)))
    t = jnp.arange(s)
    outs = []
    for gi, w in enumerate(POOL_WINDOWS):
        lo = jnp.clip(t - w // 2, 0, s)
        hi = jnp.clip(t - w // 2 + w, 0, s)
        c = csum[:, :, gi]
        win_sum = jnp.take(c, hi, axis=1) - jnp.take(c, lo, axis=1)
        cnt = (hi - lo).astype(jnp.float32)[None, :, None]
        outs.append(win_sum / cnt - ug[:, :, gi])
    pooled = jnp.stack(outs, axis=2)
    mixed = jnp.einsum('bsgc,gcd->bsgd', pooled, w_grp.astype(jnp.float32)) + b_grp.astype(jnp.float32)
    return (mixed.reshape(bsz, s, POOL_WIDTH) * scale.astype(jnp.float32)).astype(u.dtype)


def conv_module(glu_in, w_dw, b_dw, g, b):
    a, gate = jnp.split(glu_in, 2, axis=-1)
    v = a * jax.nn.sigmoid(gate)
    v = lax.conv_general_dilated(
        v, w_dw[:, None, :].astype(v.dtype), window_strides=(1,),
        padding=((CONV_KERNEL // 2, CONV_KERNEL // 2),),
        dimension_numbers=('NWC', 'WIO', 'NWC'),
        feature_group_count=CONV_WIDTH) + b_dw
    v = layer_norm(v, g, b)
    return jax.nn.silu(v)


def encoder_layer(x, p_i, w_in, b_in, w_fnet_proj, w_pool_group, b_pool_group, pool_scale,
                  w_pool_proj, w_dw, b_dw, conv_ln_g, conv_ln_b, w_conv_proj, w_out, b_out,
                  ln_g, ln_b, w_ple, w_ple_gate, b_ple_gate):
    h = jnp.einsum('bsd,dn->bsn', x, w_in) + b_in
    fv, fz, pv, pz, cglu, cz, mg = jnp.split(h, IN_OFFSETS, axis=-1)
    ya = jnp.einsum('bsc,cd->bsd', fourier_mix(fv) * jax.nn.silu(fz), w_fnet_proj)
    yb = jnp.einsum('bsc,cd->bsd', pool_mix(pv, w_pool_group, b_pool_group, pool_scale) * jax.nn.silu(pz), w_pool_proj)
    yc = jnp.einsum('bsc,cd->bsd', conv_module(cglu, w_dw, b_dw, conv_ln_g, conv_ln_b) * jax.nn.silu(cz), w_conv_proj)
    ga, gb, gc = jnp.split(jax.nn.sigmoid(mg), N_BRANCHES, axis=-1)
    merged = ga * ya + gb * yb + gc * yc
    out = jnp.einsum('bsd,de->bse', merged, w_out) + b_out
    x = layer_norm(DEEPNORM_ALPHA * x + out, ln_g, ln_b)
    ple = jnp.einsum('bsp,pd->bsd', p_i, w_ple)
    gate = jax.nn.sigmoid(jnp.einsum('bsd,de->bse', x, w_ple_gate) + b_ple_gate)
    return x + gate * ple


def trunk(x, p, emb_ln_g, emb_ln_b, w_in, b_in, w_fnet_proj, w_pool_group, b_pool_group,
          pool_scale, w_pool_proj, w_dw, b_dw, conv_ln_g, conv_ln_b, w_conv_proj, w_out, b_out,
          ln_g, ln_b, w_ple, w_ple_gate, b_ple_gate):
    x = layer_norm(x, emb_ln_g, emb_ln_b)
    for i in range(DEPTH):
        x = encoder_layer(x, p[i], w_in[i], b_in[i], w_fnet_proj[i], w_pool_group[i], b_pool_group[i],
                          pool_scale[i], w_pool_proj[i], w_dw[i], b_dw[i], conv_ln_g[i], conv_ln_b[i],
                          w_conv_proj[i], w_out[i], b_out[i], ln_g[i], ln_b[i], w_ple[i],
                          w_ple_gate[i], b_ple_gate[i])
    return x


def setup_inputs(seed: int = 0) -> dict:
    key = jax.random.key(seed)
    ks = jax.random.split(key, 26)
    f32 = jnp.float32
    nrm = lambda k, shape, s: (jax.random.normal(k, shape, f32) * s).astype(f32)
    return {
        "x_prompt": nrm(ks[0], (BATCH, SEQ, D_MODEL), 1.0),
        "x_sample": nrm(ks[1], (DEC_BATCH, DEC_SEQ, D_MODEL), 1.0),
        "p_prompt": nrm(ks[2], (DEPTH, BATCH, SEQ, PLE_DIM), 1.0),
        "p_sample": nrm(ks[3], (DEPTH, DEC_BATCH, DEC_SEQ, PLE_DIM), 1.0),
        "emb_ln_g": 1.0 + nrm(ks[4], (D_MODEL,), 0.02),
        "emb_ln_b": nrm(ks[5], (D_MODEL,), 0.02),
        "w_in": nrm(ks[6], (DEPTH, D_MODEL, N_IN), D_MODEL ** -0.5),
        "b_in": nrm(ks[7], (DEPTH, N_IN), 0.02),
        "w_fnet_proj": nrm(ks[8], (DEPTH, FNET_WIDTH, D_MODEL), DEEPNORM_BETA * FNET_WIDTH ** -0.5),
        "w_pool_group": nrm(ks[9], (DEPTH, POOL_GROUPS, POOL_GROUP_DIM, POOL_GROUP_DIM), POOL_GROUP_DIM ** -0.5),
        "b_pool_group": nrm(ks[10], (DEPTH, POOL_GROUPS, POOL_GROUP_DIM), 0.02),
        "pool_scale": 1.0 + nrm(ks[11], (DEPTH, POOL_WIDTH), 0.1),
        "w_pool_proj": nrm(ks[12], (DEPTH, POOL_WIDTH, D_MODEL), DEEPNORM_BETA * POOL_WIDTH ** -0.5),
        "w_dw": nrm(ks[13], (DEPTH, CONV_KERNEL, CONV_WIDTH), CONV_KERNEL ** -0.5),
        "b_dw": nrm(ks[14], (DEPTH, CONV_WIDTH), 0.02),
        "conv_ln_g": 1.0 + nrm(ks[15], (DEPTH, CONV_WIDTH), 0.02),
        "conv_ln_b": nrm(ks[16], (DEPTH, CONV_WIDTH), 0.02),
        "w_conv_proj": nrm(ks[17], (DEPTH, CONV_WIDTH, D_MODEL), DEEPNORM_BETA * CONV_WIDTH ** -0.5),
        "w_out": nrm(ks[18], (DEPTH, D_MODEL, D_MODEL), DEEPNORM_BETA * D_MODEL ** -0.5),
        "b_out": nrm(ks[19], (DEPTH, D_MODEL), 0.02),
        "ln_g": 1.0 + nrm(ks[20], (DEPTH, D_MODEL), 0.02),
        "ln_b": nrm(ks[21], (DEPTH, D_MODEL), 0.02),
        "w_ple": nrm(ks[22], (DEPTH, PLE_DIM, D_MODEL), 0.5 * PLE_DIM ** -0.5),
        "w_ple_gate": nrm(ks[23], (DEPTH, D_MODEL, D_MODEL), D_MODEL ** -0.5),
        "b_ple_gate": nrm(ks[24], (DEPTH, D_MODEL), 0.02),
    }


def reference(x_prompt, x_sample, p_prompt, p_sample, emb_ln_g, emb_ln_b, w_in, b_in, w_fnet_proj,
              w_pool_group, b_pool_group, pool_scale, w_pool_proj, w_dw, b_dw, conv_ln_g, conv_ln_b,
              w_conv_proj, w_out, b_out, ln_g, ln_b, w_ple, w_ple_gate, b_ple_gate):
    y_prompt = trunk(x_prompt, p_prompt, emb_ln_g, emb_ln_b, w_in, b_in, w_fnet_proj, w_pool_group,
                     b_pool_group, pool_scale, w_pool_proj, w_dw, b_dw, conv_ln_g, conv_ln_b,
                     w_conv_proj, w_out, b_out, ln_g, ln_b, w_ple, w_ple_gate, b_ple_gate)
    y_sample = trunk(x_sample, p_sample, emb_ln_g, emb_ln_b, w_in, b_in, w_fnet_proj, w_pool_group,
                     b_pool_group, pool_scale, w_pool_proj, w_dw, b_dw, conv_ln_g, conv_ln_b,
                     w_conv_proj, w_out, b_out, ln_g, ln_b, w_ple, w_ple_gate, b_ple_gate)
    return (y_prompt, y_sample)
```

```cpp
#include <hip/hip_runtime.h>
#include <hip/hip_cooperative_groups.h>
#include <cstdio>
namespace cg = cooperative_groups;

#define LAS __attribute__((address_space(3)))
typedef unsigned short bf16_t;
typedef short bf16x8 __attribute__((ext_vector_type(8)));
typedef float f32x4 __attribute__((ext_vector_type(4)));
typedef float f32x2 __attribute__((ext_vector_type(2)));
typedef unsigned u32x4 __attribute__((ext_vector_type(4)));
typedef unsigned u32x2 __attribute__((ext_vector_type(2)));

constexpr int M_TOK = 32768, M_PROMPT = 16384, DM = 2048, NIN = 10752, LDH = 10240, DEPTH = 4, PLE = 256;
constexpr int H_FV = 0, H_FZ = 512, H_PV = 1024, H_PZ = 2048, H_V = 3072, H_CZ = 3584, H_MG = 4096;
constexpr float LN_EPS = 1e-5f;
constexpr float DN_ALPHA = 1.6817928305074290f;
constexpr size_t WT_IN = 0, WT_F = (size_t)NIN * DM, WT_P = WT_F + (size_t)DM * 512, WT_C = WT_P + (size_t)DM * 1024, WT_OUT = WT_C + (size_t)DM * 512,
                 WT_PG = WT_OUT + (size_t)DM * DM, WT_PLE = WT_PG + (size_t)DM * DM, WT_LAYER = WT_PLE + (size_t)DM * PLE;
constexpr size_t OFF_WT = 0;
constexpr size_t OFF_FC = OFF_WT + (size_t)DEPTH * WT_LAYER * 2;
constexpr size_t OFF_BIAS = OFF_FC + (size_t)512 * 1024 * 2;
constexpr size_t OFF_H = OFF_BIAS + (size_t)DEPTH * NIN * 4;
constexpr size_t OFF_MRG = OFF_H + (size_t)M_TOK * LDH * 2;
constexpr size_t OFF_XB = OFF_MRG + (size_t)M_TOK * DM * 2;
constexpr size_t OFF_XC = OFF_XB + (size_t)M_TOK * DM * 2;
constexpr size_t OFF_PB = OFF_XC + (size_t)M_TOK * 1024 * 2;
constexpr size_t WS_END = OFF_PB + (size_t)M_TOK * PLE * 2;
constexpr size_t OFF_BAR = WS_END;
constexpr size_t OFF_CGB = OFF_BAR + 16384;
constexpr size_t OFF_STATS = OFF_CGB + (size_t)DEPTH * 2 * DM * 4;
constexpr size_t WS_END2 = OFF_STATS + (size_t)M_TOK * 2 * 4;
constexpr size_t OFF_PVF = OFF_H;
constexpr size_t OFF_XN = OFF_H;
constexpr size_t OFF_PLEB = OFF_H + (size_t)M_TOK * DM * 2;
static_assert(OFF_FC % 256 == 0 && OFF_BIAS % 256 == 0 && OFF_H % 256 == 0 && OFF_MRG % 256 == 0 && OFF_XB % 256 == 0 && OFF_XC % 256 == 0 && OFF_PB % 256 == 0, "align");

constexpr int LDS_BYTES = 131072 + 4096;
#ifndef PHM
#define PHM 0xFFFF
#endif

typedef __bf16 bf16x2_t __attribute__((ext_vector_type(2)));
__device__ __forceinline__ unsigned cvt_pk_bf16(float lo, float hi) { f32x2 v = {lo, hi}; bf16x2_t b = __builtin_convertvector(v, bf16x2_t); return __builtin_bit_cast(unsigned, b); }
__device__ __forceinline__ float bf_lo(unsigned w) { return __uint_as_float(w << 16); }
__device__ __forceinline__ float bf_hi(unsigned w) { return __uint_as_float(w & 0xffff0000u); }
__device__ __forceinline__ float bf1(bf16_t h) { return __uint_as_float(((unsigned)h) << 16); }
__device__ __forceinline__ float sigmoidf_(float x) { return __builtin_amdgcn_rcpf(1.0f + __expf(-x)); }
__device__ __forceinline__ f32x4 sig4(f32x4 v) { return (f32x4){sigmoidf_(v[0]), sigmoidf_(v[1]), sigmoidf_(v[2]), sigmoidf_(v[3])}; }
__device__ __forceinline__ f32x4 silu4(f32x4 v) { return v * sig4(v); }
__device__ __forceinline__ void unpack8(u32x4 w, f32x4& a, f32x4& b) { a = (f32x4){bf_lo(w.x), bf_hi(w.x), bf_lo(w.y), bf_hi(w.y)}; b = (f32x4){bf_lo(w.z), bf_hi(w.z), bf_lo(w.w), bf_hi(w.w)}; }
__device__ __forceinline__ u32x4 pack8(f32x4 a, f32x4 b) { u32x4 w; w.x = cvt_pk_bf16(a[0], a[1]); w.y = cvt_pk_bf16(a[2], a[3]); w.z = cvt_pk_bf16(b[0], b[1]); w.w = cvt_pk_bf16(b[2], b[3]); return w; }
__device__ __forceinline__ float wave_sum(float v) {
#pragma unroll
    for (int o = 1; o < 64; o <<= 1) v += __shfl_xor(v, o);
    return v;
}
__device__ __forceinline__ int opaque_tid() { int t = threadIdx.x; asm volatile("" : "+v"(t)); return t; }
#define TID_VARS const int tid = opaque_tid(), lane = tid & 63, wave = __builtin_amdgcn_readfirstlane(tid >> 6); const int gw = bid * 8 + wave; const size_t gt = (size_t)bid * 512 + tid; (void)lane; (void)gw; (void)gt;
#define CG_SYNC() do { asm volatile("s_waitcnt vmcnt(0) lgkmcnt(0)" ::: "memory"); grid.sync(); asm volatile("" ::: "memory"); } while (0)
#define GRID_SYNC() do { asm volatile("" ::: "memory"); xcd_barrier(xbar); asm volatile("" ::: "memory"); } while (0)
#define LDS_WAIT() asm volatile("s_waitcnt lgkmcnt(0)" ::: "memory")

namespace pg8 {
constexpr int BM = 256, BK = 64, HALF = 128, HTB = HALF * BK * 2, NXCD = 8, WGM = 4;
__device__ __forceinline__ int lds_byte(int r, int c) { const int st = (r >> 4) * 2 + (c >> 5), rr = r & 15, cc = c & 31, ob = rr * 64 + cc * 2; return st * 1024 + (ob ^ (((ob >> 9) & 1) << 5)); }
__device__ __forceinline__ void stage_rc(int b, int& R, int& C) { const int st = b / 1024, sb = b % 1024, swz = sb ^ (((sb >> 9) & 1) << 5); R = (st >> 1) * 16 + swz / 64; C = (st & 1) * 32 + (swz % 64) / 2; }
__device__ __forceinline__ int perm32(int rho) { const int n = rho >> 4, i = rho & 15; return 8 * (i >> 2) + 4 * n + (i & 3); }
struct Unit { int pm, pn; };
struct Gemm { const bf16_t* A; const bf16_t* Bt; int M, N, K, lda, ldb; };
struct StaticOrder {
    int nM, nN, nwg, G, c;
    __device__ void init(int M, int N, int G_, int c_) { nM = M / BM; nN = N / BM; nwg = nM * nN; G = G_; c = c_; }
    __device__ bool next(int i, Unit& u) const {
        const long L = (long)i * G + c; if (L >= nwg) return false;
        int wgid = (int)L; { const int q = nwg / NXCD, r = nwg % NXCD, xcd = wgid % NXCD, off = wgid / NXCD; wgid = (xcd < r ? xcd * (q + 1) : r * (q + 1) + (xcd - r) * q) + off; }
        const int nig = WGM * nN, gid = wgid / nig, fm = gid * WGM, gsz = (nM - fm) < WGM ? (nM - fm) : WGM;
        u.pm = fm + ((wgid % nig) % gsz); u.pn = (wgid % nig) / gsz; return true;
    }
};
template <class Epi>
__device__ __forceinline__ void gemm_phase(LAS unsigned char* lds, const Gemm g, const StaticOrder& S, const Epi& E, const int tid) {
    const int wid = __builtin_amdgcn_readfirstlane(tid >> 6), lane = tid & 63, wr = wid >> 2, wc = wid & 3, fr = lane & 15, fq = lane >> 4;
    const int K = g.K, nt = K / BK;
    unsigned voffA[2], voffB[2];
#pragma unroll
    for (int i = 0; i < 2; ++i) { int R, C; stage_rc(tid * 16 + i * 8192, R, C); const int Rb = (R & ~31) + perm32(R & 31);
        voffA[i] = (unsigned)(R * g.lda + C) * 2u; voffB[i] = (unsigned)(Rb * g.ldb + C) * 2u; }
    const size_t kstep = (size_t)(BK * 2);
    const size_t hstepA = (size_t)HALF * g.lda * 2, hstepB = (size_t)HALF * g.ldb * 2;
    const size_t tstepA = 2 * hstepA, tstepB = 2 * hstepB;
    const unsigned ldsw = (unsigned)wid * 1024u;
    const int aoff = lds_byte(wr * 64 + fr, fq * 8), boff = lds_byte(wc * 32 + fr, fq * 8);
#define PG8_SA(b, h) (((b) * 2 + (h)) * HTB)
#define PG8_SB(b, h) ((4 + (b) * 2 + (h)) * HTB)
#define PG8_STAGE(bufoff, gbase, voff) do { _Pragma("unroll") for (int _i = 0; _i < 2; ++_i) \
        __builtin_amdgcn_global_load_lds((const unsigned*)((const char*)(gbase) + (voff)[_i]), (LAS unsigned*)(lds + (bufoff) + ldsw + _i * 8192), 16, 0, 0); } while (0)
#define PG8_LDA(dst, b, h) do { _Pragma("unroll") for (int m = 0; m < 4; ++m) _Pragma("unroll") for (int k = 0; k < 2; ++k) dst[m][k] = *(const LAS bf16x8*)(lds + PG8_SA(b, h) + aoff + m * 2048 + k * 1024); } while (0)
#define PG8_LDB(dst, b, h) do { _Pragma("unroll") for (int n = 0; n < 2; ++n) _Pragma("unroll") for (int k = 0; k < 2; ++k) dst[n][k] = *(const LAS bf16x8*)(lds + PG8_SB(b, h) + boff + n * 2048 + k * 1024); } while (0)
#define PG8_MMA(ai, bj, At, Bt) do { __builtin_amdgcn_s_setprio(1); _Pragma("unroll") for (int m = 0; m < 4; ++m) _Pragma("unroll") for (int n = 0; n < 2; ++n) _Pragma("unroll") for (int k = 0; k < 2; ++k) \
        acc[ai][bj][m][n] = __builtin_amdgcn_mfma_f32_16x16x32_bf16(Bt[n][k], At[m][k], acc[ai][bj][m][n], 0, 0, 0); __builtin_amdgcn_s_setprio(0); } while (0)
#define PG8_WAIT_V(n) asm volatile("s_waitcnt vmcnt(" #n ")" ::: "memory")
#define PG8_WAIT_L(n) asm volatile("s_waitcnt lgkmcnt(" #n ")" ::: "memory")
#define PG8_BAR __builtin_amdgcn_s_barrier()
#define PG8_SCHED __builtin_amdgcn_sched_barrier(0)
    Unit cur, nxt; int ui = 0;
    if (!S.next(0, cur)) return;
    f32x4 acc[2][2][4][2];
#pragma unroll
    for (int a = 0; a < 2; ++a)
#pragma unroll
        for (int b = 0; b < 2; ++b)
#pragma unroll
            for (int m = 0; m < 4; ++m)
#pragma unroll
                for (int n = 0; n < 2; ++n) acc[a][b][m][n] = (f32x4){0.f, 0.f, 0.f, 0.f};
    bf16x8 At[4][2], B0[2][2], B1[2][2];
    const char* cA = (const char*)g.A + (size_t)cur.pm * tstepA; const char* cB = (const char*)g.Bt + (size_t)cur.pn * tstepB;
    PG8_STAGE(PG8_SB(0, 0), cB, voffB); PG8_STAGE(PG8_SA(0, 0), cA, voffA); PG8_STAGE(PG8_SB(0, 1), cB + hstepB, voffB); PG8_STAGE(PG8_SA(0, 1), cA + hstepA, voffA);
    if (wr == 1) PG8_BAR;
    PG8_WAIT_V(4); PG8_BAR;
    PG8_STAGE(PG8_SB(1, 0), cB + kstep, voffB); PG8_STAGE(PG8_SA(1, 0), cA + kstep, voffA); PG8_STAGE(PG8_SB(1, 1), cB + hstepB + kstep, voffB);
    PG8_WAIT_V(6); PG8_BAR;
    for (;;) {
        const bool has_next = S.next(ui + 1, nxt);
        const char* nA = has_next ? (const char*)g.A + (size_t)nxt.pm * tstepA : cA; const char* nB = has_next ? (const char*)g.Bt + (size_t)nxt.pn * tstepB : cB;
        for (int t = 0; t < nt; t += 2) {
            const bool last = (t == nt - 2);
            const char* a1 = cA + (size_t)(t + 1) * kstep;
            const char* a2 = last ? nA : cA + (size_t)(t + 2) * kstep; const char* b2 = last ? nB : cB + (size_t)(t + 2) * kstep;
            const char* a3 = a2 + kstep; const char* b3 = b2 + kstep;
            PG8_LDB(B0, 0, 0); PG8_SCHED; PG8_LDA(At, 0, 0); PG8_STAGE(PG8_SA(1, 1), a1 + hstepA, voffA);
            PG8_WAIT_L(8); PG8_BAR; PG8_WAIT_L(0); PG8_MMA(0, 0, At, B0); PG8_BAR; PG8_SCHED;
            PG8_LDB(B1, 0, 1); PG8_STAGE(PG8_SB(0, 0), b2, voffB);
            PG8_BAR; PG8_WAIT_L(0); PG8_MMA(0, 1, At, B1); PG8_BAR;
            PG8_LDA(At, 0, 1); PG8_STAGE(PG8_SA(0, 0), a2, voffA);
            PG8_BAR; PG8_WAIT_L(0); PG8_MMA(1, 0, At, B0); PG8_BAR; PG8_SCHED;
            PG8_STAGE(PG8_SB(0, 1), b2 + hstepB, voffB);
            PG8_WAIT_V(6); PG8_BAR; PG8_MMA(1, 1, At, B1); PG8_BAR;
            PG8_LDB(B0, 1, 0); PG8_SCHED; PG8_LDA(At, 1, 0); PG8_STAGE(PG8_SA(0, 1), a2 + hstepA, voffA);
            PG8_WAIT_L(8); PG8_BAR; PG8_WAIT_L(0); PG8_MMA(0, 0, At, B0); PG8_BAR; PG8_SCHED;
            PG8_LDB(B1, 1, 1); PG8_STAGE(PG8_SB(1, 0), b3, voffB);
            PG8_BAR; PG8_WAIT_L(0); PG8_MMA(0, 1, At, B1); PG8_BAR;
            PG8_LDA(At, 1, 1); PG8_STAGE(PG8_SA(1, 0), a3, voffA);
            PG8_BAR; PG8_WAIT_L(0); PG8_MMA(1, 0, At, B0); PG8_BAR; PG8_SCHED;
            PG8_STAGE(PG8_SB(1, 1), b3 + hstepB, voffB);
            PG8_WAIT_V(6); PG8_BAR; PG8_MMA(1, 1, At, B1); PG8_BAR;
        }
        E(acc, cur, wr, wc, fr, fq);
        if (!has_next) break;
#pragma unroll
        for (int a = 0; a < 2; ++a)
#pragma unroll
            for (int b = 0; b < 2; ++b)
#pragma unroll
                for (int m = 0; m < 4; ++m)
#pragma unroll
                    for (int n = 0; n < 2; ++n) acc[a][b][m][n] = (f32x4){0.f, 0.f, 0.f, 0.f};
        cur = nxt; cA = nA; cB = nB; ++ui;
    }
    PG8_WAIT_V(0);
    if (wr == 0) PG8_BAR;
    PG8_BAR;
#undef PG8_SA
#undef PG8_SB
#undef PG8_STAGE
#undef PG8_LDA
#undef PG8_LDB
#undef PG8_MMA
#undef PG8_WAIT_V
#undef PG8_WAIT_L
#undef PG8_BAR
#undef PG8_SCHED
}
}
using pg8::Unit;

typedef const f32x4 (&AccRef)[2][2][4][2];

struct EpiIn {
    bf16_t* H; const float* bias;
    template <int MODE> __device__ __forceinline__ void body(AccRef acc, const f32x4 (&bv)[2][2], int row0, int hc) const {
#pragma unroll
        for (int ai = 0; ai < 2; ++ai)
#pragma unroll
            for (int m = 0; m < 4; ++m) { bf16_t* rowp = H + (size_t)(row0 + ai * 128 + m * 16) * LDH + hc;
#pragma unroll
                for (int bj = 0; bj < 2; ++bj) { f32x4 v0 = acc[ai][bj][m][0] + bv[bj][0], v1 = acc[ai][bj][m][1] + bv[bj][1];
                    if (MODE == 1) { v0 = silu4(v0); v1 = silu4(v1); }
                    if (MODE == 2) { v0 = sig4(v0); v1 = sig4(v1); }
                    *(u32x4*)(rowp + bj * 128) = pack8(v0, v1); } }
    }
    __device__ __forceinline__ void operator()(AccRef acc, const Unit& u, int wr, int wc, int fr, int fq) const {
        const int pn = u.pn; int mode, hc;
        if (pn < 2) { mode = 0; hc = pn * 256; } else if (pn < 4) { mode = 1; hc = pn * 256; } else if (pn < 8) { mode = 0; hc = pn * 256; } else if (pn < 12) { mode = 1; hc = pn * 256; }
        else if (pn < 16) { mode = 3; hc = H_V + (pn - 12) * 128; } else if (pn < 18) { mode = 1; hc = H_CZ + (pn - 16) * 256; } else { mode = 2; hc = H_MG + (pn - 18) * 256; }
        const int row0 = u.pm * 256 + wr * 64 + fr, lc = wc * 32 + 8 * fq;
        f32x4 bv[2][2];
#pragma unroll
        for (int bj = 0; bj < 2; ++bj)
#pragma unroll
            for (int n = 0; n < 2; ++n) bv[bj][n] = *(const f32x4*)(bias + pn * 256 + bj * 128 + lc + 4 * n);
        hc += lc;
        if (mode == 3) {
#pragma unroll
            for (int ai = 0; ai < 2; ++ai)
#pragma unroll
                for (int m = 0; m < 4; ++m) { bf16_t* rowp = H + (size_t)(row0 + ai * 128 + m * 16) * LDH + hc;
                    const f32x4 a0 = acc[ai][0][m][0] + bv[0][0], a1 = acc[ai][0][m][1] + bv[0][1], g0 = acc[ai][1][m][0] + bv[1][0], g1 = acc[ai][1][m][1] + bv[1][1];
                    *(u32x4*)rowp = pack8(a0 * sig4(g0), a1 * sig4(g1)); }
        } else if (mode == 0) body<0>(acc, bv, row0, hc);
        else if (mode == 1) body<1>(acc, bv, row0, hc);
        else body<2>(acc, bv, row0, hc);
    }
};
struct EpiFnet {
    bf16_t* H;
    __device__ __forceinline__ void operator()(AccRef acc, const Unit& u, int wr, int wc, int fr, int fq) const {
        const float sc = (u.pm < 64) ? 0.001953125f   : 0.0009765625f  ;
        const int row0 = u.pm * 256 + wr * 64 + fr, c0 = H_FZ + u.pn * 256 + wc * 32 + 8 * fq;
#pragma unroll
        for (int ai = 0; ai < 2; ++ai)
#pragma unroll
            for (int m = 0; m < 4; ++m) { bf16_t* rowp = H + (size_t)(row0 + ai * 128 + m * 16) * LDH + c0;
#pragma unroll
                for (int bj = 0; bj < 2; ++bj) { f32x4 z0, z1; unpack8(*(const u32x4*)(rowp + bj * 128), z0, z1);
                    *(u32x4*)(rowp + bj * 128) = pack8(acc[ai][bj][m][0] * sc * z0, acc[ai][bj][m][1] * sc * z1); }
                if (m & 1) asm volatile("" ::: "memory"); }
    }
};
struct EpiMerge {
    bf16_t* MRG; const bf16_t* gate; int first;
    __device__ __forceinline__ void operator()(AccRef acc, const Unit& u, int wr, int wc, int fr, int fq) const {
        const int row0 = u.pm * 256 + wr * 64 + fr, c0 = u.pn * 256 + wc * 32 + 8 * fq;
#pragma unroll
        for (int ai = 0; ai < 2; ++ai)
#pragma unroll
            for (int m = 0; m < 4; ++m) { const size_t row = (size_t)(row0 + ai * 128 + m * 16); bf16_t* mp = MRG + row * DM + c0; const bf16_t* gp = gate + row * LDH + c0;
#pragma unroll
                for (int bj = 0; bj < 2; ++bj) { f32x4 g0, g1; unpack8(*(const u32x4*)(gp + bj * 128), g0, g1);
                    f32x4 o0 = g0 * acc[ai][bj][m][0], o1 = g1 * acc[ai][bj][m][1];
                    if (!first) { f32x4 p0, p1; unpack8(*(const u32x4*)(mp + bj * 128), p0, p1); o0 += p0; o1 += p1; }
                    *(u32x4*)(mp + bj * 128) = pack8(o0, o1); }
                if (m & 1) asm volatile("" ::: "memory"); }
    }
};
struct EpiOut {
    float* X; const float* bias; const float* lng; bf16_t* YG; float* stats;
    __device__ __forceinline__ void operator()(AccRef acc, const Unit& u, int wr, int wc, int fr, int fq) const {
        const int row0 = u.pm * 256 + wr * 64 + fr, c0 = u.pn * 256 + wc * 32 + 8 * fq;
        f32x4 bv[2][2], gv[2][2];
#pragma unroll
        for (int bj = 0; bj < 2; ++bj)
#pragma unroll
            for (int n = 0; n < 2; ++n) { bv[bj][n] = *(const f32x4*)(bias + c0 + bj * 128 + 4 * n); gv[bj][n] = *(const f32x4*)(lng + c0 + bj * 128 + 4 * n); }
#pragma unroll
        for (int ai = 0; ai < 2; ++ai)
#pragma unroll
            for (int m = 0; m < 4; ++m) { const int row = row0 + ai * 128 + m * 16; float* xp = X + (size_t)row * DM + c0; bf16_t* yp = YG + (size_t)row * DM + c0;
                float sm = 0.f, sq = 0.f;
#pragma unroll
                for (int bj = 0; bj < 2; ++bj) {
                    const f32x4 y0 = *(const f32x4*)(xp + bj * 128) * DN_ALPHA + acc[ai][bj][m][0] + bv[bj][0], y1 = *(const f32x4*)(xp + bj * 128 + 4) * DN_ALPHA + acc[ai][bj][m][1] + bv[bj][1];
                    *(f32x4*)(xp + bj * 128) = y0; *(f32x4*)(xp + bj * 128 + 4) = y1;
                    *(u32x4*)(yp + bj * 128) = pack8(y0 * gv[bj][0], y1 * gv[bj][1]);
                    sm += (y0[0] + y0[1]) + (y0[2] + y0[3]) + (y1[0] + y1[1]) + (y1[2] + y1[3]);
                    sq += (y0[0] * y0[0] + y0[1] * y0[1]) + (y0[2] * y0[2] + y0[3] * y0[3]) + (y1[0] * y1[0] + y1[1] * y1[1]) + (y1[2] * y1[2] + y1[3] * y1[3]);
                }
                sm += __shfl_xor(sm, 16); sq += __shfl_xor(sq, 16); sm += __shfl_xor(sm, 32); sq += __shfl_xor(sq, 32);
                if (fq == 0) { (void)__hip_atomic_fetch_add(stats + 2 * row, sm, __ATOMIC_RELAXED, __HIP_MEMORY_SCOPE_AGENT); (void)__hip_atomic_fetch_add(stats + 2 * row + 1, sq, __ATOMIC_RELAXED, __HIP_MEMORY_SCOPE_AGENT); }
                if (m & 1) asm volatile("" ::: "memory"); }
    }
};
struct EpiPlain {
    bf16_t* O;
    __device__ __forceinline__ void operator()(AccRef acc, const Unit& u, int wr, int wc, int fr, int fq) const {
        const int row0 = u.pm * 256 + wr * 64 + fr, c0 = u.pn * 256 + wc * 32 + 8 * fq;
#pragma unroll
        for (int ai = 0; ai < 2; ++ai)
#pragma unroll
            for (int m = 0; m < 4; ++m) { bf16_t* op = O + (size_t)(row0 + ai * 128 + m * 16) * DM + c0;
#pragma unroll
                for (int bj = 0; bj < 2; ++bj) *(u32x4*)(op + bj * 128) = pack8(acc[ai][bj][m][0], acc[ai][bj][m][1]); }
    }
};
struct EpiGate {
    float* X; const float* cg; const float* cb; const float* lng; const float* lnb; const bf16_t* PLEB; bf16_t* XB; const float* stats;
    __device__ __forceinline__ void operator()(AccRef acc, const Unit& u, int wr, int wc, int fr, int fq) const {
        const int row0 = u.pm * 256 + wr * 64 + fr, c0 = u.pn * 256 + wc * 32 + 8 * fq;
#pragma unroll
        for (int ai = 0; ai < 2; ++ai)
#pragma unroll
            for (int m = 0; m < 4; ++m) { const int row = row0 + ai * 128 + m * 16; const size_t ro = (size_t)row * DM + c0;
                const f32x2 st = *(const f32x2*)(stats + 2 * row);
                const float mu = st.x * (1.f / DM), var = st.y * (1.f / DM) - mu * mu, r = 1.f / sqrtf(var + LN_EPS);
#pragma unroll
                for (int bj = 0; bj < 2; ++bj) { f32x4 p0, p1; unpack8(*(const u32x4*)(PLEB + ro + bj * 128), p0, p1);
                    const f32x4 y0 = *(const f32x4*)(X + ro + bj * 128), y1 = *(const f32x4*)(X + ro + bj * 128 + 4);
                    const f32x4 g0 = *(const f32x4*)(lng + c0 + bj * 128), g1 = *(const f32x4*)(lng + c0 + bj * 128 + 4), b0 = *(const f32x4*)(lnb + c0 + bj * 128), b1 = *(const f32x4*)(lnb + c0 + bj * 128 + 4);
                    const f32x4 x0 = (y0 - mu) * r * g0 + b0, x1 = (y1 - mu) * r * g1 + b1;
                    const f32x4 cg0 = *(const f32x4*)(cg + c0 + bj * 128), cg1 = *(const f32x4*)(cg + c0 + bj * 128 + 4), cb0 = *(const f32x4*)(cb + c0 + bj * 128), cb1 = *(const f32x4*)(cb + c0 + bj * 128 + 4);
                    const f32x4 o0 = x0 + sig4((acc[ai][bj][m][0] - mu * cg0) * r + cb0) * p0, o1 = x1 + sig4((acc[ai][bj][m][1] - mu * cg1) * r + cb1) * p1;
                    *(f32x4*)(X + ro + bj * 128) = o0; *(f32x4*)(X + ro + bj * 128 + 4) = o1; *(u32x4*)(XB + ro + bj * 128) = pack8(o0, o1); }
                if (m & 1) asm volatile("" ::: "memory"); }
    }
};

struct Params { const float* in[25]; float* out; unsigned char* ws; int ph_lo, ph_hi; };
enum { I_XP = 0, I_XS, I_PP, I_PS, I_EG, I_EB, I_WIN, I_BIN, I_WF, I_WG, I_BG, I_PSC, I_WP, I_WDW, I_BDW, I_CG, I_CB, I_WC, I_WOUT, I_BOUT, I_LNG, I_LNB, I_WPLE, I_WPG, I_BPG };

__device__ __forceinline__ void seq_of_row(int row, int& base, int& S) {
    if (row < M_PROMPT) { S = 2048; base = row & ~2047; } else { S = 8192; base = M_PROMPT + ((row - M_PROMPT) & ~8191); }
}

__device__ __forceinline__ void ln_row(const float* src, float* dstf, bf16_t* dstb, const float* g, const float* b, int lane) {
    f32x4 v[8]; float s = 0.f;
#pragma unroll
    for (int j = 0; j < 8; ++j) { v[j] = ((const f32x4*)src)[lane + 64 * j]; s += (v[j][0] + v[j][1]) + (v[j][2] + v[j][3]); }
    const float mean = wave_sum(s) * (1.f / DM); float s2 = 0.f;
#pragma unroll
    for (int j = 0; j < 8; ++j) { v[j] = v[j] - mean; s2 += (v[j][0] * v[j][0] + v[j][1] * v[j][1]) + (v[j][2] * v[j][2] + v[j][3] * v[j][3]); }
    const float rstd = 1.f / sqrtf(wave_sum(s2) * (1.f / DM) + LN_EPS);
#pragma unroll
    for (int j = 0; j < 8; ++j) { const f32x4 gg = ((const f32x4*)g)[lane + 64 * j], bb = ((const f32x4*)b)[lane + 64 * j]; const f32x4 o = v[j] * rstd * gg + bb;
        ((f32x4*)dstf)[lane + 64 * j] = o; u32x2 w; w.x = cvt_pk_bf16(o[0], o[1]); w.y = cvt_pk_bf16(o[2], o[3]); ((u32x2*)dstb)[lane + 64 * j] = w; }
}

__device__ __forceinline__ void transpose_item(const float* W, int ldw, int col0, bf16_t* WT, int ldt, int row0, int k0, LAS float* scr, int lane) {
    { float wv[32];
#pragma unroll
    for (int i = 0; i < 32; ++i) { const int kk = 2 * i + (lane >> 5); wv[i] = W[(size_t)(k0 + kk) * ldw + col0 + (lane & 31)]; }
#pragma unroll
    for (int i = 0; i < 32; ++i) { const int kk = 2 * i + (lane >> 5); scr[kk * 33 + (lane & 31)] = wv[i]; } }
    LDS_WAIT();
    const int c = lane & 7;
#pragma unroll
    for (int j = 0; j < 4; ++j) { const int n = (lane >> 3) + 8 * j; const LAS float* s = scr + (8 * c) * 33 + n;
        u32x4 o; o.x = cvt_pk_bf16(s[0 * 33], s[1 * 33]); o.y = cvt_pk_bf16(s[2 * 33], s[3 * 33]); o.z = cvt_pk_bf16(s[4 * 33], s[5 * 33]); o.w = cvt_pk_bf16(s[6 * 33], s[7 * 33]);
        *(u32x4*)(WT + (size_t)(row0 + n) * ldt + k0 + 8 * c) = o; }
    LDS_WAIT();
}

__device__ __forceinline__ void fft_lds(LAS f32x2* X, const LAS f32x2* tw, int logR, int logCW, int tid) {
    const int CWm = (1 << logCW) - 1;
    for (int p = 0; p < logR; ++p) {
        const int lh = logR - 1 - p, half = 1 << lh;
#pragma unroll 4
        for (int it = 0; it < 16; ++it) {
            const int f = it * 512 + tid, c = f & CWm, j = f >> logCW, grp = j >> lh, pos = j & (half - 1);
            const int i0 = ((grp << (lh + 1)) + pos), i1 = i0 + half;
            const f32x2 a = X[(i0 << logCW) + c], b = X[(i1 << logCW) + c], w = tw[pos << p];
            const f32x2 d = a - b;
            X[(i0 << logCW) + c] = a + b;
            X[(i1 << logCW) + c] = (f32x2){d.x * w.x - d.y * w.y, d.x * w.y + d.y * w.x};
        }
        __syncthreads();
    }
}


#define XB_TMO      128
#define XB_XCNT(j)  (256  + 64 * (j))
#define XB_XSUB(j)  (1280 + 64 * (j))
#define XB_XGEN(j)  (2304 + 64 * (j))
#define XB_TOP      3328
#define XB_TOPGEN   3392
#define XCD_BAR_WORDS 3456
#define XB_SPIN_CAP (1u << 22)
__device__ __forceinline__ unsigned xb_ld(unsigned* p)              { return __hip_atomic_load(p, __ATOMIC_RELAXED, __HIP_MEMORY_SCOPE_AGENT); }
__device__ __forceinline__ unsigned xb_add(unsigned* p, unsigned v) { return __hip_atomic_fetch_add(p, v, __ATOMIC_RELAXED, __HIP_MEMORY_SCOPE_AGENT); }
__device__ __forceinline__ unsigned xb_xcc_id() { return (unsigned)__builtin_amdgcn_s_getreg((3 << 11) | 20) & 0xFu; }
#define XB_SPIN(cond, bar) do { unsigned _sp = 0; while (cond) { __builtin_amdgcn_s_sleep(1); \
    if ((++_sp & 255u) == 0u) { if (xb_ld(&(bar)[XB_TMO])) break; if (_sp > XB_SPIN_CAP) { atomicAdd(&(bar)[XB_TMO], 1u); break; } } } } while (0)
struct XcdBarrier { unsigned* bar; unsigned x; volatile LAS unsigned* st; };
__device__ __forceinline__ XcdBarrier xcd_barrier_post(unsigned* bar, volatile LAS unsigned* st) {
    XcdBarrier b; b.bar = bar; b.x = xb_xcc_id(); b.st = st;
    if (threadIdx.x == 0) (void)xb_add(&bar[XB_XCNT(b.x)], 1u);
    return b;
}
__device__ __forceinline__ void xcd_barrier_complete(unsigned* bar, unsigned x, unsigned& nloc, unsigned& nx) {
    const unsigned G = gridDim.x * gridDim.y * gridDim.z;
    unsigned sum, cnt, mine, sp = 0u;
    for (;;) {
        sum = 0u; cnt = 0u; mine = 0u;
#pragma unroll
        for (unsigned j = 0; j < 16; ++j) { const unsigned c = xb_ld(&bar[XB_XCNT(j)]); sum += c; cnt += (c > 0u) ? 1u : 0u; mine = (j == x) ? c : mine; }
        if (sum == G) break;
        __builtin_amdgcn_s_sleep(1);
        if ((++sp & 255u) == 0u) { if (xb_ld(&bar[XB_TMO])) break; if (sp > XB_SPIN_CAP) { atomicAdd(&bar[XB_TMO], 1u); break; } }
    }
    nloc = mine > 0u ? mine : 1u; nx = cnt > 0u ? cnt : 1u;
}
__device__ __forceinline__ void xcd_barrier(const XcdBarrier& b) {
    asm volatile("s_waitcnt vmcnt(0)" ::: "memory");
    __syncthreads();
    if (threadIdx.x == 0) {
        unsigned* bar = b.bar;
        __builtin_amdgcn_s_waitcnt(0);
        unsigned nloc = b.st[0], nx = b.st[1];
        if (nloc == 0u) { xcd_barrier_complete(bar, b.x, nloc, nx); b.st[0] = nloc; b.st[1] = nx; }
        const unsigned old = xb_add(&bar[XB_XSUB(b.x)], 1u);
        const unsigned gen = old / nloc;
        if (old + 1u == (gen + 1u) * nloc) {
            __builtin_amdgcn_fence(__ATOMIC_RELEASE, "agent");
            asm volatile("s_waitcnt vmcnt(0)" ::: "memory");
            const unsigned og = xb_add(&bar[XB_TOP], 1u);
            const unsigned tg = og / nx;
            if (og + 1u == (tg + 1u) * nx) xb_add(&bar[XB_TOPGEN], 1u);
            else XB_SPIN(xb_ld(&bar[XB_TOPGEN]) == tg, bar);
            __builtin_amdgcn_fence(__ATOMIC_ACQUIRE, "agent");
            xb_add(&bar[XB_XGEN(b.x)], 1u);
            asm volatile("s_waitcnt vmcnt(0)" ::: "memory");
        } else {
            XB_SPIN(xb_ld(&bar[XB_XGEN(b.x)]) == gen, bar);
            __builtin_amdgcn_fence(__ATOMIC_ACQUIRE, "agent");
            asm volatile("s_waitcnt vmcnt(0)" ::: "memory");
        }
    }
    __syncthreads();
}

typedef const __attribute__((address_space(4))) Params* KP;
__device__ __forceinline__ KP kparams() { unsigned long long k = (unsigned long long)__builtin_amdgcn_kernarg_segment_ptr(); asm volatile("" : "+s"(k)); return (KP)k; }
#define KARGS0 KP p = kparams(); unsigned char* ws = p->ws; \
    bf16_t* WT = (bf16_t*)(ws + OFF_WT); bf16_t* FC = (bf16_t*)(ws + OFF_FC); float* BIASP = (float*)(ws + OFF_BIAS); \
    bf16_t* H = (bf16_t*)(ws + OFF_H); bf16_t* MRG = (bf16_t*)(ws + OFF_MRG); bf16_t* XB = (bf16_t*)(ws + OFF_XB); f32x2* ZB = (f32x2*)(ws + OFF_XB); \
    bf16_t* XC = (bf16_t*)(ws + OFF_XC); bf16_t* PB = (bf16_t*)(ws + OFF_PB); float* PVF = (float*)(ws + OFF_PVF); \
    bf16_t* XN = (bf16_t*)(ws + OFF_XN); bf16_t* PLEB = (bf16_t*)(ws + OFF_PLEB); float* X = p->out; \
    float* CGB = (float*)(ws + OFF_CGB); float* STATS = (float*)(ws + OFF_STATS); \
    (void)WT; (void)FC; (void)BIASP; (void)H; (void)MRG; (void)XB; (void)ZB; (void)XC; (void)PB; (void)PVF; (void)XN; (void)PLEB; (void)X; (void)CGB; (void)STATS;
#define KARGS KARGS0 const bf16_t* wt = WT + (size_t)l * WT_LAYER; (void)wt;
__global__ void __launch_bounds__(512, 2) fwd_megakernel(Params p_) {
    extern __shared__ __attribute__((aligned(16))) unsigned char smem[];
    cg::grid_group grid = cg::this_grid();
    LAS unsigned char* lds = (LAS unsigned char*)smem;
    const int G = gridDim.x, bid = blockIdx.x;
    const int NGW = G * 8;
    const size_t NGT = (size_t)G * 512;
    volatile LAS unsigned* xst = (volatile LAS unsigned*)(lds + 131072 + 4000);
    if (threadIdx.x < 2) xst[threadIdx.x] = 0u;
    __syncthreads();
    const XcdBarrier xbar = xcd_barrier_post((unsigned*)(kparams()->ws + OFF_BAR), xst);

    if (PHM & 1)
    {
        TID_VARS
            KARGS0
        const float* w_in = p->in[I_WIN]; const float* wg = p->in[I_WG];
        for (int task = gw; task < DEPTH * 512 * 4; task += NGW) {
            const int g = task & 3, kb = (task >> 2) & 511, l = task >> 11;
            const float* a = w_in + ((size_t)l * DM + kb * 4) * NIN + 1024 + g * 256;
            const float* b = wg + ((size_t)(l * 4 + g) * 256) * 256 + 4 * lane;
            f32x4 acc0 = {0, 0, 0, 0}, acc1 = acc0, acc2 = acc0, acc3 = acc0;
#pragma unroll 8
            for (int c = 0; c < 256; ++c) { const f32x4 bv = *(const f32x4*)(b + (size_t)c * 256);
                acc0 += a[c] * bv; acc1 += a[NIN + c] * bv; acc2 += a[2 * NIN + c] * bv; acc3 += a[3 * NIN + c] * bv; }
            float* o = PVF + ((size_t)l * DM + kb * 4) * 1024 + g * 256 + 4 * lane;
            *(f32x4*)o = acc0; *(f32x4*)(o + 1024) = acc1; *(f32x4*)(o + 2048) = acc2; *(f32x4*)(o + 3072) = acc3;
        }
        const float* b_in = p->in[I_BIN];
        for (size_t e = gt; e < (size_t)DEPTH * NIN; e += NGT) {
            const int l = (int)(e / NIN), n = (int)(e % NIN); float v;
            if (n >= 1024 && n < 2048) v = 0.f;
            else if (n >= 3072 && n < 4096) { const int j = (n - 3072) >> 8, lc = (n - 3072) & 255; v = b_in[(size_t)l * NIN + (lc < 128 ? 3072 + j * 128 + lc : 3584 + j * 128 + (lc - 128))]; }
            else v = b_in[(size_t)l * NIN + n];
            BIASP[e] = v;
        }
        for (size_t e = gt; e < (size_t)512 * 1024; e += NGT) {
            const int r = (int)(e >> 10), q = (int)(e & 1023), g = r >> 7, d = r & 127, half = q >> 9, g2 = (q >> 7) & 3, c = q & 127;
            float v = 0.f;
            if (g == g2) { const float ang = (float)((c * d) & 127) * (1.0f / 64.0f); v = half ? sinpif(ang) : cospif(ang); }
            FC[e] = (bf16_t)(cvt_pk_bf16(v, 0.f) & 0xffffu);
        }
        for (size_t e = gt; e < (size_t)DEPTH * DM * 16; e += NGT) {
            const int kc = (int)(e / ((size_t)DEPTH * DM)), le = (int)(e % ((size_t)DEPTH * DM)), l = le / DM, col = le % DM;
            const float* w = p->in[I_WPG] + ((size_t)l * DM + kc * 128) * DM + col; const float* g = p->in[I_LNG] + l * DM + kc * 128; const float* b = p->in[I_LNB] + l * DM + kc * 128;
            float sg = 0.f, sb = (kc == 0) ? p->in[I_BPG][l * DM + col] : 0.f;
#pragma unroll 8
            for (int k = 0; k < 128; ++k) { const float wv = w[(size_t)k * DM]; sg += g[k] * wv; sb += b[k] * wv; }
            (void)__hip_atomic_fetch_add(CGB + ((size_t)l * 2 + 0) * DM + col, sg, __ATOMIC_RELAXED, __HIP_MEMORY_SCOPE_AGENT);
            (void)__hip_atomic_fetch_add(CGB + ((size_t)l * 2 + 1) * DM + col, sb, __ATOMIC_RELAXED, __HIP_MEMORY_SCOPE_AGENT);
        }
        for (int row = gw; row < M_TOK; row += NGW) {
            const float* src = row < M_PROMPT ? p->in[I_XP] + (size_t)row * DM : p->in[I_XS] + (size_t)(row - M_PROMPT) * DM;
            ln_row(src, X + (size_t)row * DM, XB + (size_t)row * DM, p->in[I_EG], p->in[I_EB], lane);
        }
    }
    CG_SYNC();
    if (PHM & 2)
    {
        TID_VARS
            KARGS0
        LAS float* scr = (LAS float*)(lds + wave * 16384);
        constexpr int IT_IN = 32 * 336, IT_F = 8 * 64, IT_P = 16 * 64, IT_C = 8 * 64, IT_OUT = 32 * 64, IT_PG = 32 * 64, IT_PLE = 4 * 64;
        constexpr int IT_LAYER = IT_IN + IT_F + IT_P + IT_C + IT_OUT + IT_PG + IT_PLE;
        for (int it = gw; it < DEPTH * IT_LAYER; it += NGW) {
            const int l = it / IT_LAYER; int r = it % IT_LAYER;
            bf16_t* wt = WT + (size_t)l * WT_LAYER;
            if (r < IT_IN) {
                const int kb = r / 336, nb = r % 336, n0 = nb * 32, k0 = kb * 64;
                const float* src = p->in[I_WIN] + (size_t)l * DM * NIN; int ldw = NIN, col0 = n0;
                if (n0 >= 1024 && n0 < 2048) { src = PVF + (size_t)l * DM * 1024; ldw = 1024; col0 = n0 - 1024; }
                else if (n0 >= 3072 && n0 < 4096) { const int j = (n0 - 3072) >> 8, lc = (n0 - 3072) & 255; col0 = lc < 128 ? 3072 + j * 128 + lc : 3584 + j * 128 + (lc - 128); }
                transpose_item(src, ldw, col0, wt + WT_IN, DM, n0, k0, scr, lane); continue; }
            r -= IT_IN;
            if (r < IT_F) { transpose_item(p->in[I_WF] + (size_t)l * 512 * DM, DM, (r % 64) * 32, wt + WT_F, 512, (r % 64) * 32, (r / 64) * 64, scr, lane); continue; }
            r -= IT_F;
            if (r < IT_P) { transpose_item(p->in[I_WP] + (size_t)l * 1024 * DM, DM, (r % 64) * 32, wt + WT_P, 1024, (r % 64) * 32, (r / 64) * 64, scr, lane); continue; }
            r -= IT_P;
            if (r < IT_C) { transpose_item(p->in[I_WC] + (size_t)l * 512 * DM, DM, (r % 64) * 32, wt + WT_C, 512, (r % 64) * 32, (r / 64) * 64, scr, lane); continue; }
            r -= IT_C;
            if (r < IT_OUT) { transpose_item(p->in[I_WOUT] + (size_t)l * DM * DM, DM, (r % 64) * 32, wt + WT_OUT, DM, (r % 64) * 32, (r / 64) * 64, scr, lane); continue; }
            r -= IT_OUT;
            if (r < IT_PG) { transpose_item(p->in[I_WPG] + (size_t)l * DM * DM, DM, (r % 64) * 32, wt + WT_PG, DM, (r % 64) * 32, (r / 64) * 64, scr, lane); continue; }
            r -= IT_PG;
            transpose_item(p->in[I_WPLE] + (size_t)l * PLE * DM, DM, (r % 64) * 32, wt + WT_PLE, PLE, (r % 64) * 32, (r / 64) * 64, scr, lane);
        }
    }
    GRID_SYNC();

    LAS f32x2* FX = (LAS f32x2*)lds;
    LAS f32x2* TW = (LAS f32x2*)(lds + 131072);
    LAS f32x2* TW2 = (LAS f32x2*)(lds + 131072 + 2048);

    for (int l = 0; l < DEPTH; ++l) {
        if (PHM & 4)
        {
            TID_VARS
            KARGS
            pg8::Gemm g{XB, wt + WT_IN, M_TOK, NIN, DM, DM, DM}; pg8::StaticOrder S; S.init(M_TOK, NIN, G, bid);
            EpiIn E{H, BIASP + (size_t)l * NIN};
            pg8::gemm_phase(lds, g, S, E, tid);
        }
        GRID_SYNC();
        if (PHM & 8)
        {
            TID_VARS
            KARGS
            if (tid < 16) { const float ang = (float)tid * (1.0f / 16.0f); TW[tid] = (f32x2){cospif(ang), -sinpif(ang)}; }
            for (int t = bid; t < 1024; t += G) {
                int base, n1, S1, lS;
                if (t < 512) { base = (t >> 6) * 2048; n1 = t & 63; S1 = 64; lS = 11; } else { const int tt = t - 512; base = M_PROMPT + (tt >> 8) * 8192; n1 = tt & 255; S1 = 256; lS = 13; }
                __syncthreads();
                if (tid < 32) { const int k2 = (int)(__brev((unsigned)tid) >> 27); const float ang = (float)((k2 * n1) & ((1 << lS) - 1)) * (2.0f / (float)(1 << lS)); TW2[tid] = (f32x2){cospif(ang), -sinpif(ang)}; }
                { bf16_t hv[32];
#pragma unroll
                for (int n2 = 0; n2 < 32; ++n2) hv[n2] = H[(size_t)(base + n1 + S1 * n2) * LDH + H_FV + tid];
#pragma unroll
                for (int n2 = 0; n2 < 32; ++n2) FX[n2 * 512 + tid] = (f32x2){bf1(hv[n2]), 0.f}; }
                __syncthreads();
                fft_lds(FX, TW, 5, 9, tid);
#pragma unroll 8
                for (int i2 = 0; i2 < 32; ++i2) { const int k2 = (int)(__brev((unsigned)i2) >> 27); const f32x2 z = FX[i2 * 512 + tid], w = TW2[i2];
                    ZB[(size_t)(base + k2 * S1 + n1) * 512 + tid] = (f32x2){z.x * w.x - z.y * w.y, z.x * w.y + z.y * w.x}; }
            }
            __syncthreads();
            {
                LAS float* WD = (LAS float*)lds;
                LAS unsigned char* VT = lds + 63488;
                const float* wdw = p->in[I_WDW] + (size_t)l * 31 * 512;
                for (int e = tid; e < 31 * 512; e += 512) WD[e] = wdw[e];
                const float* bdw = p->in[I_BDW] + l * 512 + 8 * lane; const float* cg_ = p->in[I_CG] + l * 512 + 8 * lane; const float* cb_ = p->in[I_CB] + l * 512 + 8 * lane;
                const f32x4 bd0 = *(const f32x4*)bdw, bd1 = *(const f32x4*)(bdw + 4), lg0 = *(const f32x4*)cg_, lg1 = *(const f32x4*)(cg_ + 4), lb0 = *(const f32x4*)cb_, lb1 = *(const f32x4*)(cb_ + 4);
                for (int rb = bid; rb < M_TOK / 128; rb += G)
                for (int c = 0; c < 4; ++c) {
                    const int R0 = rb * 128 + 32 * c; int base, S; seq_of_row(R0, base, S); const int t0 = R0 - base;
                    __syncthreads();
#pragma unroll
                    for (int it = 0; it < 8; ++it) { const int idx = it * 512 + tid; if (idx < 62 * 64) { const int q = idx >> 6, c16 = idx & 63, tt = t0 - 15 + q;
                        u32x4 v = {0u, 0u, 0u, 0u}; if (tt >= 0 && tt < S) v = *(const u32x4*)(H + (size_t)(base + tt) * LDH + H_V + c16 * 8);
                        *(LAS u32x4*)(VT + q * 1024 + c16 * 16) = v; } }
                    __syncthreads();
                    for (int i = wave; i < 32; i += 8) {
                        bf16_t* zp = H + (size_t)(R0 + i) * LDH + H_CZ + 8 * lane;
                        const u32x4 zw = *(const u32x4*)zp;
                        f32x4 a0 = bd0, a1 = bd1;
#pragma unroll 4
                        for (int j = 0; j < 31; ++j) {
                            f32x4 v0, v1; unpack8(*(const LAS u32x4*)(VT + (i + j) * 1024 + lane * 16), v0, v1);
                            const f32x4 w0 = *(const LAS f32x4*)(WD + j * 512 + 8 * lane), w1 = *(const LAS f32x4*)(WD + j * 512 + 8 * lane + 4);
                            a0 += w0 * v0; a1 += w1 * v1;
                        }
                        const float mean = wave_sum((a0[0] + a0[1]) + (a0[2] + a0[3]) + (a1[0] + a1[1]) + (a1[2] + a1[3])) * (1.f / 512.f);
                        a0 = a0 - mean; a1 = a1 - mean;
                        const float var = wave_sum((a0[0] * a0[0] + a0[1] * a0[1]) + (a0[2] * a0[2] + a0[3] * a0[3]) + (a1[0] * a1[0] + a1[1] * a1[1]) + (a1[2] * a1[2] + a1[3] * a1[3])) * (1.f / 512.f);
                        const float rstd = 1.f / sqrtf(var + LN_EPS);
                        f32x4 y0 = a0 * rstd * lg0 + lb0, y1 = a1 * rstd * lg1 + lb1;
                        f32x4 z0, z1; unpack8(zw, z0, z1);
                        *(u32x4*)zp = pack8(silu4(y0) * z0, silu4(y1) * z1);
                    }
                }
            }
            {
                const float* bg = p->in[I_BG] + l * 1024; const float* psc = p->in[I_PSC] + l * 1024;
                for (int rb = bid; rb < M_TOK / 128; rb += G) {
                const int R0 = rb * 128; int base, S; seq_of_row(R0, base, S); const int t0 = R0 - base;
                for (int g = 0; g < 4; ++g) {
                    const int hw = 1 << g, NR = 128 + 2 * hw;
                    __syncthreads();
                    for (int idx = tid; idx < NR * 32; idx += 512) { const int q = idx >> 5, c16 = idx & 31, tt = t0 - hw + q;
                        u32x4 v = {0u, 0u, 0u, 0u}; if (tt >= 0 && tt < S) v = *(const u32x4*)(H + (size_t)(base + tt) * LDH + H_PV + g * 256 + c16 * 8);
                        *(LAS u32x4*)(lds + q * 512 + c16 * 16) = v; }
                    __syncthreads();
                    u32x4 zws[8];
#pragma unroll
                    for (int k = 0; k < 8; ++k) { const int o = k * 512 + tid, r = o >> 5, chl = o & 31, ch = g * 32 + chl; zws[k] = *(const u32x4*)(H + (size_t)(R0 + r) * LDH + H_PZ + ch * 8); }
                    const int chl_ = tid & 31, ch_ = g * 32 + chl_;
                    const f32x4 b0 = *(const f32x4*)(bg + ch_ * 8), b1 = *(const f32x4*)(bg + ch_ * 8 + 4), q0 = *(const f32x4*)(psc + ch_ * 8), q1 = *(const f32x4*)(psc + ch_ * 8 + 4);
#pragma unroll
                    for (int k = 0; k < 8; ++k) {
                        const int o = k * 512 + tid, r = o >> 5, chl = o & 31, t = t0 + r, ch = g * 32 + chl;
                        bf16_t* zp = H + (size_t)(R0 + r) * LDH + H_PZ + ch * 8;
                        f32x4 s0 = {0, 0, 0, 0}, s1 = s0;
                        for (int kk = 0; kk < 2 * hw; ++kk) { f32x4 v0, v1; unpack8(*(const LAS u32x4*)(lds + (r + kk) * 512 + chl * 16), v0, v1); s0 += v0; s1 += v1; }
                        f32x4 c0, c1; unpack8(*(const LAS u32x4*)(lds + (r + hw) * 512 + chl * 16), c0, c1);
                        const float inv = 1.0f / (float)(min(t + hw, S) - max(t - hw, 0));
                        f32x4 z0, z1; unpack8(zws[k], z0, z1);
                        *(u32x4*)zp = pack8(((s0 * inv - c0) + b0) * q0 * z0, ((s1 * inv - c1) + b1) * q1 * z1);
                    }
                }
                }
            }
            {
                for (size_t e = gt; e < (size_t)M_TOK * 2; e += NGT) STATS[e] = 0.f;
                const float* pp = p->in[I_PP] + (size_t)l * M_PROMPT * PLE; const float* ps = p->in[I_PS] + (size_t)l * M_PROMPT * PLE;
#pragma unroll 4
                for (size_t e = gt; e < (size_t)M_TOK * PLE / 8; e += NGT) {
                    const size_t o = e * 8; const float* src = o < (size_t)M_PROMPT * PLE ? pp + o : ps + (o - (size_t)M_PROMPT * PLE);
                    *(u32x4*)(PB + o) = pack8(*(const f32x4*)src, *(const f32x4*)(src + 4));
                }
            }
        }
        GRID_SYNC();
        if (PHM & 16)
        {
            TID_VARS
            KARGS
            for (int t = bid; t < 1024; t += G) {
                int base, k2, cc, lR, lCW;
                if (t < 512) { base = (t >> 6) * 2048; const int rem = t & 63; k2 = rem >> 1; cc = rem & 1; lR = 6; lCW = 8; }
                else { const int tt = t - 512; base = M_PROMPT + (tt >> 8) * 8192; const int rem = tt & 255; k2 = rem >> 3; cc = rem & 7; lR = 8; lCW = 6; }
                const int R = 1 << lR, CWm = (1 << lCW) - 1;
                __syncthreads();
                if (tid < (R >> 1)) { const float ang = (float)tid * (2.0f / (float)R); TW[tid] = (f32x2){cospif(ang), -sinpif(ang)}; }
                const f32x2* zsrc = ZB + (size_t)(base + k2 * R) * 512 + (cc << lCW);
#pragma unroll
                for (int ih = 0; ih < 32; ih += 16) { f32x2 zv[16];
#pragma unroll
                    for (int it = 0; it < 16; ++it) { const int f = (ih + it) * 512 + tid, c = f & CWm, n1 = f >> lCW; zv[it] = zsrc[(size_t)n1 * 512 + c]; }
#pragma unroll
                    for (int it = 0; it < 16; ++it) FX[(ih + it) * 512 + tid] = zv[it]; }
                __syncthreads();
                fft_lds(FX, TW, lR, lCW, tid);
#pragma unroll 8
                for (int it = 0; it < 32; ++it) { const int f = it * 512 + tid, c = f & CWm, i1 = f >> lCW; const int k1 = (int)(__brev((unsigned)i1) >> (32 - lR));
                    const f32x2 z = FX[f]; bf16_t* o = XC + (size_t)(base + k2 + 32 * k1) * 1024 + (cc << lCW) + c;
                    o[0] = (bf16_t)(cvt_pk_bf16(z.x, 0.f) & 0xffffu); o[512] = (bf16_t)(cvt_pk_bf16(z.y, 0.f) & 0xffffu); }
            }
            __syncthreads();
            { const int tid = opaque_tid(); pg8::Gemm g{H + H_PZ, wt + WT_P, M_TOK, DM, 1024, LDH, 1024}; pg8::StaticOrder S; S.init(M_TOK, DM, G, bid);
              EpiMerge E{MRG, H + H_MG + DM, 1}; pg8::gemm_phase(lds, g, S, E, tid); }
            { const int tid = opaque_tid(); pg8::Gemm g{H + H_CZ, wt + WT_C, M_TOK, DM, 512, LDH, 512}; pg8::StaticOrder S; S.init(M_TOK, DM, G, bid);
              EpiMerge E{MRG, H + H_MG + 2 * DM, 0}; pg8::gemm_phase(lds, g, S, E, tid); }
        }
        GRID_SYNC();
        if (PHM & 32)
        {
            TID_VARS
            KARGS
            pg8::Gemm g{XC, FC, M_TOK, 512, 1024, 1024, 1024}; pg8::StaticOrder S; S.init(M_TOK, 512, G, bid);
            EpiFnet E{H}; pg8::gemm_phase(lds, g, S, E, tid);
        }
        GRID_SYNC();
        if (PHM & 64)
        {
            TID_VARS
            KARGS
            pg8::Gemm g{H + H_FZ, wt + WT_F, M_TOK, DM, 512, LDH, 512}; pg8::StaticOrder S; S.init(M_TOK, DM, G, bid);
            EpiMerge E{MRG, H + H_MG, 0}; pg8::gemm_phase(lds, g, S, E, tid);
        }
        GRID_SYNC();
        if (PHM & 128)
        {
            TID_VARS
            KARGS
            { const int tid = opaque_tid(); pg8::Gemm g{MRG, wt + WT_OUT, M_TOK, DM, DM, DM, DM}; pg8::StaticOrder S; S.init(M_TOK, DM, G, bid);
              EpiOut E{X, p->in[I_BOUT] + (size_t)l * DM, p->in[I_LNG] + (size_t)l * DM, XN, STATS}; pg8::gemm_phase(lds, g, S, E, tid); }
            { const int tid = opaque_tid(); pg8::Gemm g{PB, wt + WT_PLE, M_TOK, DM, PLE, PLE, PLE}; pg8::StaticOrder S; S.init(M_TOK, DM, G, bid);
              EpiPlain E{PLEB}; pg8::gemm_phase(lds, g, S, E, tid); }
        }
        GRID_SYNC();
        if (PHM & 512)
        {
            TID_VARS
            KARGS
            pg8::Gemm g{XN, wt + WT_PG, M_TOK, DM, DM, DM, DM}; pg8::StaticOrder S; S.init(M_TOK, DM, G, bid);
            EpiGate E{X, CGB + ((size_t)l * 2 + 0) * DM, CGB + ((size_t)l * 2 + 1) * DM, p->in[I_LNG] + (size_t)l * DM, p->in[I_LNB] + (size_t)l * DM, PLEB, XB, STATS}; pg8::gemm_phase(lds, g, S, E, tid);
        }
        if (l + 1 < DEPTH) GRID_SYNC();
    }
}

extern "C" void kernel_launch(void* const* d_in, const int* in_sizes, int n_in, void* d_out, int out_size, void* d_ws, size_t ws_size, hipStream_t stream) {
    static int grid_blocks = 0;
    if (grid_blocks == 0) {
        if (n_in != 25 || out_size != M_TOK * DM || ws_size < WS_END2) { fprintf(stderr, "kernel_launch: unexpected shapes: n_in %d out %d ws %zu (need %zu)\n", n_in, out_size, ws_size, (size_t)WS_END2); grid_blocks = -1; return; }
        int dev = 0, cus = 0, per_cu = 0;
        hipGetDevice(&dev);
        hipDeviceGetAttribute(&cus, hipDeviceAttributeMultiprocessorCount, dev);
        if (hipFuncSetAttribute((const void*)fwd_megakernel, hipFuncAttributeMaxDynamicSharedMemorySize, LDS_BYTES) != hipSuccess) { fprintf(stderr, "kernel_launch: hipFuncSetAttribute failed\n"); grid_blocks = -1; return; }
        hipOccupancyMaxActiveBlocksPerMultiprocessor(&per_cu, (const void*)fwd_megakernel, 512, LDS_BYTES);
        if (per_cu < 1) { fprintf(stderr, "kernel_launch: occupancy query says %d blocks per CU\n", per_cu); per_cu = 1; }
        (void)hipGetLastError();
        grid_blocks = cus;
    }
    if (grid_blocks < 0) return;
    if (hipMemsetAsync((char*)d_ws + OFF_BAR, 0, 16384 + (size_t)DEPTH * 2 * DM * 4, stream) != hipSuccess) { fprintf(stderr, "kernel_launch: memset failed\n"); return; }
    Params p{};
    for (int i = 0; i < 25; ++i) p.in[i] = (const float*)d_in[i];
    p.out = (float*)d_out; p.ws = (unsigned char*)d_ws; p.ph_lo = 0; p.ph_hi = 1000;
    void* args[] = {&p};
    hipError_t e = hipLaunchCooperativeKernel((const void*)fwd_megakernel, dim3(grid_blocks), dim3(512), args, LDS_BYTES, stream);
    if (e != hipSuccess) fprintf(stderr, "cooperative launch failed: %s (grid %d)\n", hipGetErrorString(e), grid_blocks);
}
```

```cpp
#include <hip/hip_runtime.h>
#include <hip/hip_cooperative_groups.h>
#include <cstdio>
namespace cg = cooperative_groups;

#define LAS __attribute__((address_space(3)))
typedef unsigned short bf16_t;
typedef short bf16x8 __attribute__((ext_vector_type(8)));
typedef float f32x4 __attribute__((ext_vector_type(4)));
typedef float f32x2 __attribute__((ext_vector_type(2)));
typedef unsigned u32x4 __attribute__((ext_vector_type(4)));
typedef unsigned u32x2 __attribute__((ext_vector_type(2)));

constexpr int M_TOK = 32768, M_PROMPT = 16384, DM = 2048, NIN = 10752, LDH = 10240, DEPTH = 4, PLE = 256;
constexpr size_t SEG_F = 0, SEG_P = SEG_F + (size_t)M_TOK * 1024, SEG_C = SEG_P + (size_t)M_TOK * 2048, SEG_G = SEG_C + (size_t)M_TOK * 1024;
constexpr int LDF = 1024, LDP = 2048, LDC = 1024, LDG = 2048;
constexpr float LN_EPS = 1e-5f;
constexpr float DN_ALPHA = 1.6817928305074290f;
constexpr size_t WT_IN = 0, WT_F = (size_t)NIN * DM, WT_P = WT_F + (size_t)DM * 512, WT_C = WT_P + (size_t)DM * 1024, WT_OUT = WT_C + (size_t)DM * 512,
                 WT_PG = WT_OUT + (size_t)DM * DM, WT_PLE = WT_PG + (size_t)DM * DM, WT_LAYER = WT_PLE + (size_t)DM * PLE;
constexpr size_t OFF_WT = 0;
constexpr size_t OFF_FC = OFF_WT + (size_t)DEPTH * WT_LAYER * 2;
constexpr size_t OFF_BIAS = OFF_FC + (size_t)512 * 1024 * 2;
constexpr size_t OFF_H = OFF_BIAS + (size_t)DEPTH * NIN * 4;
constexpr size_t OFF_MRG = OFF_H + (size_t)M_TOK * LDH * 2;
constexpr size_t OFF_XB = OFF_MRG + (size_t)M_TOK * DM * 2;
constexpr size_t OFF_XC = OFF_XB + (size_t)M_TOK * DM * 2;
constexpr size_t OFF_PB = OFF_XC + (size_t)M_TOK * 1024 * 2;
constexpr size_t WS_END = OFF_PB + (size_t)M_TOK * PLE * 2;
constexpr size_t OFF_BAR = WS_END;
constexpr size_t OFF_CGB = OFF_BAR + 16384;
constexpr size_t OFF_STATS = OFF_CGB + (size_t)DEPTH * 2 * DM * 4;
constexpr size_t WS_END2 = OFF_STATS + (size_t)M_TOK * 2 * 4;
constexpr size_t OFF_PVF = OFF_H;
constexpr size_t OFF_XN = OFF_H;
constexpr size_t OFF_PLEB = OFF_H + (size_t)M_TOK * DM * 2;
static_assert(OFF_FC % 256 == 0 && OFF_BIAS % 256 == 0 && OFF_H % 256 == 0 && OFF_MRG % 256 == 0 && OFF_XB % 256 == 0 && OFF_XC % 256 == 0 && OFF_PB % 256 == 0, "align");

constexpr int LDS_BYTES = 131072 + 4096;
#ifndef PHM
#define PHM 0xFFFF
#endif

typedef __bf16 bf16x2_t __attribute__((ext_vector_type(2)));
__device__ __forceinline__ unsigned cvt_pk_bf16(float lo, float hi) { f32x2 v = {lo, hi}; bf16x2_t b = __builtin_convertvector(v, bf16x2_t); return __builtin_bit_cast(unsigned, b); }
__device__ __forceinline__ float bf_lo(unsigned w) { return __uint_as_float(w << 16); }
__device__ __forceinline__ float bf_hi(unsigned w) { return __uint_as_float(w & 0xffff0000u); }
__device__ __forceinline__ float bf1(bf16_t h) { return __uint_as_float(((unsigned)h) << 16); }
__device__ __forceinline__ float sigmoidf_(float x) { return __builtin_amdgcn_rcpf(1.0f + __expf(-x)); }
__device__ __forceinline__ f32x4 sig4(f32x4 v) { return (f32x4){sigmoidf_(v[0]), sigmoidf_(v[1]), sigmoidf_(v[2]), sigmoidf_(v[3])}; }
__device__ __forceinline__ f32x4 silu4(f32x4 v) { return v * sig4(v); }
__device__ __forceinline__ void unpack8(u32x4 w, f32x4& a, f32x4& b) { a = (f32x4){bf_lo(w.x), bf_hi(w.x), bf_lo(w.y), bf_hi(w.y)}; b = (f32x4){bf_lo(w.z), bf_hi(w.z), bf_lo(w.w), bf_hi(w.w)}; }
__device__ __forceinline__ u32x4 pack8(f32x4 a, f32x4 b) { u32x4 w; w.x = cvt_pk_bf16(a[0], a[1]); w.y = cvt_pk_bf16(a[2], a[3]); w.z = cvt_pk_bf16(b[0], b[1]); w.w = cvt_pk_bf16(b[2], b[3]); return w; }
__device__ __forceinline__ float wave_sum(float v) {
#pragma unroll
    for (int o = 1; o < 64; o <<= 1) v += __shfl_xor(v, o);
    return v;
}
__device__ __forceinline__ int opaque_tid() { int t = threadIdx.x; asm volatile("" : "+v"(t)); return t; }
#define TID_VARS const int tid = opaque_tid(), lane = tid & 63, wave = __builtin_amdgcn_readfirstlane(tid >> 6); const int gw = bid * 8 + wave; const size_t gt = (size_t)bid * 512 + tid; (void)lane; (void)gw; (void)gt;
#define CG_SYNC() do { asm volatile("s_waitcnt vmcnt(0) lgkmcnt(0)" ::: "memory"); grid.sync(); asm volatile("" ::: "memory"); } while (0)
#define GRID_SYNC() do { asm volatile("" ::: "memory"); xcd_barrier(xbar); asm volatile("" ::: "memory"); } while (0)
#define LDS_WAIT() asm volatile("s_waitcnt lgkmcnt(0)" ::: "memory")

namespace pg8 {
constexpr int BM = 256, BK = 64, HALF = 128, HTB = HALF * BK * 2, NXCD = 8, WGM = 4;
__device__ __forceinline__ int lds_byte(int r, int c) { const int st = (r >> 4) * 2 + (c >> 5), rr = r & 15, cc = c & 31, ob = rr * 64 + cc * 2; return st * 1024 + (ob ^ (((ob >> 9) & 1) << 5)); }
__device__ __forceinline__ void stage_rc(int b, int& R, int& C) { const int st = b / 1024, sb = b % 1024, swz = sb ^ (((sb >> 9) & 1) << 5); R = (st >> 1) * 16 + swz / 64; C = (st & 1) * 32 + (swz % 64) / 2; }
__device__ __forceinline__ int perm32(int rho) { const int n = rho >> 4, i = rho & 15; return 8 * (i >> 2) + 4 * n + (i & 3); }
struct Unit { int pm, pn; };
struct Gemm { const bf16_t* A; const bf16_t* Bt; int M, N, K, lda, ldb; };
struct StaticOrder {
    int nM, nN, nwg, G, c;
    __device__ void init(int M, int N, int G_, int c_) { nM = M / BM; nN = N / BM; nwg = nM * nN; G = G_; c = c_; }
    __device__ bool next(int i, Unit& u) const {
        const long L = (long)i * G + c; if (L >= nwg) return false;
        int wgid = (int)L; { const int q = nwg / NXCD, r = nwg % NXCD, xcd = wgid % NXCD, off = wgid / NXCD; wgid = (xcd < r ? xcd * (q + 1) : r * (q + 1) + (xcd - r) * q) + off; }
        const int nig = WGM * nN, gid = wgid / nig, fm = gid * WGM, gsz = (nM - fm) < WGM ? (nM - fm) : WGM;
        u.pm = fm + ((wgid % nig) % gsz); u.pn = (wgid % nig) / gsz; return true;
    }
};
template <class Epi>
__device__ __forceinline__ void gemm_phase(LAS unsigned char* lds, const Gemm g, const StaticOrder& S, const Epi& E, const int tid) {
    const int wid = __builtin_amdgcn_readfirstlane(tid >> 6), lane = tid & 63, wr = wid >> 2, wc = wid & 3, fr = lane & 15, fq = lane >> 4;
    const int K = g.K, nt = K / BK;
    unsigned voffA[2], voffB[2];
#pragma unroll
    for (int i = 0; i < 2; ++i) { int R, C; stage_rc(tid * 16 + i * 8192, R, C); const int Rb = (R & ~31) + perm32(R & 31);
        voffA[i] = (unsigned)(R * g.lda + C) * 2u; voffB[i] = (unsigned)(Rb * g.ldb + C) * 2u; }
    const size_t kstep = (size_t)(BK * 2);
    const size_t hstepA = (size_t)HALF * g.lda * 2, hstepB = (size_t)HALF * g.ldb * 2;
    const size_t tstepA = 2 * hstepA, tstepB = 2 * hstepB;
    const unsigned ldsw = (unsigned)wid * 1024u;
    const int aoff = lds_byte(wr * 64 + fr, fq * 8), boff = lds_byte(wc * 32 + fr, fq * 8);
#define PG8_SA(b, h) (((b) * 2 + (h)) * HTB)
#define PG8_SB(b, h) ((4 + (b) * 2 + (h)) * HTB)
#define PG8_STAGE(bufoff, gbase, voff) do { _Pragma("unroll") for (int _i = 0; _i < 2; ++_i) \
        __builtin_amdgcn_global_load_lds((const unsigned*)((const char*)(gbase) + (voff)[_i]), (LAS unsigned*)(lds + (bufoff) + ldsw + _i * 8192), 16, 0, 0); } while (0)
#define PG8_LDA(dst, b, h) do { _Pragma("unroll") for (int m = 0; m < 4; ++m) _Pragma("unroll") for (int k = 0; k < 2; ++k) dst[m][k] = *(const LAS bf16x8*)(lds + PG8_SA(b, h) + aoff + m * 2048 + k * 1024); } while (0)
#define PG8_LDB(dst, b, h) do { _Pragma("unroll") for (int n = 0; n < 2; ++n) _Pragma("unroll") for (int k = 0; k < 2; ++k) dst[n][k] = *(const LAS bf16x8*)(lds + PG8_SB(b, h) + boff + n * 2048 + k * 1024); } while (0)
#define PG8_MMA(ai, bj, At, Bt) do { __builtin_amdgcn_s_setprio(1); _Pragma("unroll") for (int m = 0; m < 4; ++m) _Pragma("unroll") for (int n = 0; n < 2; ++n) _Pragma("unroll") for (int k = 0; k < 2; ++k) \
        acc[ai][bj][m][n] = __builtin_amdgcn_mfma_f32_16x16x32_bf16(Bt[n][k], At[m][k], acc[ai][bj][m][n], 0, 0, 0); __builtin_amdgcn_s_setprio(0); } while (0)
#define PG8_WAIT_V(n) asm volatile("s_waitcnt vmcnt(" #n ")" ::: "memory")
#define PG8_WAIT_L(n) asm volatile("s_waitcnt lgkmcnt(" #n ")" ::: "memory")
#define PG8_BAR __builtin_amdgcn_s_barrier()
#define PG8_SCHED __builtin_amdgcn_sched_barrier(0)
    Unit cur, nxt; int ui = 0;
    if (!S.next(0, cur)) return;
    f32x4 acc[2][2][4][2];
#pragma unroll
    for (int a = 0; a < 2; ++a)
#pragma unroll
        for (int b = 0; b < 2; ++b)
#pragma unroll
            for (int m = 0; m < 4; ++m)
#pragma unroll
                for (int n = 0; n < 2; ++n) acc[a][b][m][n] = (f32x4){0.f, 0.f, 0.f, 0.f};
    bf16x8 At[4][2], B0[2][2], B1[2][2];
    const char* cA = (const char*)g.A + (size_t)cur.pm * tstepA; const char* cB = (const char*)g.Bt + (size_t)cur.pn * tstepB;
    PG8_STAGE(PG8_SB(0, 0), cB, voffB); PG8_STAGE(PG8_SA(0, 0), cA, voffA); PG8_STAGE(PG8_SB(0, 1), cB + hstepB, voffB); PG8_STAGE(PG8_SA(0, 1), cA + hstepA, voffA);
    if (wr == 1) PG8_BAR;
    PG8_WAIT_V(4); PG8_BAR;
    PG8_STAGE(PG8_SB(1, 0), cB + kstep, voffB); PG8_STAGE(PG8_SA(1, 0), cA + kstep, voffA); PG8_STAGE(PG8_SB(1, 1), cB + hstepB + kstep, voffB);
    PG8_WAIT_V(6); PG8_BAR;
    for (;;) {
        const bool has_next = S.next(ui + 1, nxt);
        const char* nA = has_next ? (const char*)g.A + (size_t)nxt.pm * tstepA : cA; const char* nB = has_next ? (const char*)g.Bt + (size_t)nxt.pn * tstepB : cB;
        for (int t = 0; t < nt; t += 2) {
            const bool last = (t == nt - 2);
            const char* a1 = cA + (size_t)(t + 1) * kstep;
            const char* a2 = last ? nA : cA + (size_t)(t + 2) * kstep; const char* b2 = last ? nB : cB + (size_t)(t + 2) * kstep;
            const char* a3 = a2 + kstep; const char* b3 = b2 + kstep;
            PG8_LDB(B0, 0, 0); PG8_SCHED; PG8_LDA(At, 0, 0); PG8_STAGE(PG8_SA(1, 1), a1 + hstepA, voffA);
            PG8_WAIT_L(8); PG8_BAR; PG8_WAIT_L(0); PG8_MMA(0, 0, At, B0); PG8_BAR; PG8_SCHED;
            PG8_LDB(B1, 0, 1); PG8_STAGE(PG8_SB(0, 0), b2, voffB);
            PG8_BAR; PG8_WAIT_L(0); PG8_MMA(0, 1, At, B1); PG8_BAR;
            PG8_LDA(At, 0, 1); PG8_STAGE(PG8_SA(0, 0), a2, voffA);
            PG8_BAR; PG8_WAIT_L(0); PG8_MMA(1, 0, At, B0); PG8_BAR; PG8_SCHED;
            PG8_STAGE(PG8_SB(0, 1), b2 + hstepB, voffB);
            PG8_WAIT_V(6); PG8_BAR; PG8_MMA(1, 1, At, B1); PG8_BAR;
            PG8_LDB(B0, 1, 0); PG8_SCHED; PG8_LDA(At, 1, 0); PG8_STAGE(PG8_SA(0, 1), a2 + hstepA, voffA);
            PG8_WAIT_L(8); PG8_BAR; PG8_WAIT_L(0); PG8_MMA(0, 0, At, B0); PG8_BAR; PG8_SCHED;
            PG8_LDB(B1, 1, 1); PG8_STAGE(PG8_SB(1, 0), b3, voffB);
            PG8_BAR; PG8_WAIT_L(0); PG8_MMA(0, 1, At, B1); PG8_BAR;
            PG8_LDA(At, 1, 1); PG8_STAGE(PG8_SA(1, 0), a3, voffA);
            PG8_BAR; PG8_WAIT_L(0); PG8_MMA(1, 0, At, B0); PG8_BAR; PG8_SCHED;
            PG8_STAGE(PG8_SB(1, 1), b3 + hstepB, voffB);
            PG8_WAIT_V(6); PG8_BAR; PG8_MMA(1, 1, At, B1); PG8_BAR;
        }
        E(acc, cur, wr, wc, fr, fq);
        if (!has_next) break;
#pragma unroll
        for (int a = 0; a < 2; ++a)
#pragma unroll
            for (int b = 0; b < 2; ++b)
#pragma unroll
                for (int m = 0; m < 4; ++m)
#pragma unroll
                    for (int n = 0; n < 2; ++n) acc[a][b][m][n] = (f32x4){0.f, 0.f, 0.f, 0.f};
        cur = nxt; cA = nA; cB = nB; ++ui;
    }
    PG8_WAIT_V(0);
    if (wr == 0) PG8_BAR;
    PG8_BAR;
#undef PG8_SA
#undef PG8_SB
#undef PG8_STAGE
#undef PG8_LDA
#undef PG8_LDB
#undef PG8_MMA
#undef PG8_WAIT_V
#undef PG8_WAIT_L
#undef PG8_BAR
#undef PG8_SCHED
}
}
using pg8::Unit;

typedef const f32x4 (&AccRef)[2][2][4][2];

struct EpiIn {
    bf16_t* H; const float* bias;
    template <int MODE> __device__ __forceinline__ void body(AccRef acc, const f32x4 (&bv)[2][2], int row0, size_t hc, int ld) const {
#pragma unroll
        for (int ai = 0; ai < 2; ++ai)
#pragma unroll
            for (int m = 0; m < 4; ++m) { bf16_t* rowp = H + (size_t)(row0 + ai * 128 + m * 16) * ld + hc;
#pragma unroll
                for (int bj = 0; bj < 2; ++bj) { f32x4 v0 = acc[ai][bj][m][0] + bv[bj][0], v1 = acc[ai][bj][m][1] + bv[bj][1];
                    if (MODE == 1) { v0 = silu4(v0); v1 = silu4(v1); }
                    if (MODE == 2) { v0 = sig4(v0); v1 = sig4(v1); }
                    *(u32x4*)(rowp + bj * 128) = pack8(v0, v1); } }
    }
    __device__ __forceinline__ void operator()(AccRef acc, const Unit& u, int wr, int wc, int fr, int fq) const {
        const int pn = u.pn; int mode, ld; size_t hc;
        if (pn < 2) { mode = 0; hc = SEG_F + pn * 256; ld = LDF; } else if (pn < 4) { mode = 1; hc = SEG_F + pn * 256; ld = LDF; }
        else if (pn < 8) { mode = 0; hc = SEG_P + (pn - 4) * 256; ld = LDP; } else if (pn < 12) { mode = 1; hc = SEG_P + (pn - 4) * 256; ld = LDP; }
        else if (pn < 16) { mode = 3; hc = SEG_C + (pn - 12) * 128; ld = LDC; } else if (pn < 18) { mode = 1; hc = SEG_C + 512 + (pn - 16) * 256; ld = LDC; }
        else { const int e = (pn - 18) * 256; mode = 2; hc = SEG_G + (size_t)(e >> 11) * M_TOK * LDG + (e & 2047); ld = LDG; }
        const int row0 = u.pm * 256 + wr * 64 + fr, lc = wc * 32 + 8 * fq;
        f32x4 bv[2][2];
#pragma unroll
        for (int bj = 0; bj < 2; ++bj)
#pragma unroll
            for (int n = 0; n < 2; ++n) bv[bj][n] = *(const f32x4*)(bias + pn * 256 + bj * 128 + lc + 4 * n);
        hc += lc;
        if (mode == 3) {
#pragma unroll
            for (int ai = 0; ai < 2; ++ai)
#pragma unroll
                for (int m = 0; m < 4; ++m) { bf16_t* rowp = H + (size_t)(row0 + ai * 128 + m * 16) * ld + hc;
                    const f32x4 a0 = acc[ai][0][m][0] + bv[0][0], a1 = acc[ai][0][m][1] + bv[0][1], g0 = acc[ai][1][m][0] + bv[1][0], g1 = acc[ai][1][m][1] + bv[1][1];
                    *(u32x4*)rowp = pack8(a0 * sig4(g0), a1 * sig4(g1)); }
        } else if (mode == 0) body<0>(acc, bv, row0, hc, ld);
        else if (mode == 1) body<1>(acc, bv, row0, hc, ld);
        else body<2>(acc, bv, row0, hc, ld);
    }
};
struct EpiFnet {
    bf16_t* H;
    __device__ __forceinline__ void operator()(AccRef acc, const Unit& u, int wr, int wc, int fr, int fq) const {
        const float sc = (u.pm < 64) ? 0.001953125f   : 0.0009765625f  ;
        const int row0 = u.pm * 256 + wr * 64 + fr, c0 = 512 + u.pn * 256 + wc * 32 + 8 * fq;
#pragma unroll
        for (int ai = 0; ai < 2; ++ai)
#pragma unroll
            for (int m = 0; m < 4; ++m) { bf16_t* rowp = H + SEG_F + (size_t)(row0 + ai * 128 + m * 16) * LDF + c0;
#pragma unroll
                for (int bj = 0; bj < 2; ++bj) { f32x4 z0, z1; unpack8(*(const u32x4*)(rowp + bj * 128), z0, z1);
                    *(u32x4*)(rowp + bj * 128) = pack8(acc[ai][bj][m][0] * sc * z0, acc[ai][bj][m][1] * sc * z1); }
                if (m & 1) asm volatile("" ::: "memory"); }
    }
};
struct EpiMerge {
    bf16_t* MRG; const bf16_t* gate; int first;
    __device__ __forceinline__ void operator()(AccRef acc, const Unit& u, int wr, int wc, int fr, int fq) const {
        const int row0 = u.pm * 256 + wr * 64 + fr, c0 = u.pn * 256 + wc * 32 + 8 * fq;
#pragma unroll
        for (int ai = 0; ai < 2; ++ai)
#pragma unroll
            for (int m = 0; m < 4; ++m) { const size_t row = (size_t)(row0 + ai * 128 + m * 16); bf16_t* mp = MRG + row * DM + c0; const bf16_t* gp = gate + row * LDG + c0;
#pragma unroll
                for (int bj = 0; bj < 2; ++bj) { f32x4 g0, g1; unpack8(*(const u32x4*)(gp + bj * 128), g0, g1);
                    f32x4 o0 = g0 * acc[ai][bj][m][0], o1 = g1 * acc[ai][bj][m][1];
                    if (!first) { f32x4 p0, p1; unpack8(*(const u32x4*)(mp + bj * 128), p0, p1); o0 += p0; o1 += p1; }
                    *(u32x4*)(mp + bj * 128) = pack8(o0, o1); }
                if (m & 1) asm volatile("" ::: "memory"); }
    }
};
struct EpiOut {
    float* X; const float* bias; const float* lng; bf16_t* YG; float* stats;
    __device__ __forceinline__ void operator()(AccRef acc, const Unit& u, int wr, int wc, int fr, int fq) const {
        const int row0 = u.pm * 256 + wr * 64 + fr, c0 = u.pn * 256 + wc * 32 + 8 * fq;
        f32x4 bv[2][2], gv[2][2];
#pragma unroll
        for (int bj = 0; bj < 2; ++bj)
#pragma unroll
            for (int n = 0; n < 2; ++n) { bv[bj][n] = *(const f32x4*)(bias + c0 + bj * 128 + 4 * n); gv[bj][n] = *(const f32x4*)(lng + c0 + bj * 128 + 4 * n); }
#pragma unroll
        for (int ai = 0; ai < 2; ++ai)
#pragma unroll
            for (int m = 0; m < 4; ++m) { const int row = row0 + ai * 128 + m * 16; float* xp = X + (size_t)row * DM + c0; bf16_t* yp = YG + (size_t)row * DM + c0;
                float sm = 0.f, sq = 0.f;
#pragma unroll
                for (int bj = 0; bj < 2; ++bj) {
                    const f32x4 y0 = *(const f32x4*)(xp + bj * 128) * DN_ALPHA + acc[ai][bj][m][0] + bv[bj][0], y1 = *(const f32x4*)(xp + bj * 128 + 4) * DN_ALPHA + acc[ai][bj][m][1] + bv[bj][1];
                    *(f32x4*)(xp + bj * 128) = y0; *(f32x4*)(xp + bj * 128 + 4) = y1;
                    *(u32x4*)(yp + bj * 128) = pack8(y0 * gv[bj][0], y1 * gv[bj][1]);
                    sm += (y0[0] + y0[1]) + (y0[2] + y0[3]) + (y1[0] + y1[1]) + (y1[2] + y1[3]);
                    sq += (y0[0] * y0[0] + y0[1] * y0[1]) + (y0[2] * y0[2] + y0[3] * y0[3]) + (y1[0] * y1[0] + y1[1] * y1[1]) + (y1[2] * y1[2] + y1[3] * y1[3]);
                }
                sm += __shfl_xor(sm, 16); sq += __shfl_xor(sq, 16); sm += __shfl_xor(sm, 32); sq += __shfl_xor(sq, 32);
                if (fq == 0) { (void)__hip_atomic_fetch_add(stats + 2 * row, sm, __ATOMIC_RELAXED, __HIP_MEMORY_SCOPE_AGENT); (void)__hip_atomic_fetch_add(stats + 2 * row + 1, sq, __ATOMIC_RELAXED, __HIP_MEMORY_SCOPE_AGENT); }
                if (m & 1) asm volatile("" ::: "memory"); }
    }
};
struct EpiPlain {
    bf16_t* O;
    __device__ __forceinline__ void operator()(AccRef acc, const Unit& u, int wr, int wc, int fr, int fq) const {
        const int row0 = u.pm * 256 + wr * 64 + fr, c0 = u.pn * 256 + wc * 32 + 8 * fq;
#pragma unroll
        for (int ai = 0; ai < 2; ++ai)
#pragma unroll
            for (int m = 0; m < 4; ++m) { bf16_t* op = O + (size_t)(row0 + ai * 128 + m * 16) * DM + c0;
#pragma unroll
                for (int bj = 0; bj < 2; ++bj) *(u32x4*)(op + bj * 128) = pack8(acc[ai][bj][m][0], acc[ai][bj][m][1]); }
    }
};
struct EpiGate {
    float* X; const float* cg; const float* cb; const float* lng; const float* lnb; const bf16_t* PLEB; bf16_t* XB; const float* stats;
    __device__ __forceinline__ void operator()(AccRef acc, const Unit& u, int wr, int wc, int fr, int fq) const {
        const int row0 = u.pm * 256 + wr * 64 + fr, c0 = u.pn * 256 + wc * 32 + 8 * fq;
#pragma unroll
        for (int ai = 0; ai < 2; ++ai)
#pragma unroll
            for (int m = 0; m < 4; ++m) { const int row = row0 + ai * 128 + m * 16; const size_t ro = (size_t)row * DM + c0;
                const f32x2 st = *(const f32x2*)(stats + 2 * row);
                const float mu = st.x * (1.f / DM), var = st.y * (1.f / DM) - mu * mu, r = 1.f / sqrtf(var + LN_EPS);
#pragma unroll
                for (int bj = 0; bj < 2; ++bj) { f32x4 p0, p1; unpack8(*(const u32x4*)(PLEB + ro + bj * 128), p0, p1);
                    const f32x4 y0 = *(const f32x4*)(X + ro + bj * 128), y1 = *(const f32x4*)(X + ro + bj * 128 + 4);
                    const f32x4 g0 = *(const f32x4*)(lng + c0 + bj * 128), g1 = *(const f32x4*)(lng + c0 + bj * 128 + 4), b0 = *(const f32x4*)(lnb + c0 + bj * 128), b1 = *(const f32x4*)(lnb + c0 + bj * 128 + 4);
                    const f32x4 x0 = (y0 - mu) * r * g0 + b0, x1 = (y1 - mu) * r * g1 + b1;
                    const f32x4 cg0 = *(const f32x4*)(cg + c0 + bj * 128), cg1 = *(const f32x4*)(cg + c0 + bj * 128 + 4), cb0 = *(const f32x4*)(cb + c0 + bj * 128), cb1 = *(const f32x4*)(cb + c0 + bj * 128 + 4);
                    const f32x4 o0 = x0 + sig4((acc[ai][bj][m][0] - mu * cg0) * r + cb0) * p0, o1 = x1 + sig4((acc[ai][bj][m][1] - mu * cg1) * r + cb1) * p1;
                    *(f32x4*)(X + ro + bj * 128) = o0; *(f32x4*)(X + ro + bj * 128 + 4) = o1; *(u32x4*)(XB + ro + bj * 128) = pack8(o0, o1); }
                if (m & 1) asm volatile("" ::: "memory"); }
    }
};

struct Params { const float* in[25]; float* out; unsigned char* ws; int ph_lo, ph_hi; };
enum { I_XP = 0, I_XS, I_PP, I_PS, I_EG, I_EB, I_WIN, I_BIN, I_WF, I_WG, I_BG, I_PSC, I_WP, I_WDW, I_BDW, I_CG, I_CB, I_WC, I_WOUT, I_BOUT, I_LNG, I_LNB, I_WPLE, I_WPG, I_BPG };

__device__ __forceinline__ void seq_of_row(int row, int& base, int& S) {
    if (row < M_PROMPT) { S = 2048; base = row & ~2047; } else { S = 8192; base = M_PROMPT + ((row - M_PROMPT) & ~8191); }
}

__device__ __forceinline__ void ln_row(const float* src, float* dstf, bf16_t* dstb, const float* g, const float* b, int lane) {
    f32x4 v[8]; float s = 0.f;
#pragma unroll
    for (int j = 0; j < 8; ++j) { v[j] = ((const f32x4*)src)[lane + 64 * j]; s += (v[j][0] + v[j][1]) + (v[j][2] + v[j][3]); }
    const float mean = wave_sum(s) * (1.f / DM); float s2 = 0.f;
#pragma unroll
    for (int j = 0; j < 8; ++j) { v[j] = v[j] - mean; s2 += (v[j][0] * v[j][0] + v[j][1] * v[j][1]) + (v[j][2] * v[j][2] + v[j][3] * v[j][3]); }
    const float rstd = 1.f / sqrtf(wave_sum(s2) * (1.f / DM) + LN_EPS);
#pragma unroll
    for (int j = 0; j < 8; ++j) { const f32x4 gg = ((const f32x4*)g)[lane + 64 * j], bb = ((const f32x4*)b)[lane + 64 * j]; const f32x4 o = v[j] * rstd * gg + bb;
        ((f32x4*)dstf)[lane + 64 * j] = o; u32x2 w; w.x = cvt_pk_bf16(o[0], o[1]); w.y = cvt_pk_bf16(o[2], o[3]); ((u32x2*)dstb)[lane + 64 * j] = w; }
}

__device__ __forceinline__ void transpose_item(const float* W, int ldw, int col0, bf16_t* WT, int ldt, int row0, int k0, LAS float* scr, int lane) {
    { float wv[32];
#pragma unroll
    for (int i = 0; i < 32; ++i) { const int kk = 2 * i + (lane >> 5); wv[i] = W[(size_t)(k0 + kk) * ldw + col0 + (lane & 31)]; }
#pragma unroll
    for (int i = 0; i < 32; ++i) { const int kk = 2 * i + (lane >> 5); scr[kk * 33 + (lane & 31)] = wv[i]; } }
    LDS_WAIT();
    const int c = lane & 7;
#pragma unroll
    for (int j = 0; j < 4; ++j) { const int n = (lane >> 3) + 8 * j; const LAS float* s = scr + (8 * c) * 33 + n;
        u32x4 o; o.x = cvt_pk_bf16(s[0 * 33], s[1 * 33]); o.y = cvt_pk_bf16(s[2 * 33], s[3 * 33]); o.z = cvt_pk_bf16(s[4 * 33], s[5 * 33]); o.w = cvt_pk_bf16(s[6 * 33], s[7 * 33]);
        *(u32x4*)(WT + (size_t)(row0 + n) * ldt + k0 + 8 * c) = o; }
    LDS_WAIT();
}

__device__ __forceinline__ void fft_lds(LAS f32x2* X, const LAS f32x2* tw, int logR, int logCW, int tid) {
    const int CWm = (1 << logCW) - 1;
    for (int p = 0; p < logR; ++p) {
        const int lh = logR - 1 - p, half = 1 << lh;
#pragma unroll 4
        for (int it = 0; it < 16; ++it) {
            const int f = it * 512 + tid, c = f & CWm, j = f >> logCW, grp = j >> lh, pos = j & (half - 1);
            const int i0 = ((grp << (lh + 1)) + pos), i1 = i0 + half;
            const f32x2 a = X[(i0 << logCW) + c], b = X[(i1 << logCW) + c], w = tw[pos << p];
            const f32x2 d = a - b;
            X[(i0 << logCW) + c] = a + b;
            X[(i1 << logCW) + c] = (f32x2){d.x * w.x - d.y * w.y, d.x * w.y + d.y * w.x};
        }
        __syncthreads();
    }
}


#define XB_TMO      128
#define XB_XCNT(j)  (256  + 64 * (j))
#define XB_XSUB(j)  (1280 + 64 * (j))
#define XB_XGEN(j)  (2304 + 64 * (j))
#define XB_TOP      3328
#define XB_TOPGEN   3392
#define XCD_BAR_WORDS 3456
#define XB_SPIN_CAP (1u << 22)
__device__ __forceinline__ unsigned xb_ld(unsigned* p)              { return __hip_atomic_load(p, __ATOMIC_RELAXED, __HIP_MEMORY_SCOPE_AGENT); }
__device__ __forceinline__ unsigned xb_add(unsigned* p, unsigned v) { return __hip_atomic_fetch_add(p, v, __ATOMIC_RELAXED, __HIP_MEMORY_SCOPE_AGENT); }
__device__ __forceinline__ unsigned xb_xcc_id() { return (unsigned)__builtin_amdgcn_s_getreg((3 << 11) | 20) & 0xFu; }
#define XB_SPIN(cond, bar) do { unsigned _sp = 0; while (cond) { __builtin_amdgcn_s_sleep(1); \
    if ((++_sp & 255u) == 0u) { if (xb_ld(&(bar)[XB_TMO])) break; if (_sp > XB_SPIN_CAP) { atomicAdd(&(bar)[XB_TMO], 1u); break; } } } } while (0)
struct XcdBarrier { unsigned* bar; unsigned x; volatile LAS unsigned* st; };
__device__ __forceinline__ XcdBarrier xcd_barrier_post(unsigned* bar, volatile LAS unsigned* st) {
    XcdBarrier b; b.bar = bar; b.x = xb_xcc_id(); b.st = st;
    if (threadIdx.x == 0) (void)xb_add(&bar[XB_XCNT(b.x)], 1u);
    return b;
}
__device__ __forceinline__ void xcd_barrier_complete(unsigned* bar, unsigned x, unsigned& nloc, unsigned& nx) {
    const unsigned G = gridDim.x * gridDim.y * gridDim.z;
    unsigned sum, cnt, mine, sp = 0u;
    for (;;) {
        sum = 0u; cnt = 0u; mine = 0u;
#pragma unroll
        for (unsigned j = 0; j < 16; ++j) { const unsigned c = xb_ld(&bar[XB_XCNT(j)]); sum += c; cnt += (c > 0u) ? 1u : 0u; mine = (j == x) ? c : mine; }
        if (sum == G) break;
        __builtin_amdgcn_s_sleep(1);
        if ((++sp & 255u) == 0u) { if (xb_ld(&bar[XB_TMO])) break; if (sp > XB_SPIN_CAP) { atomicAdd(&bar[XB_TMO], 1u); break; } }
    }
    nloc = mine > 0u ? mine : 1u; nx = cnt > 0u ? cnt : 1u;
}
__device__ __forceinline__ void xcd_barrier(const XcdBarrier& b) {
    asm volatile("s_waitcnt vmcnt(0)" ::: "memory");
    __syncthreads();
    if (threadIdx.x == 0) {
        unsigned* bar = b.bar;
        __builtin_amdgcn_s_waitcnt(0);
        unsigned nloc = b.st[0], nx = b.st[1];
        if (nloc == 0u) { xcd_barrier_complete(bar, b.x, nloc, nx); b.st[0] = nloc; b.st[1] = nx; }
        const unsigned old = xb_add(&bar[XB_XSUB(b.x)], 1u);
        const unsigned gen = old / nloc;
        if (old + 1u == (gen + 1u) * nloc) {
            __builtin_amdgcn_fence(__ATOMIC_RELEASE, "agent");
            asm volatile("s_waitcnt vmcnt(0)" ::: "memory");
            const unsigned og = xb_add(&bar[XB_TOP], 1u);
            const unsigned tg = og / nx;
            if (og + 1u == (tg + 1u) * nx) xb_add(&bar[XB_TOPGEN], 1u);
            else XB_SPIN(xb_ld(&bar[XB_TOPGEN]) == tg, bar);
            __builtin_amdgcn_fence(__ATOMIC_ACQUIRE, "agent");
            xb_add(&bar[XB_XGEN(b.x)], 1u);
            asm volatile("s_waitcnt vmcnt(0)" ::: "memory");
        } else {
            XB_SPIN(xb_ld(&bar[XB_XGEN(b.x)]) == gen, bar);
            __builtin_amdgcn_fence(__ATOMIC_ACQUIRE, "agent");
            asm volatile("s_waitcnt vmcnt(0)" ::: "memory");
        }
    }
    __syncthreads();
}

typedef const __attribute__((address_space(4))) Params* KP;
__device__ __forceinline__ KP kparams() { unsigned long long k = (unsigned long long)__builtin_amdgcn_kernarg_segment_ptr(); asm volatile("" : "+s"(k)); return (KP)k; }
#define KARGS0 KP p = kparams(); unsigned char* ws = p->ws; \
    bf16_t* WT = (bf16_t*)(ws + OFF_WT); bf16_t* FC = (bf16_t*)(ws + OFF_FC); float* BIASP = (float*)(ws + OFF_BIAS); \
    bf16_t* H = (bf16_t*)(ws + OFF_H); bf16_t* MRG = (bf16_t*)(ws + OFF_MRG); bf16_t* XB = (bf16_t*)(ws + OFF_XB); f32x2* ZB = (f32x2*)(ws + OFF_XB); \
    bf16_t* XC = (bf16_t*)(ws + OFF_XC); bf16_t* PB = (bf16_t*)(ws + OFF_PB); float* PVF = (float*)(ws + OFF_PVF); \
    bf16_t* XN = (bf16_t*)(ws + OFF_XN); bf16_t* PLEB = (bf16_t*)(ws + OFF_PLEB); float* X = p->out; \
    float* CGB = (float*)(ws + OFF_CGB); float* STATS = (float*)(ws + OFF_STATS); \
    (void)WT; (void)FC; (void)BIASP; (void)H; (void)MRG; (void)XB; (void)ZB; (void)XC; (void)PB; (void)PVF; (void)XN; (void)PLEB; (void)X; (void)CGB; (void)STATS;
#define KARGS KARGS0 const bf16_t* wt = WT + (size_t)l * WT_LAYER; (void)wt;
__global__ void __launch_bounds__(512, 2) fwd_megakernel(Params p_) {
    extern __shared__ __attribute__((aligned(16))) unsigned char smem[];
    cg::grid_group grid = cg::this_grid();
    LAS unsigned char* lds = (LAS unsigned char*)smem;
    const int G = gridDim.x, bid = blockIdx.x;
    const int NGW = G * 8;
    const size_t NGT = (size_t)G * 512;
    volatile LAS unsigned* xst = (volatile LAS unsigned*)(lds + 131072 + 4000);
    if (threadIdx.x < 2) xst[threadIdx.x] = 0u;
    __syncthreads();
    const XcdBarrier xbar = xcd_barrier_post((unsigned*)(kparams()->ws + OFF_BAR), xst);

    if (PHM & 1)
    {
        TID_VARS
            KARGS0
        const float* w_in = p->in[I_WIN]; const float* wg = p->in[I_WG];
        for (int task = gw; task < DEPTH * 512 * 4; task += NGW) {
            const int g = task & 3, kb = (task >> 2) & 511, l = task >> 11;
            const float* a = w_in + ((size_t)l * DM + kb * 4) * NIN + 1024 + g * 256;
            const float* b = wg + ((size_t)(l * 4 + g) * 256) * 256 + 4 * lane;
            f32x4 acc0 = {0, 0, 0, 0}, acc1 = acc0, acc2 = acc0, acc3 = acc0;
#pragma unroll 8
            for (int c = 0; c < 256; ++c) { const f32x4 bv = *(const f32x4*)(b + (size_t)c * 256);
                acc0 += a[c] * bv; acc1 += a[NIN + c] * bv; acc2 += a[2 * NIN + c] * bv; acc3 += a[3 * NIN + c] * bv; }
            float* o = PVF + ((size_t)l * DM + kb * 4) * 1024 + g * 256 + 4 * lane;
            *(f32x4*)o = acc0; *(f32x4*)(o + 1024) = acc1; *(f32x4*)(o + 2048) = acc2; *(f32x4*)(o + 3072) = acc3;
        }
        const float* b_in = p->in[I_BIN];
        for (size_t e = gt; e < (size_t)DEPTH * NIN; e += NGT) {
            const int l = (int)(e / NIN), n = (int)(e % NIN); float v;
            if (n >= 1024 && n < 2048) v = 0.f;
            else if (n >= 3072 && n < 4096) { const int j = (n - 3072) >> 8, lc = (n - 3072) & 255; v = b_in[(size_t)l * NIN + (lc < 128 ? 3072 + j * 128 + lc : 3584 + j * 128 + (lc - 128))]; }
            else v = b_in[(size_t)l * NIN + n];
            BIASP[e] = v;
        }
        for (size_t e = gt; e < (size_t)512 * 1024; e += NGT) {
            const int r = (int)(e >> 10), q = (int)(e & 1023), g = r >> 7, d = r & 127, half = q >> 9, g2 = (q >> 7) & 3, c = q & 127;
            float v = 0.f;
            if (g == g2) { const float ang = (float)((c * d) & 127) * (1.0f / 64.0f); v = half ? sinpif(ang) : cospif(ang); }
            FC[e] = (bf16_t)(cvt_pk_bf16(v, 0.f) & 0xffffu);
        }
        for (size_t e = gt; e < (size_t)DEPTH * DM * 16; e += NGT) {
            const int kc = (int)(e / ((size_t)DEPTH * DM)), le = (int)(e % ((size_t)DEPTH * DM)), l = le / DM, col = le % DM;
            const float* w = p->in[I_WPG] + ((size_t)l * DM + kc * 128) * DM + col; const float* g = p->in[I_LNG] + l * DM + kc * 128; const float* b = p->in[I_LNB] + l * DM + kc * 128;
            float sg = 0.f, sb = (kc == 0) ? p->in[I_BPG][l * DM + col] : 0.f;
#pragma unroll 8
            for (int k = 0; k < 128; ++k) { const float wv = w[(size_t)k * DM]; sg += g[k] * wv; sb += b[k] * wv; }
            (void)__hip_atomic_fetch_add(CGB + ((size_t)l * 2 + 0) * DM + col, sg, __ATOMIC_RELAXED, __HIP_MEMORY_SCOPE_AGENT);
            (void)__hip_atomic_fetch_add(CGB + ((size_t)l * 2 + 1) * DM + col, sb, __ATOMIC_RELAXED, __HIP_MEMORY_SCOPE_AGENT);
        }
        for (int row = gw; row < M_TOK; row += NGW) {
            const float* src = row < M_PROMPT ? p->in[I_XP] + (size_t)row * DM : p->in[I_XS] + (size_t)(row - M_PROMPT) * DM;
            ln_row(src, X + (size_t)row * DM, XB + (size_t)row * DM, p->in[I_EG], p->in[I_EB], lane);
        }
    }
    CG_SYNC();
    if (PHM & 2)
    {
        TID_VARS
            KARGS0
        LAS float* scr = (LAS float*)(lds + wave * 16384);
        constexpr int IT_IN = 32 * 336, IT_F = 8 * 64, IT_P = 16 * 64, IT_C = 8 * 64, IT_OUT = 32 * 64, IT_PG = 32 * 64, IT_PLE = 4 * 64;
        constexpr int IT_LAYER = IT_IN + IT_F + IT_P + IT_C + IT_OUT + IT_PG + IT_PLE;
        for (int it = gw; it < DEPTH * IT_LAYER; it += NGW) {
            const int l = it / IT_LAYER; int r = it % IT_LAYER;
            bf16_t* wt = WT + (size_t)l * WT_LAYER;
            if (r < IT_IN) {
                const int kb = r / 336, nb = r % 336, n0 = nb * 32, k0 = kb * 64;
                const float* src = p->in[I_WIN] + (size_t)l * DM * NIN; int ldw = NIN, col0 = n0;
                if (n0 >= 1024 && n0 < 2048) { src = PVF + (size_t)l * DM * 1024; ldw = 1024; col0 = n0 - 1024; }
                else if (n0 >= 3072 && n0 < 4096) { const int j = (n0 - 3072) >> 8, lc = (n0 - 3072) & 255; col0 = lc < 128 ? 3072 + j * 128 + lc : 3584 + j * 128 + (lc - 128); }
                transpose_item(src, ldw, col0, wt + WT_IN, DM, n0, k0, scr, lane); continue; }
            r -= IT_IN;
            if (r < IT_F) { transpose_item(p->in[I_WF] + (size_t)l * 512 * DM, DM, (r % 64) * 32, wt + WT_F, 512, (r % 64) * 32, (r / 64) * 64, scr, lane); continue; }
            r -= IT_F;
            if (r < IT_P) { transpose_item(p->in[I_WP] + (size_t)l * 1024 * DM, DM, (r % 64) * 32, wt + WT_P, 1024, (r % 64) * 32, (r / 64) * 64, scr, lane); continue; }
            r -= IT_P;
            if (r < IT_C) { transpose_item(p->in[I_WC] + (size_t)l * 512 * DM, DM, (r % 64) * 32, wt + WT_C, 512, (r % 64) * 32, (r / 64) * 64, scr, lane); continue; }
            r -= IT_C;
            if (r < IT_OUT) { transpose_item(p->in[I_WOUT] + (size_t)l * DM * DM, DM, (r % 64) * 32, wt + WT_OUT, DM, (r % 64) * 32, (r / 64) * 64, scr, lane); continue; }
            r -= IT_OUT;
            if (r < IT_PG) { transpose_item(p->in[I_WPG] + (size_t)l * DM * DM, DM, (r % 64) * 32, wt + WT_PG, DM, (r % 64) * 32, (r / 64) * 64, scr, lane); continue; }
            r -= IT_PG;
            transpose_item(p->in[I_WPLE] + (size_t)l * PLE * DM, DM, (r % 64) * 32, wt + WT_PLE, PLE, (r % 64) * 32, (r / 64) * 64, scr, lane);
        }
    }
    GRID_SYNC();

    LAS f32x2* FX = (LAS f32x2*)lds;
    LAS f32x2* TW = (LAS f32x2*)(lds + 131072);
    LAS f32x2* TW2 = (LAS f32x2*)(lds + 131072 + 2048);

    for (int l = 0; l < DEPTH; ++l) {
        if (PHM & 4)
        {
            TID_VARS
            KARGS
            pg8::Gemm g{XB, wt + WT_IN, M_TOK, NIN, DM, DM, DM}; pg8::StaticOrder S; S.init(M_TOK, NIN, G, bid);
            EpiIn E{H, BIASP + (size_t)l * NIN};
            pg8::gemm_phase(lds, g, S, E, tid);
        }
        GRID_SYNC();
        if (PHM & 8)
        {
            TID_VARS
            KARGS
            if (tid < 16) { const float ang = (float)tid * (1.0f / 16.0f); TW[tid] = (f32x2){cospif(ang), -sinpif(ang)}; }
            for (int t = bid; t < 1024; t += G) {
                int base, n1, S1, lS;
                if (t < 512) { base = (t >> 6) * 2048; n1 = t & 63; S1 = 64; lS = 11; } else { const int tt = t - 512; base = M_PROMPT + (tt >> 8) * 8192; n1 = tt & 255; S1 = 256; lS = 13; }
                __syncthreads();
                if (tid < 32) { const int k2 = (int)(__brev((unsigned)tid) >> 27); const float ang = (float)((k2 * n1) & ((1 << lS) - 1)) * (2.0f / (float)(1 << lS)); TW2[tid] = (f32x2){cospif(ang), -sinpif(ang)}; }
                { bf16_t hv[32];
#pragma unroll
                for (int n2 = 0; n2 < 32; ++n2) hv[n2] = H[SEG_F + (size_t)(base + n1 + S1 * n2) * LDF + tid];
#pragma unroll
                for (int n2 = 0; n2 < 32; ++n2) FX[n2 * 512 + tid] = (f32x2){bf1(hv[n2]), 0.f}; }
                __syncthreads();
                fft_lds(FX, TW, 5, 9, tid);
#pragma unroll 8
                for (int i2 = 0; i2 < 32; ++i2) { const int k2 = (int)(__brev((unsigned)i2) >> 27); const f32x2 z = FX[i2 * 512 + tid], w = TW2[i2];
                    ZB[(size_t)(base + k2 * S1 + n1) * 512 + tid] = (f32x2){z.x * w.x - z.y * w.y, z.x * w.y + z.y * w.x}; }
            }
            __syncthreads();
            {
                LAS float* WD = (LAS float*)lds;
                LAS unsigned char* VT = lds + 63488;
                const float* wdw = p->in[I_WDW] + (size_t)l * 31 * 512;
                for (int e = tid; e < 31 * 512; e += 512) WD[e] = wdw[e];
                const float* bdw = p->in[I_BDW] + l * 512 + 8 * lane; const float* cg_ = p->in[I_CG] + l * 512 + 8 * lane; const float* cb_ = p->in[I_CB] + l * 512 + 8 * lane;
                const f32x4 bd0 = *(const f32x4*)bdw, bd1 = *(const f32x4*)(bdw + 4), lg0 = *(const f32x4*)cg_, lg1 = *(const f32x4*)(cg_ + 4), lb0 = *(const f32x4*)cb_, lb1 = *(const f32x4*)(cb_ + 4);
                for (int rb = bid; rb < M_TOK / 128; rb += G)
                for (int c = 0; c < 4; ++c) {
                    const int R0 = rb * 128 + 32 * c; int base, S; seq_of_row(R0, base, S); const int t0 = R0 - base;
                    __syncthreads();
#pragma unroll
                    for (int it = 0; it < 8; ++it) { const int idx = it * 512 + tid; if (idx < 62 * 64) { const int q = idx >> 6, c16 = idx & 63, tt = t0 - 15 + q;
                        u32x4 v = {0u, 0u, 0u, 0u}; if (tt >= 0 && tt < S) v = *(const u32x4*)(H + SEG_C + (size_t)(base + tt) * LDC + c16 * 8);
                        *(LAS u32x4*)(VT + q * 1024 + c16 * 16) = v; } }
                    __syncthreads();
                    for (int i = wave; i < 32; i += 8) {
                        bf16_t* zp = H + SEG_C + (size_t)(R0 + i) * LDC + 512 + 8 * lane;
                        const u32x4 zw = *(const u32x4*)zp;
                        f32x4 a0 = bd0, a1 = bd1;
#pragma unroll 4
                        for (int j = 0; j < 31; ++j) {
                            f32x4 v0, v1; unpack8(*(const LAS u32x4*)(VT + (i + j) * 1024 + lane * 16), v0, v1);
                            const f32x4 w0 = *(const LAS f32x4*)(WD + j * 512 + 8 * lane), w1 = *(const LAS f32x4*)(WD + j * 512 + 8 * lane + 4);
                            a0 += w0 * v0; a1 += w1 * v1;
                        }
                        const float mean = wave_sum((a0[0] + a0[1]) + (a0[2] + a0[3]) + (a1[0] + a1[1]) + (a1[2] + a1[3])) * (1.f / 512.f);
                        a0 = a0 - mean; a1 = a1 - mean;
                        const float var = wave_sum((a0[0] * a0[0] + a0[1] * a0[1]) + (a0[2] * a0[2] + a0[3] * a0[3]) + (a1[0] * a1[0] + a1[1] * a1[1]) + (a1[2] * a1[2] + a1[3] * a1[3])) * (1.f / 512.f);
                        const float rstd = 1.f / sqrtf(var + LN_EPS);
                        f32x4 y0 = a0 * rstd * lg0 + lb0, y1 = a1 * rstd * lg1 + lb1;
                        f32x4 z0, z1; unpack8(zw, z0, z1);
                        *(u32x4*)zp = pack8(silu4(y0) * z0, silu4(y1) * z1);
                    }
                }
            }
            {
                const float* bg = p->in[I_BG] + l * 1024; const float* psc = p->in[I_PSC] + l * 1024;
                for (int rb = bid; rb < M_TOK / 128; rb += G) {
                const int R0 = rb * 128; int base, S; seq_of_row(R0, base, S); const int t0 = R0 - base;
                for (int g = 0; g < 4; ++g) {
                    const int hw = 1 << g, NR = 128 + 2 * hw;
                    __syncthreads();
                    for (int idx = tid; idx < NR * 32; idx += 512) { const int q = idx >> 5, c16 = idx & 31, tt = t0 - hw + q;
                        u32x4 v = {0u, 0u, 0u, 0u}; if (tt >= 0 && tt < S) v = *(const u32x4*)(H + SEG_P + (size_t)(base + tt) * LDP + g * 256 + c16 * 8);
                        *(LAS u32x4*)(lds + q * 512 + c16 * 16) = v; }
                    __syncthreads();
                    u32x4 zws[8];
#pragma unroll
                    for (int k = 0; k < 8; ++k) { const int o = k * 512 + tid, r = o >> 5, chl = o & 31, ch = g * 32 + chl; zws[k] = *(const u32x4*)(H + SEG_P + (size_t)(R0 + r) * LDP + 1024 + ch * 8); }
                    const int chl_ = tid & 31, ch_ = g * 32 + chl_;
                    const f32x4 b0 = *(const f32x4*)(bg + ch_ * 8), b1 = *(const f32x4*)(bg + ch_ * 8 + 4), q0 = *(const f32x4*)(psc + ch_ * 8), q1 = *(const f32x4*)(psc + ch_ * 8 + 4);
#pragma unroll
                    for (int k = 0; k < 8; ++k) {
                        const int o = k * 512 + tid, r = o >> 5, chl = o & 31, t = t0 + r, ch = g * 32 + chl;
                        bf16_t* zp = H + SEG_P + (size_t)(R0 + r) * LDP + 1024 + ch * 8;
                        f32x4 s0 = {0, 0, 0, 0}, s1 = s0;
                        for (int kk = 0; kk < 2 * hw; ++kk) { f32x4 v0, v1; unpack8(*(const LAS u32x4*)(lds + (r + kk) * 512 + chl * 16), v0, v1); s0 += v0; s1 += v1; }
                        f32x4 c0, c1; unpack8(*(const LAS u32x4*)(lds + (r + hw) * 512 + chl * 16), c0, c1);
                        const float inv = 1.0f / (float)(min(t + hw, S) - max(t - hw, 0));
                        f32x4 z0, z1; unpack8(zws[k], z0, z1);
                        *(u32x4*)zp = pack8(((s0 * inv - c0) + b0) * q0 * z0, ((s1 * inv - c1) + b1) * q1 * z1);
                    }
                }
                }
            }
            {
                for (size_t e = gt; e < (size_t)M_TOK * 2; e += NGT) STATS[e] = 0.f;
                const float* pp = p->in[I_PP] + (size_t)l * M_PROMPT * PLE; const float* ps = p->in[I_PS] + (size_t)l * M_PROMPT * PLE;
#pragma unroll 4
                for (size_t e = gt; e < (size_t)M_TOK * PLE / 8; e += NGT) {
                    const size_t o = e * 8; const float* src = o < (size_t)M_PROMPT * PLE ? pp + o : ps + (o - (size_t)M_PROMPT * PLE);
                    *(u32x4*)(PB + o) = pack8(*(const f32x4*)src, *(const f32x4*)(src + 4));
                }
            }
        }
        GRID_SYNC();
        if (PHM & 16)
        {
            TID_VARS
            KARGS
            for (int t = bid; t < 1024; t += G) {
                int base, k2, cc, lR, lCW;
                if (t < 512) { base = (t >> 6) * 2048; const int rem = t & 63; k2 = rem >> 1; cc = rem & 1; lR = 6; lCW = 8; }
                else { const int tt = t - 512; base = M_PROMPT + (tt >> 8) * 8192; const int rem = tt & 255; k2 = rem >> 3; cc = rem & 7; lR = 8; lCW = 6; }
                const int R = 1 << lR, CWm = (1 << lCW) - 1;
                __syncthreads();
                if (tid < (R >> 1)) { const float ang = (float)tid * (2.0f / (float)R); TW[tid] = (f32x2){cospif(ang), -sinpif(ang)}; }
                const f32x2* zsrc = ZB + (size_t)(base + k2 * R) * 512 + (cc << lCW);
#pragma unroll
                for (int ih = 0; ih < 32; ih += 16) { f32x2 zv[16];
#pragma unroll
                    for (int it = 0; it < 16; ++it) { const int f = (ih + it) * 512 + tid, c = f & CWm, n1 = f >> lCW; zv[it] = zsrc[(size_t)n1 * 512 + c]; }
#pragma unroll
                    for (int it = 0; it < 16; ++it) FX[(ih + it) * 512 + tid] = zv[it]; }
                __syncthreads();
                fft_lds(FX, TW, lR, lCW, tid);
#pragma unroll 8
                for (int it = 0; it < 32; ++it) { const int f = it * 512 + tid, c = f & CWm, i1 = f >> lCW; const int k1 = (int)(__brev((unsigned)i1) >> (32 - lR));
                    const f32x2 z = FX[f]; bf16_t* o = XC + (size_t)(base + k2 + 32 * k1) * 1024 + (cc << lCW) + c;
                    o[0] = (bf16_t)(cvt_pk_bf16(z.x, 0.f) & 0xffffu); o[512] = (bf16_t)(cvt_pk_bf16(z.y, 0.f) & 0xffffu); }
            }
            __syncthreads();
            { const int tid = opaque_tid(); pg8::Gemm g{H + SEG_P + 1024, wt + WT_P, M_TOK, DM, 1024, LDP, 1024}; pg8::StaticOrder S; S.init(M_TOK, DM, G, bid);
              EpiMerge E{MRG, H + SEG_G + (size_t)M_TOK * LDG, 1}; pg8::gemm_phase(lds, g, S, E, tid); }
            { const int tid = opaque_tid(); pg8::Gemm g{H + SEG_C + 512, wt + WT_C, M_TOK, DM, 512, LDC, 512}; pg8::StaticOrder S; S.init(M_TOK, DM, G, bid);
              EpiMerge E{MRG, H + SEG_G + (size_t)2 * M_TOK * LDG, 0}; pg8::gemm_phase(lds, g, S, E, tid); }
        }
        GRID_SYNC();
        if (PHM & 32)
        {
            TID_VARS
            KARGS
            pg8::Gemm g{XC, FC, M_TOK, 512, 1024, 1024, 1024}; pg8::StaticOrder S; S.init(M_TOK, 512, G, bid);
            EpiFnet E{H}; pg8::gemm_phase(lds, g, S, E, tid);
        }
        GRID_SYNC();
        if (PHM & 64)
        {
            TID_VARS
            KARGS
            pg8::Gemm g{H + SEG_F + 512, wt + WT_F, M_TOK, DM, 512, LDF, 512}; pg8::StaticOrder S; S.init(M_TOK, DM, G, bid);
            EpiMerge E{MRG, H + SEG_G, 0}; pg8::gemm_phase(lds, g, S, E, tid);
        }
        GRID_SYNC();
        if (PHM & 128)
        {
            TID_VARS
            KARGS
            { const int tid = opaque_tid(); pg8::Gemm g{MRG, wt + WT_OUT, M_TOK, DM, DM, DM, DM}; pg8::StaticOrder S; S.init(M_TOK, DM, G, bid);
              EpiOut E{X, p->in[I_BOUT] + (size_t)l * DM, p->in[I_LNG] + (size_t)l * DM, XN, STATS}; pg8::gemm_phase(lds, g, S, E, tid); }
            { const int tid = opaque_tid(); pg8::Gemm g{PB, wt + WT_PLE, M_TOK, DM, PLE, PLE, PLE}; pg8::StaticOrder S; S.init(M_TOK, DM, G, bid);
              EpiPlain E{PLEB}; pg8::gemm_phase(lds, g, S, E, tid); }
        }
        GRID_SYNC();
        if (PHM & 512)
        {
            TID_VARS
            KARGS
            pg8::Gemm g{XN, wt + WT_PG, M_TOK, DM, DM, DM, DM}; pg8::StaticOrder S; S.init(M_TOK, DM, G, bid);
            EpiGate E{X, CGB + ((size_t)l * 2 + 0) * DM, CGB + ((size_t)l * 2 + 1) * DM, p->in[I_LNG] + (size_t)l * DM, p->in[I_LNB] + (size_t)l * DM, PLEB, XB, STATS}; pg8::gemm_phase(lds, g, S, E, tid);
        }
        if (l + 1 < DEPTH) GRID_SYNC();
    }
}

extern "C" void kernel_launch(void* const* d_in, const int* in_sizes, int n_in, void* d_out, int out_size, void* d_ws, size_t ws_size, hipStream_t stream) {
    static int grid_blocks = 0;
    if (grid_blocks == 0) {
        if (n_in != 25 || out_size != M_TOK * DM || ws_size < WS_END2) { fprintf(stderr, "kernel_launch: unexpected shapes: n_in %d out %d ws %zu (need %zu)\n", n_in, out_size, ws_size, (size_t)WS_END2); grid_blocks = -1; return; }
        int dev = 0, cus = 0, per_cu = 0;
        hipGetDevice(&dev);
        hipDeviceGetAttribute(&cus, hipDeviceAttributeMultiprocessorCount, dev);
        if (hipFuncSetAttribute((const void*)fwd_megakernel, hipFuncAttributeMaxDynamicSharedMemorySize, LDS_BYTES) != hipSuccess) { fprintf(stderr, "kernel_launch: hipFuncSetAttribute failed\n"); grid_blocks = -1; return; }
        hipOccupancyMaxActiveBlocksPerMultiprocessor(&per_cu, (const void*)fwd_megakernel, 512, LDS_BYTES);
        if (per_cu < 1) { fprintf(stderr, "kernel_launch: occupancy query says %d blocks per CU\n", per_cu); per_cu = 1; }
        (void)hipGetLastError();
        grid_blocks = cus;
    }
    if (grid_blocks < 0) return;
    if (hipMemsetAsync((char*)d_ws + OFF_BAR, 0, 16384 + (size_t)DEPTH * 2 * DM * 4, stream) != hipSuccess) { fprintf(stderr, "kernel_launch: memset failed\n"); return; }
    Params p{};
    for (int i = 0; i < 25; ++i) p.in[i] = (const float*)d_in[i];
    p.out = (float*)d_out; p.ws = (unsigned char*)d_ws; p.ph_lo = 0; p.ph_hi = 1000;
    void* args[] = {&p};
    hipError_t e = hipLaunchCooperativeKernel((const void*)fwd_megakernel, dim3(grid_blocks), dim3(512), args, LDS_BYTES, stream);
    if (e != hipSuccess) fprintf(stderr, "cooperative launch failed: %s (grid %d)\n", hipGetErrorString(e), grid_blocks);
}
```

```cpp
#include <hip/hip_runtime.h>
#include <hip/hip_cooperative_groups.h>
#include <cstdio>
namespace cg = cooperative_groups;

#define LAS __attribute__((address_space(3)))
typedef unsigned short bf16_t;
typedef short bf16x8 __attribute__((ext_vector_type(8)));
typedef float f32x4 __attribute__((ext_vector_type(4)));
typedef float f32x2 __attribute__((ext_vector_type(2)));
typedef unsigned u32x4 __attribute__((ext_vector_type(4)));
typedef unsigned u32x2 __attribute__((ext_vector_type(2)));

constexpr int M_TOK = 32768, M_PROMPT = 16384, DM = 2048, NIN = 10752, LDH = 10240, DEPTH = 4, PLE = 256;
constexpr size_t SEG_F = 0, SEG_P = SEG_F + (size_t)M_TOK * 1024, SEG_C = SEG_P + (size_t)M_TOK * 2048, SEG_G = SEG_C + (size_t)M_TOK * 1024;
constexpr int LDF = 1024, LDP = 2048, LDC = 1024, LDG = 2048;
constexpr float LN_EPS = 1e-5f;
constexpr float DN_ALPHA = 1.6817928305074290f;
constexpr size_t WT_IN = 0, WT_F = (size_t)NIN * DM, WT_P = WT_F + (size_t)DM * 512, WT_C = WT_P + (size_t)DM * 1024, WT_OUT = WT_C + (size_t)DM * 512,
                 WT_PG = WT_OUT + (size_t)DM * DM, WT_PLE = WT_PG + (size_t)DM * DM, WT_LAYER = WT_PLE + (size_t)DM * PLE;
constexpr size_t OFF_WT = 0;
constexpr size_t OFF_FC = OFF_WT + (size_t)DEPTH * WT_LAYER * 2;
constexpr size_t OFF_BIAS = OFF_FC + (size_t)512 * 1024 * 2;
constexpr size_t OFF_H = OFF_BIAS + (size_t)DEPTH * NIN * 4;
constexpr size_t OFF_MRG = OFF_H + (size_t)M_TOK * LDH * 2;
constexpr size_t OFF_XB = OFF_MRG + (size_t)M_TOK * DM * 2;
constexpr size_t OFF_XC = OFF_XB + (size_t)M_TOK * DM * 2;
constexpr size_t OFF_PB = OFF_XC + (size_t)M_TOK * 1024 * 2;
constexpr size_t WS_END = OFF_PB + (size_t)M_TOK * PLE * 2;
constexpr size_t OFF_BAR = WS_END;
constexpr size_t OFF_CGB = OFF_BAR + 16384;
constexpr size_t OFF_STATS = OFF_CGB + (size_t)DEPTH * 2 * DM * 4;
constexpr size_t WS_END2 = OFF_STATS + (size_t)M_TOK * 2 * 4;
constexpr size_t OFF_PVF = OFF_H;
constexpr size_t OFF_XN = OFF_H;
constexpr size_t OFF_PLEB = OFF_H + (size_t)M_TOK * DM * 2;
static_assert(OFF_FC % 256 == 0 && OFF_BIAS % 256 == 0 && OFF_H % 256 == 0 && OFF_MRG % 256 == 0 && OFF_XB % 256 == 0 && OFF_XC % 256 == 0 && OFF_PB % 256 == 0, "align");

constexpr int LDS_BYTES = 131072 + 4096;
#ifndef PHM
#define PHM 0xFFFF
#endif

typedef __bf16 bf16x2_t __attribute__((ext_vector_type(2)));
__device__ __forceinline__ unsigned cvt_pk_bf16(float lo, float hi) { f32x2 v = {lo, hi}; bf16x2_t b = __builtin_convertvector(v, bf16x2_t); return __builtin_bit_cast(unsigned, b); }
__device__ __forceinline__ float bf_lo(unsigned w) { return __uint_as_float(w << 16); }
__device__ __forceinline__ float bf_hi(unsigned w) { return __uint_as_float(w & 0xffff0000u); }
__device__ __forceinline__ float bf1(bf16_t h) { return __uint_as_float(((unsigned)h) << 16); }
__device__ __forceinline__ float sigmoidf_(float x) { return __builtin_amdgcn_rcpf(1.0f + __expf(-x)); }
__device__ __forceinline__ f32x4 sig4(f32x4 v) { return (f32x4){sigmoidf_(v[0]), sigmoidf_(v[1]), sigmoidf_(v[2]), sigmoidf_(v[3])}; }
__device__ __forceinline__ f32x4 silu4(f32x4 v) { return v * sig4(v); }
__device__ __forceinline__ void unpack8(u32x4 w, f32x4& a, f32x4& b) { a = (f32x4){bf_lo(w.x), bf_hi(w.x), bf_lo(w.y), bf_hi(w.y)}; b = (f32x4){bf_lo(w.z), bf_hi(w.z), bf_lo(w.w), bf_hi(w.w)}; }
__device__ __forceinline__ u32x4 pack8(f32x4 a, f32x4 b) { u32x4 w; w.x = cvt_pk_bf16(a[0], a[1]); w.y = cvt_pk_bf16(a[2], a[3]); w.z = cvt_pk_bf16(b[0], b[1]); w.w = cvt_pk_bf16(b[2], b[3]); return w; }
__device__ __forceinline__ float wave_sum(float v) {
#pragma unroll
    for (int o = 1; o < 64; o <<= 1) v += __shfl_xor(v, o);
    return v;
}
__device__ __forceinline__ int opaque_tid() { int t = threadIdx.x; asm volatile("" : "+v"(t)); return t; }
#define TID_VARS const int tid = opaque_tid(), lane = tid & 63, wave = __builtin_amdgcn_readfirstlane(tid >> 6); const int gw = bid * 8 + wave; const size_t gt = (size_t)bid * 512 + tid; (void)lane; (void)gw; (void)gt;
#define CG_SYNC() do { asm volatile("s_waitcnt vmcnt(0) lgkmcnt(0)" ::: "memory"); grid.sync(); asm volatile("" ::: "memory"); } while (0)
#define GRID_SYNC() do { asm volatile("" ::: "memory"); xcd_barrier(xbar); asm volatile("" ::: "memory"); } while (0)
#define LDS_WAIT() asm volatile("s_waitcnt lgkmcnt(0)" ::: "memory")

namespace pg8 {
constexpr int BM = 256, BK = 64, HALF = 128, HTB = HALF * BK * 2, NXCD = 8, WGM = 4;
__device__ __forceinline__ int lds_byte(int r, int c) { const int st = (r >> 4) * 2 + (c >> 5), rr = r & 15, cc = c & 31, ob = rr * 64 + cc * 2; return st * 1024 + (ob ^ (((ob >> 9) & 1) << 5)); }
__device__ __forceinline__ void stage_rc(int b, int& R, int& C) { const int st = b / 1024, sb = b % 1024, swz = sb ^ (((sb >> 9) & 1) << 5); R = (st >> 1) * 16 + swz / 64; C = (st & 1) * 32 + (swz % 64) / 2; }
__device__ __forceinline__ int perm32(int rho) { const int n = rho >> 4, i = rho & 15; return 8 * (i >> 2) + 4 * n + (i & 3); }
struct Unit { int pm, pn; };
struct Gemm { const bf16_t* A; const bf16_t* Bt; int M, N, K, lda, ldb; };
struct StaticOrder {
    int nM, nN, nwg, G, c;
    __device__ void init(int M, int N, int G_, int c_) { nM = M / BM; nN = N / BM; nwg = nM * nN; G = G_; c = c_; }
    __device__ bool next(int i, Unit& u) const {
        const long L = (long)i * G + c; if (L >= nwg) return false;
        int wgid = (int)L; { const int q = nwg / NXCD, r = nwg % NXCD, xcd = wgid % NXCD, off = wgid / NXCD; wgid = (xcd < r ? xcd * (q + 1) : r * (q + 1) + (xcd - r) * q) + off; }
        const int nig = WGM * nN, gid = wgid / nig, fm = gid * WGM, gsz = (nM - fm) < WGM ? (nM - fm) : WGM;
        u.pm = fm + ((wgid % nig) % gsz); u.pn = (wgid % nig) / gsz; return true;
    }
};
template <class Epi>
__device__ __forceinline__ void gemm_phase(LAS unsigned char* lds, const Gemm g, const StaticOrder& S, const Epi& E, const int tid) {
    const int wid = __builtin_amdgcn_readfirstlane(tid >> 6), lane = tid & 63, wr = wid >> 2, wc = wid & 3, fr = lane & 15, fq = lane >> 4;
    const int K = g.K, nt = K / BK;
    unsigned voffA[2], voffB[2];
#pragma unroll
    for (int i = 0; i < 2; ++i) { int R, C; stage_rc(tid * 16 + i * 8192, R, C); const int Rb = (R & ~31) + perm32(R & 31);
        voffA[i] = (unsigned)(R * g.lda + C) * 2u; voffB[i] = (unsigned)(Rb * g.ldb + C) * 2u; }
    const size_t kstep = (size_t)(BK * 2);
    const size_t hstepA = (size_t)HALF * g.lda * 2, hstepB = (size_t)HALF * g.ldb * 2;
    const size_t tstepA = 2 * hstepA, tstepB = 2 * hstepB;
    const unsigned ldsw = (unsigned)wid * 1024u;
    const int aoff = lds_byte(wr * 64 + fr, fq * 8), boff = lds_byte(wc * 32 + fr, fq * 8);
#define PG8_SA(b, h) (((b) * 2 + (h)) * HTB)
#define PG8_SB(b, h) ((4 + (b) * 2 + (h)) * HTB)
#define PG8_STAGE(bufoff, gbase, voff) do { _Pragma("unroll") for (int _i = 0; _i < 2; ++_i) \
        __builtin_amdgcn_global_load_lds((const unsigned*)((const char*)(gbase) + (voff)[_i]), (LAS unsigned*)(lds + (bufoff) + ldsw + _i * 8192), 16, 0, 0); } while (0)
#define PG8_LDA(dst, b, h) do { _Pragma("unroll") for (int m = 0; m < 4; ++m) _Pragma("unroll") for (int k = 0; k < 2; ++k) dst[m][k] = *(const LAS bf16x8*)(lds + PG8_SA(b, h) + aoff + m * 2048 + k * 1024); } while (0)
#define PG8_LDB(dst, b, h) do { _Pragma("unroll") for (int n = 0; n < 2; ++n) _Pragma("unroll") for (int k = 0; k < 2; ++k) dst[n][k] = *(const LAS bf16x8*)(lds + PG8_SB(b, h) + boff + n * 2048 + k * 1024); } while (0)
#define PG8_MMA(ai, bj, At, Bt) do { __builtin_amdgcn_s_setprio(1); _Pragma("unroll") for (int m = 0; m < 4; ++m) _Pragma("unroll") for (int n = 0; n < 2; ++n) _Pragma("unroll") for (int k = 0; k < 2; ++k) \
        acc[ai][bj][m][n] = __builtin_amdgcn_mfma_f32_16x16x32_bf16(Bt[n][k], At[m][k], acc[ai][bj][m][n], 0, 0, 0); __builtin_amdgcn_s_setprio(0); } while (0)
#define PG8_WAIT_V(n) asm volatile("s_waitcnt vmcnt(" #n ")" ::: "memory")
#define PG8_WAIT_L(n) asm volatile("s_waitcnt lgkmcnt(" #n ")" ::: "memory")
#define PG8_BAR __builtin_amdgcn_s_barrier()
#define PG8_SCHED __builtin_amdgcn_sched_barrier(0)
    Unit cur, nxt; int ui = 0;
    if (!S.next(0, cur)) return;
    f32x4 acc[2][2][4][2];
#pragma unroll
    for (int a = 0; a < 2; ++a)
#pragma unroll
        for (int b = 0; b < 2; ++b)
#pragma unroll
            for (int m = 0; m < 4; ++m)
#pragma unroll
                for (int n = 0; n < 2; ++n) acc[a][b][m][n] = (f32x4){0.f, 0.f, 0.f, 0.f};
    bf16x8 At[4][2], B0[2][2], B1[2][2];
    const char* cA = (const char*)g.A + (size_t)cur.pm * tstepA; const char* cB = (const char*)g.Bt + (size_t)cur.pn * tstepB;
    PG8_STAGE(PG8_SB(0, 0), cB, voffB); PG8_STAGE(PG8_SA(0, 0), cA, voffA); PG8_STAGE(PG8_SB(0, 1), cB + hstepB, voffB); PG8_STAGE(PG8_SA(0, 1), cA + hstepA, voffA);
    if (wr == 1) PG8_BAR;
    PG8_WAIT_V(4); PG8_BAR;
    PG8_STAGE(PG8_SB(1, 0), cB + kstep, voffB); PG8_STAGE(PG8_SA(1, 0), cA + kstep, voffA); PG8_STAGE(PG8_SB(1, 1), cB + hstepB + kstep, voffB);
    PG8_WAIT_V(6); PG8_BAR;
    for (;;) {
        const bool has_next = S.next(ui + 1, nxt);
        const char* nA = has_next ? (const char*)g.A + (size_t)nxt.pm * tstepA : cA; const char* nB = has_next ? (const char*)g.Bt + (size_t)nxt.pn * tstepB : cB;
        for (int t = 0; t < nt; t += 2) {
            const bool last = (t == nt - 2);
            const char* a1 = cA + (size_t)(t + 1) * kstep;
            const char* a2 = last ? nA : cA + (size_t)(t + 2) * kstep; const char* b2 = last ? nB : cB + (size_t)(t + 2) * kstep;
            const char* a3 = a2 + kstep; const char* b3 = b2 + kstep;
            PG8_LDB(B0, 0, 0); PG8_SCHED; PG8_LDA(At, 0, 0); PG8_STAGE(PG8_SA(1, 1), a1 + hstepA, voffA);
            PG8_WAIT_L(8); PG8_BAR; PG8_WAIT_L(0); PG8_MMA(0, 0, At, B0); PG8_BAR; PG8_SCHED;
            PG8_LDB(B1, 0, 1); PG8_STAGE(PG8_SB(0, 0), b2, voffB);
            PG8_BAR; PG8_WAIT_L(0); PG8_MMA(0, 1, At, B1); PG8_BAR;
            PG8_LDA(At, 0, 1); PG8_STAGE(PG8_SA(0, 0), a2, voffA);
            PG8_BAR; PG8_WAIT_L(0); PG8_MMA(1, 0, At, B0); PG8_BAR; PG8_SCHED;
            PG8_STAGE(PG8_SB(0, 1), b2 + hstepB, voffB);
            PG8_WAIT_V(6); PG8_BAR; PG8_MMA(1, 1, At, B1); PG8_BAR;
            PG8_LDB(B0, 1, 0); PG8_SCHED; PG8_LDA(At, 1, 0); PG8_STAGE(PG8_SA(0, 1), a2 + hstepA, voffA);
            PG8_WAIT_L(8); PG8_BAR; PG8_WAIT_L(0); PG8_MMA(0, 0, At, B0); PG8_BAR; PG8_SCHED;
            PG8_LDB(B1, 1, 1); PG8_STAGE(PG8_SB(1, 0), b3, voffB);
            PG8_BAR; PG8_WAIT_L(0); PG8_MMA(0, 1, At, B1); PG8_BAR;
            PG8_LDA(At, 1, 1); PG8_STAGE(PG8_SA(1, 0), a3, voffA);
            PG8_BAR; PG8_WAIT_L(0); PG8_MMA(1, 0, At, B0); PG8_BAR; PG8_SCHED;
            PG8_STAGE(PG8_SB(1, 1), b3 + hstepB, voffB);
            PG8_WAIT_V(6); PG8_BAR; PG8_MMA(1, 1, At, B1); PG8_BAR;
        }
        E(acc, cur, wr, wc, fr, fq);
        if (!has_next) break;
#pragma unroll
        for (int a = 0; a < 2; ++a)
#pragma unroll
            for (int b = 0; b < 2; ++b)
#pragma unroll
                for (int m = 0; m < 4; ++m)
#pragma unroll
                    for (int n = 0; n < 2; ++n) acc[a][b][m][n] = (f32x4){0.f, 0.f, 0.f, 0.f};
        cur = nxt; cA = nA; cB = nB; ++ui;
    }
    PG8_WAIT_V(0);
    if (wr == 0) PG8_BAR;
    PG8_BAR;
#undef PG8_SA
#undef PG8_SB
#undef PG8_STAGE
#undef PG8_LDA
#undef PG8_LDB
#undef PG8_MMA
#undef PG8_WAIT_V
#undef PG8_WAIT_L
#undef PG8_BAR
#undef PG8_SCHED
}
}
using pg8::Unit;

typedef const f32x4 (&AccRef)[2][2][4][2];

struct EpiIn {
    bf16_t* H; const float* bias;
    template <int MODE> __device__ __forceinline__ void body(AccRef acc, const f32x4 (&bv)[2][2], int row0, size_t hc, int ld) const {
#pragma unroll
        for (int ai = 0; ai < 2; ++ai)
#pragma unroll
            for (int m = 0; m < 4; ++m) { bf16_t* rowp = H + (size_t)(row0 + ai * 128 + m * 16) * ld + hc;
#pragma unroll
                for (int bj = 0; bj < 2; ++bj) { f32x4 v0 = acc[ai][bj][m][0] + bv[bj][0], v1 = acc[ai][bj][m][1] + bv[bj][1];
                    if (MODE == 1) { v0 = silu4(v0); v1 = silu4(v1); }
                    if (MODE == 2) { v0 = sig4(v0); v1 = sig4(v1); }
                    *(u32x4*)(rowp + bj * 128) = pack8(v0, v1); } }
    }
    __device__ __forceinline__ void operator()(AccRef acc, const Unit& u, int wr, int wc, int fr, int fq) const {
        const int pn = u.pn; int mode, ld; size_t hc;
        if (pn < 2) { mode = 0; hc = SEG_F + pn * 256; ld = LDF; } else if (pn < 4) { mode = 1; hc = SEG_F + pn * 256; ld = LDF; }
        else if (pn < 8) { mode = 0; hc = SEG_P + (pn - 4) * 256; ld = LDP; } else if (pn < 12) { mode = 1; hc = SEG_P + (pn - 4) * 256; ld = LDP; }
        else if (pn < 16) { mode = 3; hc = SEG_C + (pn - 12) * 128; ld = LDC; } else if (pn < 18) { mode = 1; hc = SEG_C + 512 + (pn - 16) * 256; ld = LDC; }
        else { const int e = (pn - 18) * 256; mode = 2; hc = SEG_G + (size_t)(e >> 11) * M_TOK * LDG + (e & 2047); ld = LDG; }
        const int row0 = u.pm * 256 + wr * 64 + fr, lc = wc * 32 + 8 * fq;
        f32x4 bv[2][2];
#pragma unroll
        for (int bj = 0; bj < 2; ++bj)
#pragma unroll
            for (int n = 0; n < 2; ++n) bv[bj][n] = *(const f32x4*)(bias + pn * 256 + bj * 128 + lc + 4 * n);
        hc += lc;
        if (mode == 3) {
#pragma unroll
            for (int ai = 0; ai < 2; ++ai)
#pragma unroll
                for (int m = 0; m < 4; ++m) { bf16_t* rowp = H + (size_t)(row0 + ai * 128 + m * 16) * ld + hc;
                    const f32x4 a0 = acc[ai][0][m][0] + bv[0][0], a1 = acc[ai][0][m][1] + bv[0][1], g0 = acc[ai][1][m][0] + bv[1][0], g1 = acc[ai][1][m][1] + bv[1][1];
                    *(u32x4*)rowp = pack8(a0 * sig4(g0), a1 * sig4(g1)); }
        } else if (mode == 0) body<0>(acc, bv, row0, hc, ld);
        else if (mode == 1) body<1>(acc, bv, row0, hc, ld);
        else body<2>(acc, bv, row0, hc, ld);
    }
};
struct EpiFnet {
    bf16_t* H;
    __device__ __forceinline__ void operator()(AccRef acc, const Unit& u, int wr, int wc, int fr, int fq) const {
        const float sc = (u.pm < 64) ? 0.001953125f   : 0.0009765625f  ;
        const int row0 = u.pm * 256 + wr * 64 + fr, c0 = 512 + u.pn * 256 + wc * 32 + 8 * fq;
#pragma unroll
        for (int ai = 0; ai < 2; ++ai) {
            u32x4 zw[4][2];
#pragma unroll
            for (int m = 0; m < 4; ++m)
#pragma unroll
                for (int bj = 0; bj < 2; ++bj) zw[m][bj] = *(const u32x4*)(H + SEG_F + (size_t)(row0 + ai * 128 + m * 16) * LDF + c0 + bj * 128);
#pragma unroll
            for (int m = 0; m < 4; ++m) { bf16_t* rowp = H + SEG_F + (size_t)(row0 + ai * 128 + m * 16) * LDF + c0;
#pragma unroll
                for (int bj = 0; bj < 2; ++bj) { f32x4 z0, z1; unpack8(zw[m][bj], z0, z1);
                    *(u32x4*)(rowp + bj * 128) = pack8(acc[ai][bj][m][0] * sc * z0, acc[ai][bj][m][1] * sc * z1); } }
            asm volatile("" ::: "memory");
        }
    }
};
struct EpiMerge {
    bf16_t* MRG; const bf16_t* gate; int first;
    __device__ __forceinline__ void operator()(AccRef acc, const Unit& u, int wr, int wc, int fr, int fq) const {
        const int row0 = u.pm * 256 + wr * 64 + fr, c0 = u.pn * 256 + wc * 32 + 8 * fq;
#pragma unroll
        for (int ai = 0; ai < 2; ++ai)
#pragma unroll
        for (int mh = 0; mh < 4; mh += 2) {
            u32x4 gw[2][2], pw[2][2];
#pragma unroll
            for (int mm = 0; mm < 2; ++mm)
#pragma unroll
                for (int bj = 0; bj < 2; ++bj) { const size_t row = (size_t)(row0 + ai * 128 + (mh + mm) * 16);
                    gw[mm][bj] = *(const u32x4*)(gate + row * LDG + c0 + bj * 128);
                    pw[mm][bj] = first ? (u32x4){0u, 0u, 0u, 0u} : *(const u32x4*)(MRG + row * DM + c0 + bj * 128); }
#pragma unroll
            for (int mm = 0; mm < 2; ++mm) { const int m = mh + mm; bf16_t* mp = MRG + (size_t)(row0 + ai * 128 + m * 16) * DM + c0;
#pragma unroll
                for (int bj = 0; bj < 2; ++bj) { f32x4 g0, g1, p0, p1; unpack8(gw[mm][bj], g0, g1); unpack8(pw[mm][bj], p0, p1);
                    *(u32x4*)(mp + bj * 128) = pack8(g0 * acc[ai][bj][m][0] + p0, g1 * acc[ai][bj][m][1] + p1); } }
            asm volatile("" ::: "memory");
        }
    }
};
struct EpiOut {
    float* X; const float* bias; const float* lng; bf16_t* YG; float* stats;
    __device__ __forceinline__ void operator()(AccRef acc, const Unit& u, int wr, int wc, int fr, int fq) const {
        const int row0 = u.pm * 256 + wr * 64 + fr, c0 = u.pn * 256 + wc * 32 + 8 * fq;
#pragma unroll
        for (int bj = 0; bj < 2; ++bj) {
            const f32x4 bv0 = *(const f32x4*)(bias + c0 + bj * 128), bv1 = *(const f32x4*)(bias + c0 + bj * 128 + 4), gv0 = *(const f32x4*)(lng + c0 + bj * 128), gv1 = *(const f32x4*)(lng + c0 + bj * 128 + 4);
#pragma unroll
            for (int ai = 0; ai < 2; ++ai)
#pragma unroll
            for (int mh = 0; mh < 4; mh += 2) {
                f32x4 xv[4][2];
#pragma unroll
                for (int m = mh; m < mh + 2; ++m)
#pragma unroll
                    for (int n = 0; n < 2; ++n) xv[m][n] = *(const f32x4*)(X + (size_t)(row0 + ai * 128 + m * 16) * DM + c0 + bj * 128 + 4 * n);
#pragma unroll
                for (int m = mh; m < mh + 2; ++m) { const int row = row0 + ai * 128 + m * 16; float* xp = X + (size_t)row * DM + c0 + bj * 128; bf16_t* yp = YG + (size_t)row * DM + c0 + bj * 128;
                    const f32x4 y0 = xv[m][0] * DN_ALPHA + acc[ai][bj][m][0] + bv0, y1 = xv[m][1] * DN_ALPHA + acc[ai][bj][m][1] + bv1;
                    *(f32x4*)xp = y0; *(f32x4*)(xp + 4) = y1;
                    *(u32x4*)yp = pack8(y0 * gv0, y1 * gv1);
                    float sm = (y0[0] + y0[1]) + (y0[2] + y0[3]) + (y1[0] + y1[1]) + (y1[2] + y1[3]);
                    float sq = (y0[0] * y0[0] + y0[1] * y0[1]) + (y0[2] * y0[2] + y0[3] * y0[3]) + (y1[0] * y1[0] + y1[1] * y1[1]) + (y1[2] * y1[2] + y1[3] * y1[3]);
                    sm += __shfl_xor(sm, 16); sq += __shfl_xor(sq, 16); sm += __shfl_xor(sm, 32); sq += __shfl_xor(sq, 32);
                    if (fq == 0) { (void)__hip_atomic_fetch_add(stats + 2 * row, sm, __ATOMIC_RELAXED, __HIP_MEMORY_SCOPE_AGENT); (void)__hip_atomic_fetch_add(stats + 2 * row + 1, sq, __ATOMIC_RELAXED, __HIP_MEMORY_SCOPE_AGENT); } }
                asm volatile("" ::: "memory");
            }
        }
    }
};
struct EpiPlain {
    bf16_t* O;
    __device__ __forceinline__ void operator()(AccRef acc, const Unit& u, int wr, int wc, int fr, int fq) const {
        const int row0 = u.pm * 256 + wr * 64 + fr, c0 = u.pn * 256 + wc * 32 + 8 * fq;
#pragma unroll
        for (int ai = 0; ai < 2; ++ai)
#pragma unroll
            for (int m = 0; m < 4; ++m) { bf16_t* op = O + (size_t)(row0 + ai * 128 + m * 16) * DM + c0;
#pragma unroll
                for (int bj = 0; bj < 2; ++bj) *(u32x4*)(op + bj * 128) = pack8(acc[ai][bj][m][0], acc[ai][bj][m][1]); }
    }
};
struct EpiGate {
    float* X; const float* cg; const float* cb; const float* lng; const float* lnb; const bf16_t* PLEB; bf16_t* XB; const float* stats;
    __device__ __forceinline__ void operator()(AccRef acc, const Unit& u, int wr, int wc, int fr, int fq) const {
        const int row0 = u.pm * 256 + wr * 64 + fr, c0 = u.pn * 256 + wc * 32 + 8 * fq;
#pragma unroll
        for (int bj = 0; bj < 2; ++bj) {
            const f32x4 g0 = *(const f32x4*)(lng + c0 + bj * 128), g1 = *(const f32x4*)(lng + c0 + bj * 128 + 4), b0 = *(const f32x4*)(lnb + c0 + bj * 128), b1 = *(const f32x4*)(lnb + c0 + bj * 128 + 4);
            const f32x4 cg0 = *(const f32x4*)(cg + c0 + bj * 128), cg1 = *(const f32x4*)(cg + c0 + bj * 128 + 4), cb0 = *(const f32x4*)(cb + c0 + bj * 128), cb1 = *(const f32x4*)(cb + c0 + bj * 128 + 4);
#pragma unroll
            for (int ai = 0; ai < 2; ++ai)
#pragma unroll
            for (int mh = 0; mh < 4; mh += 2) {
                u32x4 pw[4]; f32x4 yv[4][2]; f32x2 st[4];
#pragma unroll
                for (int m = mh; m < mh + 2; ++m) { const int row = row0 + ai * 128 + m * 16; const size_t ro = (size_t)row * DM + c0 + bj * 128;
                    pw[m] = *(const u32x4*)(PLEB + ro); yv[m][0] = *(const f32x4*)(X + ro); yv[m][1] = *(const f32x4*)(X + ro + 4); st[m] = *(const f32x2*)(stats + 2 * row); }
#pragma unroll
                for (int m = mh; m < mh + 2; ++m) { const int row = row0 + ai * 128 + m * 16; const size_t ro = (size_t)row * DM + c0 + bj * 128;
                    const float mu = st[m].x * (1.f / DM), var = st[m].y * (1.f / DM) - mu * mu, r = 1.f / sqrtf(var + LN_EPS);
                    f32x4 p0, p1; unpack8(pw[m], p0, p1);
                    const f32x4 x0 = (yv[m][0] - mu) * r * g0 + b0, x1 = (yv[m][1] - mu) * r * g1 + b1;
                    const f32x4 o0 = x0 + sig4((acc[ai][bj][m][0] - mu * cg0) * r + cb0) * p0, o1 = x1 + sig4((acc[ai][bj][m][1] - mu * cg1) * r + cb1) * p1;
                    *(f32x4*)(X + ro) = o0; *(f32x4*)(X + ro + 4) = o1; *(u32x4*)(XB + ro) = pack8(o0, o1); }
                asm volatile("" ::: "memory");
            }
        }
    }
};

struct Params { const float* in[25]; float* out; unsigned char* ws; int ph_lo, ph_hi; };
enum { I_XP = 0, I_XS, I_PP, I_PS, I_EG, I_EB, I_WIN, I_BIN, I_WF, I_WG, I_BG, I_PSC, I_WP, I_WDW, I_BDW, I_CG, I_CB, I_WC, I_WOUT, I_BOUT, I_LNG, I_LNB, I_WPLE, I_WPG, I_BPG };

__device__ __forceinline__ void seq_of_row(int row, int& base, int& S) {
    if (row < M_PROMPT) { S = 2048; base = row & ~2047; } else { S = 8192; base = M_PROMPT + ((row - M_PROMPT) & ~8191); }
}

__device__ __forceinline__ void ln_row(const float* src, float* dstf, bf16_t* dstb, const float* g, const float* b, int lane) {
    f32x4 v[8]; float s = 0.f;
#pragma unroll
    for (int j = 0; j < 8; ++j) { v[j] = ((const f32x4*)src)[lane + 64 * j]; s += (v[j][0] + v[j][1]) + (v[j][2] + v[j][3]); }
    const float mean = wave_sum(s) * (1.f / DM); float s2 = 0.f;
#pragma unroll
    for (int j = 0; j < 8; ++j) { v[j] = v[j] - mean; s2 += (v[j][0] * v[j][0] + v[j][1] * v[j][1]) + (v[j][2] * v[j][2] + v[j][3] * v[j][3]); }
    const float rstd = 1.f / sqrtf(wave_sum(s2) * (1.f / DM) + LN_EPS);
#pragma unroll
    for (int j = 0; j < 8; ++j) { const f32x4 gg = ((const f32x4*)g)[lane + 64 * j], bb = ((const f32x4*)b)[lane + 64 * j]; const f32x4 o = v[j] * rstd * gg + bb;
        ((f32x4*)dstf)[lane + 64 * j] = o; u32x2 w; w.x = cvt_pk_bf16(o[0], o[1]); w.y = cvt_pk_bf16(o[2], o[3]); ((u32x2*)dstb)[lane + 64 * j] = w; }
}

__device__ __forceinline__ void transpose_item(const float* W, int ldw, int col0, bf16_t* WT, int ldt, int row0, int k0, LAS float* scr, int lane) {
    { float wv[32];
#pragma unroll
    for (int i = 0; i < 32; ++i) { const int kk = 2 * i + (lane >> 5); wv[i] = W[(size_t)(k0 + kk) * ldw + col0 + (lane & 31)]; }
#pragma unroll
    for (int i = 0; i < 32; ++i) { const int kk = 2 * i + (lane >> 5); scr[kk * 33 + (lane & 31)] = wv[i]; } }
    LDS_WAIT();
    const int c = lane & 7;
#pragma unroll
    for (int j = 0; j < 4; ++j) { const int n = (lane >> 3) + 8 * j; const LAS float* s = scr + (8 * c) * 33 + n;
        u32x4 o; o.x = cvt_pk_bf16(s[0 * 33], s[1 * 33]); o.y = cvt_pk_bf16(s[2 * 33], s[3 * 33]); o.z = cvt_pk_bf16(s[4 * 33], s[5 * 33]); o.w = cvt_pk_bf16(s[6 * 33], s[7 * 33]);
        *(u32x4*)(WT + (size_t)(row0 + n) * ldt + k0 + 8 * c) = o; }
    LDS_WAIT();
}

__device__ __forceinline__ void fft_lds(LAS f32x2* X, const LAS f32x2* tw, int logR, int logCW, int tid) {
    const int CWm = (1 << logCW) - 1;
    for (int p = 0; p < logR; ++p) {
        const int lh = logR - 1 - p, half = 1 << lh;
#pragma unroll 4
        for (int it = 0; it < 16; ++it) {
            const int f = it * 512 + tid, c = f & CWm, j = f >> logCW, grp = j >> lh, pos = j & (half - 1);
            const int i0 = ((grp << (lh + 1)) + pos), i1 = i0 + half;
            const f32x2 a = X[(i0 << logCW) + c], b = X[(i1 << logCW) + c], w = tw[pos << p];
            const f32x2 d = a - b;
            X[(i0 << logCW) + c] = a + b;
            X[(i1 << logCW) + c] = (f32x2){d.x * w.x - d.y * w.y, d.x * w.y + d.y * w.x};
        }
        __syncthreads();
    }
}


#define XB_TMO      128
#define XB_XCNT(j)  (256  + 64 * (j))
#define XB_XSUB(j)  (1280 + 64 * (j))
#define XB_XGEN(j)  (2304 + 64 * (j))
#define XB_TOP      3328
#define XB_TOPGEN   3392
#define XCD_BAR_WORDS 3456
#define XB_SPIN_CAP (1u << 22)
__device__ __forceinline__ unsigned xb_ld(unsigned* p)              { return __hip_atomic_load(p, __ATOMIC_RELAXED, __HIP_MEMORY_SCOPE_AGENT); }
__device__ __forceinline__ unsigned xb_add(unsigned* p, unsigned v) { return __hip_atomic_fetch_add(p, v, __ATOMIC_RELAXED, __HIP_MEMORY_SCOPE_AGENT); }
__device__ __forceinline__ unsigned xb_xcc_id() { return (unsigned)__builtin_amdgcn_s_getreg((3 << 11) | 20) & 0xFu; }
#define XB_SPIN(cond, bar) do { unsigned _sp = 0; while (cond) { __builtin_amdgcn_s_sleep(1); \
    if ((++_sp & 255u) == 0u) { if (xb_ld(&(bar)[XB_TMO])) break; if (_sp > XB_SPIN_CAP) { atomicAdd(&(bar)[XB_TMO], 1u); break; } } } } while (0)
struct XcdBarrier { unsigned* bar; unsigned x; volatile LAS unsigned* st; };
__device__ __forceinline__ XcdBarrier xcd_barrier_post(unsigned* bar, volatile LAS unsigned* st) {
    XcdBarrier b; b.bar = bar; b.x = xb_xcc_id(); b.st = st;
    if (threadIdx.x == 0) (void)xb_add(&bar[XB_XCNT(b.x)], 1u);
    return b;
}
__device__ __forceinline__ void xcd_barrier_complete(unsigned* bar, unsigned x, unsigned& nloc, unsigned& nx) {
    const unsigned G = gridDim.x * gridDim.y * gridDim.z;
    unsigned sum, cnt, mine, sp = 0u;
    for (;;) {
        sum = 0u; cnt = 0u; mine = 0u;
#pragma unroll
        for (unsigned j = 0; j < 16; ++j) { const unsigned c = xb_ld(&bar[XB_XCNT(j)]); sum += c; cnt += (c > 0u) ? 1u : 0u; mine = (j == x) ? c : mine; }
        if (sum == G) break;
        __builtin_amdgcn_s_sleep(1);
        if ((++sp & 255u) == 0u) { if (xb_ld(&bar[XB_TMO])) break; if (sp > XB_SPIN_CAP) { atomicAdd(&bar[XB_TMO], 1u); break; } }
    }
    nloc = mine > 0u ? mine : 1u; nx = cnt > 0u ? cnt : 1u;
}
__device__ __forceinline__ void xcd_barrier(const XcdBarrier& b) {
    asm volatile("s_waitcnt vmcnt(0)" ::: "memory");
    __syncthreads();
    if (threadIdx.x == 0) {
        unsigned* bar = b.bar;
        __builtin_amdgcn_s_waitcnt(0);
        unsigned nloc = b.st[0], nx = b.st[1];
        if (nloc == 0u) { xcd_barrier_complete(bar, b.x, nloc, nx); b.st[0] = nloc; b.st[1] = nx; }
        const unsigned old = xb_add(&bar[XB_XSUB(b.x)], 1u);
        const unsigned gen = old / nloc;
        if (old + 1u == (gen + 1u) * nloc) {
            __builtin_amdgcn_fence(__ATOMIC_RELEASE, "agent");
            asm volatile("s_waitcnt vmcnt(0)" ::: "memory");
            const unsigned og = xb_add(&bar[XB_TOP], 1u);
            const unsigned tg = og / nx;
            if (og + 1u == (tg + 1u) * nx) xb_add(&bar[XB_TOPGEN], 1u);
            else XB_SPIN(xb_ld(&bar[XB_TOPGEN]) == tg, bar);
            __builtin_amdgcn_fence(__ATOMIC_ACQUIRE, "agent");
            xb_add(&bar[XB_XGEN(b.x)], 1u);
            asm volatile("s_waitcnt vmcnt(0)" ::: "memory");
        } else {
            XB_SPIN(xb_ld(&bar[XB_XGEN(b.x)]) == gen, bar);
            __builtin_amdgcn_fence(__ATOMIC_ACQUIRE, "agent");
            asm volatile("s_waitcnt vmcnt(0)" ::: "memory");
        }
    }
    __syncthreads();
}

typedef const __attribute__((address_space(4))) Params* KP;
__device__ __forceinline__ KP kparams() { unsigned long long k = (unsigned long long)__builtin_amdgcn_kernarg_segment_ptr(); asm volatile("" : "+s"(k)); return (KP)k; }
#define KARGS0 KP p = kparams(); unsigned char* ws = p->ws; \
    bf16_t* WT = (bf16_t*)(ws + OFF_WT); bf16_t* FC = (bf16_t*)(ws + OFF_FC); float* BIASP = (float*)(ws + OFF_BIAS); \
    bf16_t* H = (bf16_t*)(ws + OFF_H); bf16_t* MRG = (bf16_t*)(ws + OFF_MRG); bf16_t* XB = (bf16_t*)(ws + OFF_XB); f32x2* ZB = (f32x2*)(ws + OFF_XB); \
    bf16_t* XC = (bf16_t*)(ws + OFF_XC); bf16_t* PB = (bf16_t*)(ws + OFF_PB); float* PVF = (float*)(ws + OFF_PVF); \
    bf16_t* XN = (bf16_t*)(ws + OFF_XN); bf16_t* PLEB = (bf16_t*)(ws + OFF_PLEB); float* X = p->out; \
    float* CGB = (float*)(ws + OFF_CGB); float* STATS = (float*)(ws + OFF_STATS); \
    (void)WT; (void)FC; (void)BIASP; (void)H; (void)MRG; (void)XB; (void)ZB; (void)XC; (void)PB; (void)PVF; (void)XN; (void)PLEB; (void)X; (void)CGB; (void)STATS;
#define KARGS KARGS0 const bf16_t* wt = WT + (size_t)l * WT_LAYER; (void)wt;
__global__ void __launch_bounds__(512, 2) fwd_megakernel(Params p_) {
    extern __shared__ __attribute__((aligned(16))) unsigned char smem[];
    cg::grid_group grid = cg::this_grid();
    LAS unsigned char* lds = (LAS unsigned char*)smem;
    const int G = gridDim.x, bid = blockIdx.x;
    const int NGW = G * 8;
    const size_t NGT = (size_t)G * 512;
    volatile LAS unsigned* xst = (volatile LAS unsigned*)(lds + 131072 + 4000);
    if (threadIdx.x < 2) xst[threadIdx.x] = 0u;
    __syncthreads();
    const XcdBarrier xbar = xcd_barrier_post((unsigned*)(kparams()->ws + OFF_BAR), xst);

    if (PHM & 1)
    {
        TID_VARS
            KARGS0
        const float* w_in = p->in[I_WIN]; const float* wg = p->in[I_WG];
        for (int task = gw; task < DEPTH * 512 * 4; task += NGW) {
            const int g = task & 3, kb = (task >> 2) & 511, l = task >> 11;
            const float* a = w_in + ((size_t)l * DM + kb * 4) * NIN + 1024 + g * 256;
            const float* b = wg + ((size_t)(l * 4 + g) * 256) * 256 + 4 * lane;
            f32x4 acc0 = {0, 0, 0, 0}, acc1 = acc0, acc2 = acc0, acc3 = acc0;
#pragma unroll 8
            for (int c = 0; c < 256; ++c) { const f32x4 bv = *(const f32x4*)(b + (size_t)c * 256);
                acc0 += a[c] * bv; acc1 += a[NIN + c] * bv; acc2 += a[2 * NIN + c] * bv; acc3 += a[3 * NIN + c] * bv; }
            float* o = PVF + ((size_t)l * DM + kb * 4) * 1024 + g * 256 + 4 * lane;
            *(f32x4*)o = acc0; *(f32x4*)(o + 1024) = acc1; *(f32x4*)(o + 2048) = acc2; *(f32x4*)(o + 3072) = acc3;
        }
        const float* b_in = p->in[I_BIN];
        for (size_t e = gt; e < (size_t)DEPTH * NIN; e += NGT) {
            const int l = (int)(e / NIN), n = (int)(e % NIN); float v;
            if (n >= 1024 && n < 2048) v = 0.f;
            else if (n >= 3072 && n < 4096) { const int j = (n - 3072) >> 8, lc = (n - 3072) & 255; v = b_in[(size_t)l * NIN + (lc < 128 ? 3072 + j * 128 + lc : 3584 + j * 128 + (lc - 128))]; }
            else v = b_in[(size_t)l * NIN + n];
            BIASP[e] = v;
        }
        for (size_t e = gt; e < (size_t)512 * 1024; e += NGT) {
            const int r = (int)(e >> 10), q = (int)(e & 1023), g = r >> 7, d = r & 127, half = q >> 9, g2 = (q >> 7) & 3, c = q & 127;
            float v = 0.f;
            if (g == g2) { const float ang = (float)((c * d) & 127) * (1.0f / 64.0f); v = half ? sinpif(ang) : cospif(ang); }
            FC[e] = (bf16_t)(cvt_pk_bf16(v, 0.f) & 0xffffu);
        }
        for (size_t e = gt; e < (size_t)DEPTH * DM * 16; e += NGT) {
            const int kc = (int)(e / ((size_t)DEPTH * DM)), le = (int)(e % ((size_t)DEPTH * DM)), l = le / DM, col = le % DM;
            const float* w = p->in[I_WPG] + ((size_t)l * DM + kc * 128) * DM + col; const float* g = p->in[I_LNG] + l * DM + kc * 128; const float* b = p->in[I_LNB] + l * DM + kc * 128;
            float sg = 0.f, sb = (kc == 0) ? p->in[I_BPG][l * DM + col] : 0.f;
#pragma unroll 8
            for (int k = 0; k < 128; ++k) { const float wv = w[(size_t)k * DM]; sg += g[k] * wv; sb += b[k] * wv; }
            (void)__hip_atomic_fetch_add(CGB + ((size_t)l * 2 + 0) * DM + col, sg, __ATOMIC_RELAXED, __HIP_MEMORY_SCOPE_AGENT);
            (void)__hip_atomic_fetch_add(CGB + ((size_t)l * 2 + 1) * DM + col, sb, __ATOMIC_RELAXED, __HIP_MEMORY_SCOPE_AGENT);
        }
        for (int row = gw; row < M_TOK; row += NGW) {
            const float* src = row < M_PROMPT ? p->in[I_XP] + (size_t)row * DM : p->in[I_XS] + (size_t)(row - M_PROMPT) * DM;
            ln_row(src, X + (size_t)row * DM, XB + (size_t)row * DM, p->in[I_EG], p->in[I_EB], lane);
        }
    }
    CG_SYNC();
    if (PHM & 2)
    {
        TID_VARS
            KARGS0
        LAS float* scr = (LAS float*)(lds + wave * 16384);
        constexpr int IT_IN = 32 * 336, IT_F = 8 * 64, IT_P = 16 * 64, IT_C = 8 * 64, IT_OUT = 32 * 64, IT_PG = 32 * 64, IT_PLE = 4 * 64;
        constexpr int IT_LAYER = IT_IN + IT_F + IT_P + IT_C + IT_OUT + IT_PG + IT_PLE;
        for (int it = gw; it < DEPTH * IT_LAYER; it += NGW) {
            const int l = it / IT_LAYER; int r = it % IT_LAYER;
            bf16_t* wt = WT + (size_t)l * WT_LAYER;
            if (r < IT_IN) {
                const int kb = r / 336, nb = r % 336, n0 = nb * 32, k0 = kb * 64;
                const float* src = p->in[I_WIN] + (size_t)l * DM * NIN; int ldw = NIN, col0 = n0;
                if (n0 >= 1024 && n0 < 2048) { src = PVF + (size_t)l * DM * 1024; ldw = 1024; col0 = n0 - 1024; }
                else if (n0 >= 3072 && n0 < 4096) { const int j = (n0 - 3072) >> 8, lc = (n0 - 3072) & 255; col0 = lc < 128 ? 3072 + j * 128 + lc : 3584 + j * 128 + (lc - 128); }
                transpose_item(src, ldw, col0, wt + WT_IN, DM, n0, k0, scr, lane); continue; }
            r -= IT_IN;
            if (r < IT_F) { transpose_item(p->in[I_WF] + (size_t)l * 512 * DM, DM, (r % 64) * 32, wt + WT_F, 512, (r % 64) * 32, (r / 64) * 64, scr, lane); continue; }
            r -= IT_F;
            if (r < IT_P) { transpose_item(p->in[I_WP] + (size_t)l * 1024 * DM, DM, (r % 64) * 32, wt + WT_P, 1024, (r % 64) * 32, (r / 64) * 64, scr, lane); continue; }
            r -= IT_P;
            if (r < IT_C) { transpose_item(p->in[I_WC] + (size_t)l * 512 * DM, DM, (r % 64) * 32, wt + WT_C, 512, (r % 64) * 32, (r / 64) * 64, scr, lane); continue; }
            r -= IT_C;
            if (r < IT_OUT) { transpose_item(p->in[I_WOUT] + (size_t)l * DM * DM, DM, (r % 64) * 32, wt + WT_OUT, DM, (r % 64) * 32, (r / 64) * 64, scr, lane); continue; }
            r -= IT_OUT;
            if (r < IT_PG) { transpose_item(p->in[I_WPG] + (size_t)l * DM * DM, DM, (r % 64) * 32, wt + WT_PG, DM, (r % 64) * 32, (r / 64) * 64, scr, lane); continue; }
            r -= IT_PG;
            transpose_item(p->in[I_WPLE] + (size_t)l * PLE * DM, DM, (r % 64) * 32, wt + WT_PLE, PLE, (r % 64) * 32, (r / 64) * 64, scr, lane);
        }
    }
    GRID_SYNC();

    LAS f32x2* FX = (LAS f32x2*)lds;
    LAS f32x2* TW = (LAS f32x2*)(lds + 131072);
    LAS f32x2* TW2 = (LAS f32x2*)(lds + 131072 + 2048);

    for (int l = 0; l < DEPTH; ++l) {
        if (PHM & 4)
        {
            TID_VARS
            KARGS
            pg8::Gemm g{XB, wt + WT_IN, M_TOK, NIN, DM, DM, DM}; pg8::StaticOrder S; S.init(M_TOK, NIN, G, bid);
            EpiIn E{H, BIASP + (size_t)l * NIN};
            pg8::gemm_phase(lds, g, S, E, tid);
        }
        GRID_SYNC();
        if (PHM & 8)
        {
            TID_VARS
            KARGS
            if (tid < 16) { const float ang = (float)tid * (1.0f / 16.0f); TW[tid] = (f32x2){cospif(ang), -sinpif(ang)}; }
            for (int t = bid; t < 1024; t += G) {
                int base, n1, S1, lS;
                if (t < 512) { base = (t >> 6) * 2048; n1 = t & 63; S1 = 64; lS = 11; } else { const int tt = t - 512; base = M_PROMPT + (tt >> 8) * 8192; n1 = tt & 255; S1 = 256; lS = 13; }
                __syncthreads();
                if (tid < 32) { const int k2 = (int)(__brev((unsigned)tid) >> 27); const float ang = (float)((k2 * n1) & ((1 << lS) - 1)) * (2.0f / (float)(1 << lS)); TW2[tid] = (f32x2){cospif(ang), -sinpif(ang)}; }
                { bf16_t hv[32];
#pragma unroll
                for (int n2 = 0; n2 < 32; ++n2) hv[n2] = H[SEG_F + (size_t)(base + n1 + S1 * n2) * LDF + tid];
#pragma unroll
                for (int n2 = 0; n2 < 32; ++n2) FX[n2 * 512 + tid] = (f32x2){bf1(hv[n2]), 0.f}; }
                __syncthreads();
                fft_lds(FX, TW, 5, 9, tid);
#pragma unroll 8
                for (int i2 = 0; i2 < 32; ++i2) { const int k2 = (int)(__brev((unsigned)i2) >> 27); const f32x2 z = FX[i2 * 512 + tid], w = TW2[i2];
                    ZB[(size_t)(base + k2 * S1 + n1) * 512 + tid] = (f32x2){z.x * w.x - z.y * w.y, z.x * w.y + z.y * w.x}; }
            }
            __syncthreads();
            {
                LAS float* WD = (LAS float*)lds;
                LAS unsigned char* VT = lds + 63488;
                const float* wdw = p->in[I_WDW] + (size_t)l * 31 * 512;
                for (int e = tid; e < 31 * 512; e += 512) WD[e] = wdw[e];
                const float* bdw = p->in[I_BDW] + l * 512 + 8 * lane; const float* cg_ = p->in[I_CG] + l * 512 + 8 * lane; const float* cb_ = p->in[I_CB] + l * 512 + 8 * lane;
                const f32x4 bd0 = *(const f32x4*)bdw, bd1 = *(const f32x4*)(bdw + 4), lg0 = *(const f32x4*)cg_, lg1 = *(const f32x4*)(cg_ + 4), lb0 = *(const f32x4*)cb_, lb1 = *(const f32x4*)(cb_ + 4);
                for (int rb = bid; rb < M_TOK / 128; rb += G)
                for (int c = 0; c < 4; ++c) {
                    const int R0 = rb * 128 + 32 * c; int base, S; seq_of_row(R0, base, S); const int t0 = R0 - base;
                    __syncthreads();
#pragma unroll
                    for (int it = 0; it < 8; ++it) { const int idx = it * 512 + tid; if (idx < 62 * 64) { const int q = idx >> 6, c16 = idx & 63, tt = t0 - 15 + q;
                        u32x4 v = {0u, 0u, 0u, 0u}; if (tt >= 0 && tt < S) v = *(const u32x4*)(H + SEG_C + (size_t)(base + tt) * LDC + c16 * 8);
                        *(LAS u32x4*)(VT + q * 1024 + c16 * 16) = v; } }
                    __syncthreads();
                    for (int i = wave; i < 32; i += 8) {
                        bf16_t* zp = H + SEG_C + (size_t)(R0 + i) * LDC + 512 + 8 * lane;
                        const u32x4 zw = *(const u32x4*)zp;
                        f32x4 a0 = bd0, a1 = bd1;
#pragma unroll 4
                        for (int j = 0; j < 31; ++j) {
                            f32x4 v0, v1; unpack8(*(const LAS u32x4*)(VT + (i + j) * 1024 + lane * 16), v0, v1);
                            const f32x4 w0 = *(const LAS f32x4*)(WD + j * 512 + 8 * lane), w1 = *(const LAS f32x4*)(WD + j * 512 + 8 * lane + 4);
                            a0 += w0 * v0; a1 += w1 * v1;
                        }
                        const float mean = wave_sum((a0[0] + a0[1]) + (a0[2] + a0[3]) + (a1[0] + a1[1]) + (a1[2] + a1[3])) * (1.f / 512.f);
                        a0 = a0 - mean; a1 = a1 - mean;
                        const float var = wave_sum((a0[0] * a0[0] + a0[1] * a0[1]) + (a0[2] * a0[2] + a0[3] * a0[3]) + (a1[0] * a1[0] + a1[1] * a1[1]) + (a1[2] * a1[2] + a1[3] * a1[3])) * (1.f / 512.f);
                        const float rstd = 1.f / sqrtf(var + LN_EPS);
                        f32x4 y0 = a0 * rstd * lg0 + lb0, y1 = a1 * rstd * lg1 + lb1;
                        f32x4 z0, z1; unpack8(zw, z0, z1);
                        *(u32x4*)zp = pack8(silu4(y0) * z0, silu4(y1) * z1);
                    }
                }
            }
            {
                const float* bg = p->in[I_BG] + l * 1024; const float* psc = p->in[I_PSC] + l * 1024;
                for (int rb = bid; rb < M_TOK / 128; rb += G) {
                const int R0 = rb * 128; int base, S; seq_of_row(R0, base, S); const int t0 = R0 - base;
                for (int g = 0; g < 4; ++g) {
                    const int hw = 1 << g, NR = 128 + 2 * hw;
                    __syncthreads();
                    for (int idx = tid; idx < NR * 32; idx += 512) { const int q = idx >> 5, c16 = idx & 31, tt = t0 - hw + q;
                        u32x4 v = {0u, 0u, 0u, 0u}; if (tt >= 0 && tt < S) v = *(const u32x4*)(H + SEG_P + (size_t)(base + tt) * LDP + g * 256 + c16 * 8);
                        *(LAS u32x4*)(lds + q * 512 + c16 * 16) = v; }
                    __syncthreads();
                    u32x4 zws[8];
#pragma unroll
                    for (int k = 0; k < 8; ++k) { const int o = k * 512 + tid, r = o >> 5, chl = o & 31, ch = g * 32 + chl; zws[k] = *(const u32x4*)(H + SEG_P + (size_t)(R0 + r) * LDP + 1024 + ch * 8); }
                    const int chl_ = tid & 31, ch_ = g * 32 + chl_;
                    const f32x4 b0 = *(const f32x4*)(bg + ch_ * 8), b1 = *(const f32x4*)(bg + ch_ * 8 + 4), q0 = *(const f32x4*)(psc + ch_ * 8), q1 = *(const f32x4*)(psc + ch_ * 8 + 4);
#pragma unroll
                    for (int k = 0; k < 8; ++k) {
                        const int o = k * 512 + tid, r = o >> 5, chl = o & 31, t = t0 + r, ch = g * 32 + chl;
                        bf16_t* zp = H + SEG_P + (size_t)(R0 + r) * LDP + 1024 + ch * 8;
                        f32x4 s0 = {0, 0, 0, 0}, s1 = s0;
                        for (int kk = 0; kk < 2 * hw; ++kk) { f32x4 v0, v1; unpack8(*(const LAS u32x4*)(lds + (r + kk) * 512 + chl * 16), v0, v1); s0 += v0; s1 += v1; }
                        f32x4 c0, c1; unpack8(*(const LAS u32x4*)(lds + (r + hw) * 512 + chl * 16), c0, c1);
                        const float inv = 1.0f / (float)(min(t + hw, S) - max(t - hw, 0));
                        f32x4 z0, z1; unpack8(zws[k], z0, z1);
                        *(u32x4*)zp = pack8(((s0 * inv - c0) + b0) * q0 * z0, ((s1 * inv - c1) + b1) * q1 * z1);
                    }
                }
                }
            }
            {
                for (size_t e = gt; e < (size_t)M_TOK * 2; e += NGT) STATS[e] = 0.f;
                const float* pp = p->in[I_PP] + (size_t)l * M_PROMPT * PLE; const float* ps = p->in[I_PS] + (size_t)l * M_PROMPT * PLE;
#pragma unroll 4
                for (size_t e = gt; e < (size_t)M_TOK * PLE / 8; e += NGT) {
                    const size_t o = e * 8; const float* src = o < (size_t)M_PROMPT * PLE ? pp + o : ps + (o - (size_t)M_PROMPT * PLE);
                    *(u32x4*)(PB + o) = pack8(*(const f32x4*)src, *(const f32x4*)(src + 4));
                }
            }
        }
        GRID_SYNC();
        if (PHM & 16)
        {
            TID_VARS
            KARGS
            for (int t = bid; t < 1024; t += G) {
                int base, k2, cc, lR, lCW;
                if (t < 512) { base = (t >> 6) * 2048; const int rem = t & 63; k2 = rem >> 1; cc = rem & 1; lR = 6; lCW = 8; }
                else { const int tt = t - 512; base = M_PROMPT + (tt >> 8) * 8192; const int rem = tt & 255; k2 = rem >> 3; cc = rem & 7; lR = 8; lCW = 6; }
                const int R = 1 << lR, CWm = (1 << lCW) - 1;
                __syncthreads();
                if (tid < (R >> 1)) { const float ang = (float)tid * (2.0f / (float)R); TW[tid] = (f32x2){cospif(ang), -sinpif(ang)}; }
                const f32x2* zsrc = ZB + (size_t)(base + k2 * R) * 512 + (cc << lCW);
#pragma unroll
                for (int ih = 0; ih < 32; ih += 16) { f32x2 zv[16];
#pragma unroll
                    for (int it = 0; it < 16; ++it) { const int f = (ih + it) * 512 + tid, c = f & CWm, n1 = f >> lCW; zv[it] = zsrc[(size_t)n1 * 512 + c]; }
#pragma unroll
                    for (int it = 0; it < 16; ++it) FX[(ih + it) * 512 + tid] = zv[it]; }
                __syncthreads();
                fft_lds(FX, TW, lR, lCW, tid);
#pragma unroll 8
                for (int it = 0; it < 32; ++it) { const int f = it * 512 + tid, c = f & CWm, i1 = f >> lCW; const int k1 = (int)(__brev((unsigned)i1) >> (32 - lR));
                    const f32x2 z = FX[f]; bf16_t* o = XC + (size_t)(base + k2 + 32 * k1) * 1024 + (cc << lCW) + c;
                    o[0] = (bf16_t)(cvt_pk_bf16(z.x, 0.f) & 0xffffu); o[512] = (bf16_t)(cvt_pk_bf16(z.y, 0.f) & 0xffffu); }
            }
            __syncthreads();
            { const int tid = opaque_tid(); pg8::Gemm g{H + SEG_P + 1024, wt + WT_P, M_TOK, DM, 1024, LDP, 1024}; pg8::StaticOrder S; S.init(M_TOK, DM, G, bid);
              EpiMerge E{MRG, H + SEG_G + (size_t)M_TOK * LDG, 1}; pg8::gemm_phase(lds, g, S, E, tid); }
            { const int tid = opaque_tid(); pg8::Gemm g{H + SEG_C + 512, wt + WT_C, M_TOK, DM, 512, LDC, 512}; pg8::StaticOrder S; S.init(M_TOK, DM, G, bid);
              EpiMerge E{MRG, H + SEG_G + (size_t)2 * M_TOK * LDG, 0}; pg8::gemm_phase(lds, g, S, E, tid); }
        }
        GRID_SYNC();
        if (PHM & 32)
        {
            TID_VARS
            KARGS
            pg8::Gemm g{XC, FC, M_TOK, 512, 1024, 1024, 1024}; pg8::StaticOrder S; S.init(M_TOK, 512, G, bid);
            EpiFnet E{H}; pg8::gemm_phase(lds, g, S, E, tid);
        }
        GRID_SYNC();
        if (PHM & 64)
        {
            TID_VARS
            KARGS
            pg8::Gemm g{H + SEG_F + 512, wt + WT_F, M_TOK, DM, 512, LDF, 512}; pg8::StaticOrder S; S.init(M_TOK, DM, G, bid);
            EpiMerge E{MRG, H + SEG_G, 0}; pg8::gemm_phase(lds, g, S, E, tid);
        }
        GRID_SYNC();
        if (PHM & 128)
        {
            TID_VARS
            KARGS
            { const int tid = opaque_tid(); pg8::Gemm g{MRG, wt + WT_OUT, M_TOK, DM, DM, DM, DM}; pg8::StaticOrder S; S.init(M_TOK, DM, G, bid);
              EpiOut E{X, p->in[I_BOUT] + (size_t)l * DM, p->in[I_LNG] + (size_t)l * DM, XN, STATS}; pg8::gemm_phase(lds, g, S, E, tid); }
            { const int tid = opaque_tid(); pg8::Gemm g{PB, wt + WT_PLE, M_TOK, DM, PLE, PLE, PLE}; pg8::StaticOrder S; S.init(M_TOK, DM, G, bid);
              EpiPlain E{PLEB}; pg8::gemm_phase(lds, g, S, E, tid); }
        }
        GRID_SYNC();
        if (PHM & 512)
        {
            TID_VARS
            KARGS
            pg8::Gemm g{XN, wt + WT_PG, M_TOK, DM, DM, DM, DM}; pg8::StaticOrder S; S.init(M_TOK, DM, G, bid);
            EpiGate E{X, CGB + ((size_t)l * 2 + 0) * DM, CGB + ((size_t)l * 2 + 1) * DM, p->in[I_LNG] + (size_t)l * DM, p->in[I_LNB] + (size_t)l * DM, PLEB, XB, STATS}; pg8::gemm_phase(lds, g, S, E, tid);
        }
        if (l + 1 < DEPTH) GRID_SYNC();
    }
}

extern "C" void kernel_launch(void* const* d_in, const int* in_sizes, int n_in, void* d_out, int out_size, void* d_ws, size_t ws_size, hipStream_t stream) {
    static int grid_blocks = 0;
    if (grid_blocks == 0) {
        if (n_in != 25 || out_size != M_TOK * DM || ws_size < WS_END2) { fprintf(stderr, "kernel_launch: unexpected shapes: n_in %d out %d ws %zu (need %zu)\n", n_in, out_size, ws_size, (size_t)WS_END2); grid_blocks = -1; return; }
        int dev = 0, cus = 0, per_cu = 0;
        hipGetDevice(&dev);
        hipDeviceGetAttribute(&cus, hipDeviceAttributeMultiprocessorCount, dev);
        if (hipFuncSetAttribute((const void*)fwd_megakernel, hipFuncAttributeMaxDynamicSharedMemorySize, LDS_BYTES) != hipSuccess) { fprintf(stderr, "kernel_launch: hipFuncSetAttribute failed\n"); grid_blocks = -1; return; }
        hipOccupancyMaxActiveBlocksPerMultiprocessor(&per_cu, (const void*)fwd_megakernel, 512, LDS_BYTES);
        if (per_cu < 1) { fprintf(stderr, "kernel_launch: occupancy query says %d blocks per CU\n", per_cu); per_cu = 1; }
        (void)hipGetLastError();
        grid_blocks = cus;
    }
    if (grid_blocks < 0) return;
    if (hipMemsetAsync((char*)d_ws + OFF_BAR, 0, 16384 + (size_t)DEPTH * 2 * DM * 4, stream) != hipSuccess) { fprintf(stderr, "kernel_launch: memset failed\n"); return; }
    Params p{};
    for (int i = 0; i < 25; ++i) p.in[i] = (const float*)d_in[i];
    p.out = (float*)d_out; p.ws = (unsigned char*)d_ws; p.ph_lo = 0; p.ph_hi = 1000;
    void* args[] = {&p};
    hipError_t e = hipLaunchCooperativeKernel((const void*)fwd_megakernel, dim3(grid_blocks), dim3(512), args, LDS_BYTES, stream);
    if (e != hipSuccess) fprintf(stderr, "cooperative launch failed: %s (grid %d)\n", hipGetErrorString(e), grid_blocks);
}
```

```cpp
#include <hip/hip_runtime.h>
#include <hip/hip_cooperative_groups.h>
#include <cstdio>
namespace cg = cooperative_groups;

#define LAS __attribute__((address_space(3)))
typedef unsigned short bf16_t;
typedef short bf16x8 __attribute__((ext_vector_type(8)));
typedef float f32x4 __attribute__((ext_vector_type(4)));
typedef float f32x2 __attribute__((ext_vector_type(2)));
typedef unsigned u32x4 __attribute__((ext_vector_type(4)));
typedef unsigned u32x2 __attribute__((ext_vector_type(2)));

constexpr int M_TOK = 32768, M_PROMPT = 16384, DM = 2048, NIN = 10752, LDH = 10240, DEPTH = 4, PLE = 256;
constexpr size_t SEG_F = 0, SEG_P = SEG_F + (size_t)M_TOK * 1024, SEG_C = SEG_P + (size_t)M_TOK * 2048, SEG_G = SEG_C + (size_t)M_TOK * 1024;
constexpr int LDF = 1024, LDP = 2048, LDC = 1024, LDG = 2048;
constexpr float LN_EPS = 1e-5f;
constexpr float DN_ALPHA = 1.6817928305074290f;
constexpr size_t WT_IN = 0, WT_F = (size_t)NIN * DM, WT_P = WT_F + (size_t)DM * 512, WT_C = WT_P + (size_t)DM * 1024, WT_OUT = WT_C + (size_t)DM * 512,
                 WT_PG = WT_OUT + (size_t)DM * DM, WT_PLE = WT_PG + (size_t)DM * DM, WT_LAYER = WT_PLE + (size_t)DM * PLE;
constexpr size_t OFF_WT = 0;
constexpr size_t OFF_FC = OFF_WT + (size_t)DEPTH * WT_LAYER * 2;
constexpr size_t OFF_BIAS = OFF_FC + (size_t)512 * 1024 * 2;
constexpr size_t OFF_H = OFF_BIAS + (size_t)DEPTH * NIN * 4;
constexpr size_t OFF_MRG = OFF_H + (size_t)M_TOK * LDH * 2;
constexpr size_t OFF_XB = OFF_MRG + (size_t)M_TOK * DM * 2;
constexpr size_t OFF_XC = OFF_XB + (size_t)M_TOK * DM * 2;
constexpr size_t OFF_PB = OFF_XC + (size_t)M_TOK * 1024 * 2;
constexpr size_t WS_END = OFF_PB + (size_t)M_TOK * PLE * 2;
constexpr size_t OFF_BAR = WS_END;
constexpr size_t OFF_CGB = OFF_BAR + 16384;
constexpr size_t OFF_STATS = OFF_CGB + (size_t)DEPTH * 2 * DM * 4;
constexpr size_t WS_END2 = OFF_STATS + (size_t)M_TOK * 2 * 4;
constexpr size_t OFF_PVF = OFF_H;
constexpr size_t OFF_XN = OFF_H;
constexpr size_t OFF_PLEB = OFF_H + (size_t)M_TOK * DM * 2;
static_assert(OFF_FC % 256 == 0 && OFF_BIAS % 256 == 0 && OFF_H % 256 == 0 && OFF_MRG % 256 == 0 && OFF_XB % 256 == 0 && OFF_XC % 256 == 0 && OFF_PB % 256 == 0, "align");

constexpr int LDS_BYTES = 131072 + 4096;
#ifndef PHM
#define PHM 0xFFFF
#endif

typedef __bf16 bf16x2_t __attribute__((ext_vector_type(2)));
__device__ __forceinline__ unsigned cvt_pk_bf16(float lo, float hi) { f32x2 v = {lo, hi}; bf16x2_t b = __builtin_convertvector(v, bf16x2_t); return __builtin_bit_cast(unsigned, b); }
__device__ __forceinline__ float bf_lo(unsigned w) { return __uint_as_float(w << 16); }
__device__ __forceinline__ float bf_hi(unsigned w) { return __uint_as_float(w & 0xffff0000u); }
__device__ __forceinline__ float bf1(bf16_t h) { return __uint_as_float(((unsigned)h) << 16); }
__device__ __forceinline__ float sigmoidf_(float x) { return __builtin_amdgcn_rcpf(1.0f + __expf(-x)); }
__device__ __forceinline__ f32x4 sig4(f32x4 v) { return (f32x4){sigmoidf_(v[0]), sigmoidf_(v[1]), sigmoidf_(v[2]), sigmoidf_(v[3])}; }
__device__ __forceinline__ f32x4 silu4(f32x4 v) { return v * sig4(v); }
__device__ __forceinline__ void unpack8(u32x4 w, f32x4& a, f32x4& b) { a = (f32x4){bf_lo(w.x), bf_hi(w.x), bf_lo(w.y), bf_hi(w.y)}; b = (f32x4){bf_lo(w.z), bf_hi(w.z), bf_lo(w.w), bf_hi(w.w)}; }
__device__ __forceinline__ u32x4 pack8(f32x4 a, f32x4 b) { u32x4 w; w.x = cvt_pk_bf16(a[0], a[1]); w.y = cvt_pk_bf16(a[2], a[3]); w.z = cvt_pk_bf16(b[0], b[1]); w.w = cvt_pk_bf16(b[2], b[3]); return w; }
__device__ __forceinline__ float wave_sum(float v) {
#pragma unroll
    for (int o = 1; o < 64; o <<= 1) v += __shfl_xor(v, o);
    return v;
}
__device__ __forceinline__ int opaque_tid() { int t = threadIdx.x; asm volatile("" : "+v"(t)); return t; }
#define TID_VARS const int tid = opaque_tid(), lane = tid & 63, wave = __builtin_amdgcn_readfirstlane(tid >> 6); const int gw = bid * 8 + wave; const size_t gt = (size_t)bid * 512 + tid; (void)lane; (void)gw; (void)gt;
#define CG_SYNC() do { asm volatile("s_waitcnt vmcnt(0) lgkmcnt(0)" ::: "memory"); grid.sync(); asm volatile("" ::: "memory"); } while (0)
#define GRID_SYNC() do { asm volatile("" ::: "memory"); xcd_barrier(xbar); asm volatile("" ::: "memory"); } while (0)
#define LDS_WAIT() asm volatile("s_waitcnt lgkmcnt(0)" ::: "memory")

namespace pg8 {
constexpr int BM = 256, BK = 64, HALF = 128, HTB = HALF * BK * 2, NXCD = 8, WGM = 4;
__device__ __forceinline__ int lds_byte(int r, int c) { const int st = (r >> 4) * 2 + (c >> 5), rr = r & 15, cc = c & 31, ob = rr * 64 + cc * 2; return st * 1024 + (ob ^ (((ob >> 9) & 1) << 5)); }
__device__ __forceinline__ void stage_rc(int b, int& R, int& C) { const int st = b / 1024, sb = b % 1024, swz = sb ^ (((sb >> 9) & 1) << 5); R = (st >> 1) * 16 + swz / 64; C = (st & 1) * 32 + (swz % 64) / 2; }
__device__ __forceinline__ int perm32(int rho) { const int n = rho >> 4, i = rho & 15; return 8 * (i >> 2) + 4 * n + (i & 3); }
struct Unit { int pm, pn; };
struct Gemm { const bf16_t* A; const bf16_t* Bt; int M, N, K, lda, ldb; };
struct StaticOrder {
    int nM, nN, nwg, G, c;
    __device__ void init(int M, int N, int G_, int c_) { nM = M / BM; nN = N / BM; nwg = nM * nN; G = G_; c = c_; }
    __device__ bool next(int i, Unit& u) const {
        const long L = (long)i * G + c; if (L >= nwg) return false;
        int wgid = (int)L; { const int q = nwg / NXCD, r = nwg % NXCD, xcd = wgid % NXCD, off = wgid / NXCD; wgid = (xcd < r ? xcd * (q + 1) : r * (q + 1) + (xcd - r) * q) + off; }
        const int nig = WGM * nN, gid = wgid / nig, fm = gid * WGM, gsz = (nM - fm) < WGM ? (nM - fm) : WGM;
        u.pm = fm + ((wgid % nig) % gsz); u.pn = (wgid % nig) / gsz; return true;
    }
};
template <class Epi>
__device__ __forceinline__ void gemm_phase(LAS unsigned char* lds, const Gemm g, const StaticOrder& S, const Epi& E, const int tid) {
    const int wid = __builtin_amdgcn_readfirstlane(tid >> 6), lane = tid & 63, wr = wid >> 2, wc = wid & 3, fr = lane & 15, fq = lane >> 4;
    const int K = g.K, nt = K / BK;
    unsigned voffA[2], voffB[2];
#pragma unroll
    for (int i = 0; i < 2; ++i) { int R, C; stage_rc(tid * 16 + i * 8192, R, C); const int Rb = (R & ~31) + perm32(R & 31);
        voffA[i] = (unsigned)(R * g.lda + C) * 2u; voffB[i] = (unsigned)(Rb * g.ldb + C) * 2u; }
    const size_t kstep = (size_t)(BK * 2);
    const size_t hstepA = (size_t)HALF * g.lda * 2, hstepB = (size_t)HALF * g.ldb * 2;
    const size_t tstepA = 2 * hstepA, tstepB = 2 * hstepB;
    const unsigned ldsw = (unsigned)wid * 1024u;
    const int aoff = lds_byte(wr * 64 + fr, fq * 8), boff = lds_byte(wc * 32 + fr, fq * 8);
#define PG8_SA(b, h) (((b) * 2 + (h)) * HTB)
#define PG8_SB(b, h) ((4 + (b) * 2 + (h)) * HTB)
#define PG8_STAGE(bufoff, gbase, voff) do { _Pragma("unroll") for (int _i = 0; _i < 2; ++_i) \
        __builtin_amdgcn_global_load_lds((const unsigned*)((const char*)(gbase) + (voff)[_i]), (LAS unsigned*)(lds + (bufoff) + ldsw + _i * 8192), 16, 0, 0); } while (0)
#define PG8_LDA(dst, b, h) do { _Pragma("unroll") for (int m = 0; m < 4; ++m) _Pragma("unroll") for (int k = 0; k < 2; ++k) dst[m][k] = *(const LAS bf16x8*)(lds + PG8_SA(b, h) + aoff + m * 2048 + k * 1024); } while (0)
#define PG8_LDB(dst, b, h) do { _Pragma("unroll") for (int n = 0; n < 2; ++n) _Pragma("unroll") for (int k = 0; k < 2; ++k) dst[n][k] = *(const LAS bf16x8*)(lds + PG8_SB(b, h) + boff + n * 2048 + k * 1024); } while (0)
#define PG8_MMA(ai, bj, At, Bt) do { __builtin_amdgcn_s_setprio(1); _Pragma("unroll") for (int m = 0; m < 4; ++m) _Pragma("unroll") for (int n = 0; n < 2; ++n) _Pragma("unroll") for (int k = 0; k < 2; ++k) \
        acc[ai][bj][m][n] = __builtin_amdgcn_mfma_f32_16x16x32_bf16(Bt[n][k], At[m][k], acc[ai][bj][m][n], 0, 0, 0); __builtin_amdgcn_s_setprio(0); } while (0)
#define PG8_WAIT_V(n) asm volatile("s_waitcnt vmcnt(" #n ")" ::: "memory")
#define PG8_WAIT_L(n) asm volatile("s_waitcnt lgkmcnt(" #n ")" ::: "memory")
#define PG8_BAR __builtin_amdgcn_s_barrier()
#define PG8_SCHED __builtin_amdgcn_sched_barrier(0)
    Unit cur, nxt; int ui = 0;
    if (!S.next(0, cur)) return;
    f32x4 acc[2][2][4][2];
#pragma unroll
    for (int a = 0; a < 2; ++a)
#pragma unroll
        for (int b = 0; b < 2; ++b)
#pragma unroll
            for (int m = 0; m < 4; ++m)
#pragma unroll
                for (int n = 0; n < 2; ++n) acc[a][b][m][n] = (f32x4){0.f, 0.f, 0.f, 0.f};
    bf16x8 At[4][2], B0[2][2], B1[2][2];
    const char* cA = (const char*)g.A + (size_t)cur.pm * tstepA; const char* cB = (const char*)g.Bt + (size_t)cur.pn * tstepB;
    PG8_STAGE(PG8_SB(0, 0), cB, voffB); PG8_STAGE(PG8_SA(0, 0), cA, voffA); PG8_STAGE(PG8_SB(0, 1), cB + hstepB, voffB); PG8_STAGE(PG8_SA(0, 1), cA + hstepA, voffA);
    if (wr == 1) PG8_BAR;
    PG8_WAIT_V(4); PG8_BAR;
    PG8_STAGE(PG8_SB(1, 0), cB + kstep, voffB); PG8_STAGE(PG8_SA(1, 0), cA + kstep, voffA); PG8_STAGE(PG8_SB(1, 1), cB + hstepB + kstep, voffB);
    PG8_WAIT_V(6); PG8_BAR;
    for (;;) {
        const bool has_next = S.next(ui + 1, nxt);
        const char* nA = has_next ? (const char*)g.A + (size_t)nxt.pm * tstepA : cA; const char* nB = has_next ? (const char*)g.Bt + (size_t)nxt.pn * tstepB : cB;
        for (int t = 0; t < nt; t += 2) {
            const bool last = (t == nt - 2);
            const char* a1 = cA + (size_t)(t + 1) * kstep;
            const char* a2 = last ? nA : cA + (size_t)(t + 2) * kstep; const char* b2 = last ? nB : cB + (size_t)(t + 2) * kstep;
            const char* a3 = a2 + kstep; const char* b3 = b2 + kstep;
            PG8_LDB(B0, 0, 0); PG8_SCHED; PG8_LDA(At, 0, 0); PG8_STAGE(PG8_SA(1, 1), a1 + hstepA, voffA);
            PG8_WAIT_L(8); PG8_BAR; PG8_WAIT_L(0); PG8_MMA(0, 0, At, B0); PG8_BAR; PG8_SCHED;
            PG8_LDB(B1, 0, 1); PG8_STAGE(PG8_SB(0, 0), b2, voffB);
            PG8_BAR; PG8_WAIT_L(0); PG8_MMA(0, 1, At, B1); PG8_BAR;
            PG8_LDA(At, 0, 1); PG8_STAGE(PG8_SA(0, 0), a2, voffA);
            PG8_BAR; PG8_WAIT_L(0); PG8_MMA(1, 0, At, B0); PG8_BAR; PG8_SCHED;
            PG8_STAGE(PG8_SB(0, 1), b2 + hstepB, voffB);
            PG8_WAIT_V(6); PG8_BAR; PG8_MMA(1, 1, At, B1); PG8_BAR;
            PG8_LDB(B0, 1, 0); PG8_SCHED; PG8_LDA(At, 1, 0); PG8_STAGE(PG8_SA(0, 1), a2 + hstepA, voffA);
            PG8_WAIT_L(8); PG8_BAR; PG8_WAIT_L(0); PG8_MMA(0, 0, At, B0); PG8_BAR; PG8_SCHED;
            PG8_LDB(B1, 1, 1); PG8_STAGE(PG8_SB(1, 0), b3, voffB);
            PG8_BAR; PG8_WAIT_L(0); PG8_MMA(0, 1, At, B1); PG8_BAR;
            PG8_LDA(At, 1, 1); PG8_STAGE(PG8_SA(1, 0), a3, voffA);
            PG8_BAR; PG8_WAIT_L(0); PG8_MMA(1, 0, At, B0); PG8_BAR; PG8_SCHED;
            PG8_STAGE(PG8_SB(1, 1), b3 + hstepB, voffB);
            PG8_WAIT_V(6); PG8_BAR; PG8_MMA(1, 1, At, B1); PG8_BAR;
        }
        E(acc, cur, wr, wc, fr, fq);
        if (!has_next) break;
#pragma unroll
        for (int a = 0; a < 2; ++a)
#pragma unroll
            for (int b = 0; b < 2; ++b)
#pragma unroll
                for (int m = 0; m < 4; ++m)
#pragma unroll
                    for (int n = 0; n < 2; ++n) acc[a][b][m][n] = (f32x4){0.f, 0.f, 0.f, 0.f};
        cur = nxt; cA = nA; cB = nB; ++ui;
    }
    PG8_WAIT_V(0);
    if (wr == 0) PG8_BAR;
    PG8_BAR;
#undef PG8_SA
#undef PG8_SB
#undef PG8_STAGE
#undef PG8_LDA
#undef PG8_LDB
#undef PG8_MMA
#undef PG8_WAIT_V
#undef PG8_WAIT_L
#undef PG8_BAR
#undef PG8_SCHED
}
}
using pg8::Unit;

typedef const f32x4 (&AccRef)[2][2][4][2];

struct EpiIn {
    bf16_t* H; const float* bias;
    template <int MODE> __device__ __forceinline__ void body(AccRef acc, const f32x4 (&bv)[2][2], int row0, size_t hc, int ld) const {
#pragma unroll
        for (int ai = 0; ai < 2; ++ai)
#pragma unroll
            for (int m = 0; m < 4; ++m) { bf16_t* rowp = H + (size_t)(row0 + ai * 128 + m * 16) * ld + hc;
#pragma unroll
                for (int bj = 0; bj < 2; ++bj) { f32x4 v0 = acc[ai][bj][m][0] + bv[bj][0], v1 = acc[ai][bj][m][1] + bv[bj][1];
                    if (MODE == 1) { v0 = silu4(v0); v1 = silu4(v1); }
                    if (MODE == 2) { v0 = sig4(v0); v1 = sig4(v1); }
                    *(u32x4*)(rowp + bj * 128) = pack8(v0, v1); } }
    }
    __device__ __forceinline__ void operator()(AccRef acc, const Unit& u, int wr, int wc, int fr, int fq) const {
        const int pn = u.pn; int mode, ld; size_t hc;
        if (pn < 2) { mode = 0; hc = SEG_F + pn * 256; ld = LDF; } else if (pn < 4) { mode = 1; hc = SEG_F + pn * 256; ld = LDF; }
        else if (pn < 8) { mode = 0; hc = SEG_P + (pn - 4) * 256; ld = LDP; } else if (pn < 12) { mode = 1; hc = SEG_P + (pn - 4) * 256; ld = LDP; }
        else if (pn < 16) { mode = 3; hc = SEG_C + (pn - 12) * 128; ld = LDC; } else if (pn < 18) { mode = 1; hc = SEG_C + 512 + (pn - 16) * 256; ld = LDC; }
        else { const int e = (pn - 18) * 256; mode = 2; hc = SEG_G + (size_t)(e >> 11) * M_TOK * LDG + (e & 2047); ld = LDG; }
        const int row0 = u.pm * 256 + wr * 64 + fr, lc = wc * 32 + 8 * fq;
        f32x4 bv[2][2];
#pragma unroll
        for (int bj = 0; bj < 2; ++bj)
#pragma unroll
            for (int n = 0; n < 2; ++n) bv[bj][n] = *(const f32x4*)(bias + pn * 256 + bj * 128 + lc + 4 * n);
        hc += lc;
        if (mode == 3) {
#pragma unroll
            for (int ai = 0; ai < 2; ++ai)
#pragma unroll
                for (int m = 0; m < 4; ++m) { bf16_t* rowp = H + (size_t)(row0 + ai * 128 + m * 16) * ld + hc;
                    const f32x4 a0 = acc[ai][0][m][0] + bv[0][0], a1 = acc[ai][0][m][1] + bv[0][1], g0 = acc[ai][1][m][0] + bv[1][0], g1 = acc[ai][1][m][1] + bv[1][1];
                    *(u32x4*)rowp = pack8(a0 * sig4(g0), a1 * sig4(g1)); }
        } else if (mode == 0) body<0>(acc, bv, row0, hc, ld);
        else if (mode == 1) body<1>(acc, bv, row0, hc, ld);
        else body<2>(acc, bv, row0, hc, ld);
    }
};
struct EpiFnet {
    bf16_t* H;
    __device__ __forceinline__ void operator()(AccRef acc, const Unit& u, int wr, int wc, int fr, int fq) const {
        const float sc = (u.pm < 64) ? 0.001953125f   : 0.0009765625f  ;
        const int row0 = u.pm * 256 + wr * 64 + fr, c0 = 512 + u.pn * 256 + wc * 32 + 8 * fq;
#pragma unroll
        for (int ai = 0; ai < 2; ++ai) {
            u32x4 zw[4][2];
#pragma unroll
            for (int m = 0; m < 4; ++m)
#pragma unroll
                for (int bj = 0; bj < 2; ++bj) zw[m][bj] = *(const u32x4*)(H + SEG_F + (size_t)(row0 + ai * 128 + m * 16) * LDF + c0 + bj * 128);
#pragma unroll
            for (int m = 0; m < 4; ++m) { bf16_t* rowp = H + SEG_F + (size_t)(row0 + ai * 128 + m * 16) * LDF + c0;
#pragma unroll
                for (int bj = 0; bj < 2; ++bj) { f32x4 z0, z1; unpack8(zw[m][bj], z0, z1);
                    *(u32x4*)(rowp + bj * 128) = pack8(acc[ai][bj][m][0] * sc * z0, acc[ai][bj][m][1] * sc * z1); } }
            asm volatile("" ::: "memory");
        }
    }
};
template <bool FIRST> struct EpiMerge {
    bf16_t* MRG; const bf16_t* gate;
    __device__ __forceinline__ void operator()(AccRef acc, const Unit& u, int wr, int wc, int fr, int fq) const {
        const int row0 = u.pm * 256 + wr * 64 + fr, c0 = u.pn * 256 + wc * 32 + 8 * fq;
        constexpr int NB = FIRST ? 4 : 2;
#pragma unroll
        for (int ai = 0; ai < 2; ++ai)
#pragma unroll
        for (int mh = 0; mh < 4; mh += NB) {
            u32x4 gw[NB][2], pw[NB][2];
#pragma unroll
            for (int mm = 0; mm < NB; ++mm)
#pragma unroll
                for (int bj = 0; bj < 2; ++bj) { const size_t row = (size_t)(row0 + ai * 128 + (mh + mm) * 16);
                    gw[mm][bj] = *(const u32x4*)(gate + row * LDG + c0 + bj * 128);
                    if constexpr (FIRST) pw[mm][bj] = (u32x4){0u, 0u, 0u, 0u}; else pw[mm][bj] = *(const u32x4*)(MRG + row * DM + c0 + bj * 128); }
#pragma unroll
            for (int mm = 0; mm < NB; ++mm) { const int m = mh + mm; bf16_t* mp = MRG + (size_t)(row0 + ai * 128 + m * 16) * DM + c0;
#pragma unroll
                for (int bj = 0; bj < 2; ++bj) { f32x4 g0, g1, p0, p1; unpack8(gw[mm][bj], g0, g1); unpack8(pw[mm][bj], p0, p1);
                    *(u32x4*)(mp + bj * 128) = pack8(g0 * acc[ai][bj][m][0] + p0, g1 * acc[ai][bj][m][1] + p1); } }
            asm volatile("" ::: "memory");
        }
    }
};
struct EpiOut {
    float* X; const float* bias; const float* lng; bf16_t* YG; float* stats;
    __device__ __forceinline__ void operator()(AccRef acc, const Unit& u, int wr, int wc, int fr, int fq) const {
        const int row0 = u.pm * 256 + wr * 64 + fr, c0 = u.pn * 256 + wc * 32 + 8 * fq;
#pragma unroll
        for (int bj = 0; bj < 2; ++bj) {
            const f32x4 bv0 = *(const f32x4*)(bias + c0 + bj * 128), bv1 = *(const f32x4*)(bias + c0 + bj * 128 + 4), gv0 = *(const f32x4*)(lng + c0 + bj * 128), gv1 = *(const f32x4*)(lng + c0 + bj * 128 + 4);
#pragma unroll
            for (int ai = 0; ai < 2; ++ai)
#pragma unroll
            for (int mh = 0; mh < 4; mh += 2) {
                f32x4 xv[4][2];
#pragma unroll
                for (int m = mh; m < mh + 2; ++m)
#pragma unroll
                    for (int n = 0; n < 2; ++n) xv[m][n] = *(const f32x4*)(X + (size_t)(row0 + ai * 128 + m * 16) * DM + c0 + bj * 128 + 4 * n);
#pragma unroll
                for (int m = mh; m < mh + 2; ++m) { const int row = row0 + ai * 128 + m * 16; float* xp = X + (size_t)row * DM + c0 + bj * 128; bf16_t* yp = YG + (size_t)row * DM + c0 + bj * 128;
                    const f32x4 y0 = xv[m][0] * DN_ALPHA + acc[ai][bj][m][0] + bv0, y1 = xv[m][1] * DN_ALPHA + acc[ai][bj][m][1] + bv1;
                    *(f32x4*)xp = y0; *(f32x4*)(xp + 4) = y1;
                    *(u32x4*)yp = pack8(y0 * gv0, y1 * gv1);
                    float sm = (y0[0] + y0[1]) + (y0[2] + y0[3]) + (y1[0] + y1[1]) + (y1[2] + y1[3]);
                    float sq = (y0[0] * y0[0] + y0[1] * y0[1]) + (y0[2] * y0[2] + y0[3] * y0[3]) + (y1[0] * y1[0] + y1[1] * y1[1]) + (y1[2] * y1[2] + y1[3] * y1[3]);
                    sm += __shfl_xor(sm, 16); sq += __shfl_xor(sq, 16); sm += __shfl_xor(sm, 32); sq += __shfl_xor(sq, 32);
                    if (fq == 0) { (void)__hip_atomic_fetch_add(stats + 2 * row, sm, __ATOMIC_RELAXED, __HIP_MEMORY_SCOPE_AGENT); (void)__hip_atomic_fetch_add(stats + 2 * row + 1, sq, __ATOMIC_RELAXED, __HIP_MEMORY_SCOPE_AGENT); } }
                asm volatile("" ::: "memory");
            }
        }
    }
};
struct EpiPlain {
    bf16_t* O;
    __device__ __forceinline__ void operator()(AccRef acc, const Unit& u, int wr, int wc, int fr, int fq) const {
        const int row0 = u.pm * 256 + wr * 64 + fr, c0 = u.pn * 256 + wc * 32 + 8 * fq;
#pragma unroll
        for (int ai = 0; ai < 2; ++ai)
#pragma unroll
            for (int m = 0; m < 4; ++m) { bf16_t* op = O + (size_t)(row0 + ai * 128 + m * 16) * DM + c0;
#pragma unroll
                for (int bj = 0; bj < 2; ++bj) *(u32x4*)(op + bj * 128) = pack8(acc[ai][bj][m][0], acc[ai][bj][m][1]); }
    }
};
struct EpiGate {
    float* X; const float* cg; const float* cb; const float* lng; const float* lnb; const bf16_t* PLEB; bf16_t* XB; const float* stats;
    __device__ __forceinline__ void operator()(AccRef acc, const Unit& u, int wr, int wc, int fr, int fq) const {
        const int row0 = u.pm * 256 + wr * 64 + fr, c0 = u.pn * 256 + wc * 32 + 8 * fq;
#pragma unroll
        for (int bj = 0; bj < 2; ++bj) {
            const f32x4 g0 = *(const f32x4*)(lng + c0 + bj * 128), g1 = *(const f32x4*)(lng + c0 + bj * 128 + 4), b0 = *(const f32x4*)(lnb + c0 + bj * 128), b1 = *(const f32x4*)(lnb + c0 + bj * 128 + 4);
            const f32x4 cg0 = *(const f32x4*)(cg + c0 + bj * 128), cg1 = *(const f32x4*)(cg + c0 + bj * 128 + 4), cb0 = *(const f32x4*)(cb + c0 + bj * 128), cb1 = *(const f32x4*)(cb + c0 + bj * 128 + 4);
#pragma unroll
            for (int ai = 0; ai < 2; ++ai)
#pragma unroll
            for (int mh = 0; mh < 4; mh += 2) {
                u32x4 pw[4]; f32x4 yv[4][2]; f32x2 st[4];
#pragma unroll
                for (int m = mh; m < mh + 2; ++m) { const int row = row0 + ai * 128 + m * 16; const size_t ro = (size_t)row * DM + c0 + bj * 128;
                    pw[m] = *(const u32x4*)(PLEB + ro); yv[m][0] = *(const f32x4*)(X + ro); yv[m][1] = *(const f32x4*)(X + ro + 4); st[m] = *(const f32x2*)(stats + 2 * row); }
#pragma unroll
                for (int m = mh; m < mh + 2; ++m) { const int row = row0 + ai * 128 + m * 16; const size_t ro = (size_t)row * DM + c0 + bj * 128;
                    const float mu = st[m].x * (1.f / DM), var = st[m].y * (1.f / DM) - mu * mu, r = 1.f / sqrtf(var + LN_EPS);
                    f32x4 p0, p1; unpack8(pw[m], p0, p1);
                    const f32x4 x0 = (yv[m][0] - mu) * r * g0 + b0, x1 = (yv[m][1] - mu) * r * g1 + b1;
                    const f32x4 o0 = x0 + sig4((acc[ai][bj][m][0] - mu * cg0) * r + cb0) * p0, o1 = x1 + sig4((acc[ai][bj][m][1] - mu * cg1) * r + cb1) * p1;
                    *(f32x4*)(X + ro) = o0; *(f32x4*)(X + ro + 4) = o1; *(u32x4*)(XB + ro) = pack8(o0, o1); }
                asm volatile("" ::: "memory");
            }
        }
    }
};

struct Params { const float* in[25]; float* out; unsigned char* ws; int ph_lo, ph_hi; };
enum { I_XP = 0, I_XS, I_PP, I_PS, I_EG, I_EB, I_WIN, I_BIN, I_WF, I_WG, I_BG, I_PSC, I_WP, I_WDW, I_BDW, I_CG, I_CB, I_WC, I_WOUT, I_BOUT, I_LNG, I_LNB, I_WPLE, I_WPG, I_BPG };

__device__ __forceinline__ void seq_of_row(int row, int& base, int& S) {
    if (row < M_PROMPT) { S = 2048; base = row & ~2047; } else { S = 8192; base = M_PROMPT + ((row - M_PROMPT) & ~8191); }
}

__device__ __forceinline__ void ln_row(const float* src, float* dstf, bf16_t* dstb, const float* g, const float* b, int lane) {
    f32x4 v[8]; float s = 0.f;
#pragma unroll
    for (int j = 0; j < 8; ++j) { v[j] = ((const f32x4*)src)[lane + 64 * j]; s += (v[j][0] + v[j][1]) + (v[j][2] + v[j][3]); }
    const float mean = wave_sum(s) * (1.f / DM); float s2 = 0.f;
#pragma unroll
    for (int j = 0; j < 8; ++j) { v[j] = v[j] - mean; s2 += (v[j][0] * v[j][0] + v[j][1] * v[j][1]) + (v[j][2] * v[j][2] + v[j][3] * v[j][3]); }
    const float rstd = 1.f / sqrtf(wave_sum(s2) * (1.f / DM) + LN_EPS);
#pragma unroll
    for (int j = 0; j < 8; ++j) { const f32x4 gg = ((const f32x4*)g)[lane + 64 * j], bb = ((const f32x4*)b)[lane + 64 * j]; const f32x4 o = v[j] * rstd * gg + bb;
        ((f32x4*)dstf)[lane + 64 * j] = o; u32x2 w; w.x = cvt_pk_bf16(o[0], o[1]); w.y = cvt_pk_bf16(o[2], o[3]); ((u32x2*)dstb)[lane + 64 * j] = w; }
}

__device__ __forceinline__ void transpose_item(const float* W, int ldw, int col0, bf16_t* WT, int ldt, int row0, int k0, LAS float* scr, int lane) {
    { float wv[32];
#pragma unroll
    for (int i = 0; i < 32; ++i) { const int kk = 2 * i + (lane >> 5); wv[i] = W[(size_t)(k0 + kk) * ldw + col0 + (lane & 31)]; }
#pragma unroll
    for (int i = 0; i < 32; ++i) { const int kk = 2 * i + (lane >> 5); scr[kk * 33 + (lane & 31)] = wv[i]; } }
    LDS_WAIT();
    const int c = lane & 7;
#pragma unroll
    for (int j = 0; j < 4; ++j) { const int n = (lane >> 3) + 8 * j; const LAS float* s = scr + (8 * c) * 33 + n;
        u32x4 o; o.x = cvt_pk_bf16(s[0 * 33], s[1 * 33]); o.y = cvt_pk_bf16(s[2 * 33], s[3 * 33]); o.z = cvt_pk_bf16(s[4 * 33], s[5 * 33]); o.w = cvt_pk_bf16(s[6 * 33], s[7 * 33]);
        *(u32x4*)(WT + (size_t)(row0 + n) * ldt + k0 + 8 * c) = o; }
    LDS_WAIT();
}

__device__ __forceinline__ void fft_lds(LAS f32x2* X, const LAS f32x2* tw, int logR, int logCW, int tid) {
    const int CWm = (1 << logCW) - 1;
    for (int p = 0; p < logR; ++p) {
        const int lh = logR - 1 - p, half = 1 << lh;
#pragma unroll 4
        for (int it = 0; it < 16; ++it) {
            const int f = it * 512 + tid, c = f & CWm, j = f >> logCW, grp = j >> lh, pos = j & (half - 1);
            const int i0 = ((grp << (lh + 1)) + pos), i1 = i0 + half;
            const f32x2 a = X[(i0 << logCW) + c], b = X[(i1 << logCW) + c], w = tw[pos << p];
            const f32x2 d = a - b;
            X[(i0 << logCW) + c] = a + b;
            X[(i1 << logCW) + c] = (f32x2){d.x * w.x - d.y * w.y, d.x * w.y + d.y * w.x};
        }
        __syncthreads();
    }
}


#define XB_TMO      128
#define XB_XCNT(j)  (256  + 64 * (j))
#define XB_XSUB(j)  (1280 + 64 * (j))
#define XB_XGEN(j)  (2304 + 64 * (j))
#define XB_TOP      3328
#define XB_TOPGEN   3392
#define XCD_BAR_WORDS 3456
#define XB_SPIN_CAP (1u << 22)
__device__ __forceinline__ unsigned xb_ld(unsigned* p)              { return __hip_atomic_load(p, __ATOMIC_RELAXED, __HIP_MEMORY_SCOPE_AGENT); }
__device__ __forceinline__ unsigned xb_add(unsigned* p, unsigned v) { return __hip_atomic_fetch_add(p, v, __ATOMIC_RELAXED, __HIP_MEMORY_SCOPE_AGENT); }
__device__ __forceinline__ unsigned xb_xcc_id() { return (unsigned)__builtin_amdgcn_s_getreg((3 << 11) | 20) & 0xFu; }
#define XB_SPIN(cond, bar) do { unsigned _sp = 0; while (cond) { __builtin_amdgcn_s_sleep(1); \
    if ((++_sp & 255u) == 0u) { if (xb_ld(&(bar)[XB_TMO])) break; if (_sp > XB_SPIN_CAP) { atomicAdd(&(bar)[XB_TMO], 1u); break; } } } } while (0)
struct XcdBarrier { unsigned* bar; unsigned x; volatile LAS unsigned* st; };
__device__ __forceinline__ XcdBarrier xcd_barrier_post(unsigned* bar, volatile LAS unsigned* st) {
    XcdBarrier b; b.bar = bar; b.x = xb_xcc_id(); b.st = st;
    if (threadIdx.x == 0) (void)xb_add(&bar[XB_XCNT(b.x)], 1u);
    return b;
}
__device__ __forceinline__ void xcd_barrier_complete(unsigned* bar, unsigned x, unsigned& nloc, unsigned& nx) {
    const unsigned G = gridDim.x * gridDim.y * gridDim.z;
    unsigned sum, cnt, mine, sp = 0u;
    for (;;) {
        sum = 0u; cnt = 0u; mine = 0u;
#pragma unroll
        for (unsigned j = 0; j < 16; ++j) { const unsigned c = xb_ld(&bar[XB_XCNT(j)]); sum += c; cnt += (c > 0u) ? 1u : 0u; mine = (j == x) ? c : mine; }
        if (sum == G) break;
        __builtin_amdgcn_s_sleep(1);
        if ((++sp & 255u) == 0u) { if (xb_ld(&bar[XB_TMO])) break; if (sp > XB_SPIN_CAP) { atomicAdd(&bar[XB_TMO], 1u); break; } }
    }
    nloc = mine > 0u ? mine : 1u; nx = cnt > 0u ? cnt : 1u;
}
__device__ __forceinline__ void xcd_barrier(const XcdBarrier& b) {
    asm volatile("s_waitcnt vmcnt(0)" ::: "memory");
    __syncthreads();
    if (threadIdx.x == 0) {
        unsigned* bar = b.bar;
        __builtin_amdgcn_s_waitcnt(0);
        unsigned nloc = b.st[0], nx = b.st[1];
        if (nloc == 0u) { xcd_barrier_complete(bar, b.x, nloc, nx); b.st[0] = nloc; b.st[1] = nx; }
        const unsigned old = xb_add(&bar[XB_XSUB(b.x)], 1u);
        const unsigned gen = old / nloc;
        if (old + 1u == (gen + 1u) * nloc) {
            __builtin_amdgcn_fence(__ATOMIC_RELEASE, "agent");
            asm volatile("s_waitcnt vmcnt(0)" ::: "memory");
            const unsigned og = xb_add(&bar[XB_TOP], 1u);
            const unsigned tg = og / nx;
            if (og + 1u == (tg + 1u) * nx) xb_add(&bar[XB_TOPGEN], 1u);
            else XB_SPIN(xb_ld(&bar[XB_TOPGEN]) == tg, bar);
            __builtin_amdgcn_fence(__ATOMIC_ACQUIRE, "agent");
            xb_add(&bar[XB_XGEN(b.x)], 1u);
            asm volatile("s_waitcnt vmcnt(0)" ::: "memory");
        } else {
            XB_SPIN(xb_ld(&bar[XB_XGEN(b.x)]) == gen, bar);
            __builtin_amdgcn_fence(__ATOMIC_ACQUIRE, "agent");
            asm volatile("s_waitcnt vmcnt(0)" ::: "memory");
        }
    }
    __syncthreads();
}

typedef const __attribute__((address_space(4))) Params* KP;
__device__ __forceinline__ KP kparams() { unsigned long long k = (unsigned long long)__builtin_amdgcn_kernarg_segment_ptr(); asm volatile("" : "+s"(k)); return (KP)k; }
#define KARGS0 KP p = kparams(); unsigned char* ws = p->ws; \
    bf16_t* WT = (bf16_t*)(ws + OFF_WT); bf16_t* FC = (bf16_t*)(ws + OFF_FC); float* BIASP = (float*)(ws + OFF_BIAS); \
    bf16_t* H = (bf16_t*)(ws + OFF_H); bf16_t* MRG = (bf16_t*)(ws + OFF_MRG); bf16_t* XB = (bf16_t*)(ws + OFF_XB); f32x2* ZB = (f32x2*)(ws + OFF_XB); \
    bf16_t* XC = (bf16_t*)(ws + OFF_XC); bf16_t* PB = (bf16_t*)(ws + OFF_PB); float* PVF = (float*)(ws + OFF_PVF); \
    bf16_t* XN = (bf16_t*)(ws + OFF_XN); bf16_t* PLEB = (bf16_t*)(ws + OFF_PLEB); float* X = p->out; \
    float* CGB = (float*)(ws + OFF_CGB); float* STATS = (float*)(ws + OFF_STATS); \
    (void)WT; (void)FC; (void)BIASP; (void)H; (void)MRG; (void)XB; (void)ZB; (void)XC; (void)PB; (void)PVF; (void)XN; (void)PLEB; (void)X; (void)CGB; (void)STATS;
#define KARGS KARGS0 const bf16_t* wt = WT + (size_t)l * WT_LAYER; (void)wt;
__global__ void __launch_bounds__(512, 2) fwd_megakernel(Params p_) {
    extern __shared__ __attribute__((aligned(16))) unsigned char smem[];
    cg::grid_group grid = cg::this_grid();
    LAS unsigned char* lds = (LAS unsigned char*)smem;
    const int G = gridDim.x, bid = blockIdx.x;
    const int NGW = G * 8;
    const size_t NGT = (size_t)G * 512;
    volatile LAS unsigned* xst = (volatile LAS unsigned*)(lds + 131072 + 4000);
    if (threadIdx.x < 2) xst[threadIdx.x] = 0u;
    __syncthreads();
    const XcdBarrier xbar = xcd_barrier_post((unsigned*)(kparams()->ws + OFF_BAR), xst);

    if (PHM & 1)
    {
        TID_VARS
            KARGS0
        const float* w_in = p->in[I_WIN]; const float* wg = p->in[I_WG];
        for (int task = gw; task < DEPTH * 512 * 4; task += NGW) {
            const int g = task & 3, kb = (task >> 2) & 511, l = task >> 11;
            const float* a = w_in + ((size_t)l * DM + kb * 4) * NIN + 1024 + g * 256;
            const float* b = wg + ((size_t)(l * 4 + g) * 256) * 256 + 4 * lane;
            f32x4 acc0 = {0, 0, 0, 0}, acc1 = acc0, acc2 = acc0, acc3 = acc0;
#pragma unroll 8
            for (int c = 0; c < 256; ++c) { const f32x4 bv = *(const f32x4*)(b + (size_t)c * 256);
                acc0 += a[c] * bv; acc1 += a[NIN + c] * bv; acc2 += a[2 * NIN + c] * bv; acc3 += a[3 * NIN + c] * bv; }
            float* o = PVF + ((size_t)l * DM + kb * 4) * 1024 + g * 256 + 4 * lane;
            *(f32x4*)o = acc0; *(f32x4*)(o + 1024) = acc1; *(f32x4*)(o + 2048) = acc2; *(f32x4*)(o + 3072) = acc3;
        }
        const float* b_in = p->in[I_BIN];
        for (size_t e = gt; e < (size_t)DEPTH * NIN; e += NGT) {
            const int l = (int)(e / NIN), n = (int)(e % NIN); float v;
            if (n >= 1024 && n < 2048) v = 0.f;
            else if (n >= 3072 && n < 4096) { const int j = (n - 3072) >> 8, lc = (n - 3072) & 255; v = b_in[(size_t)l * NIN + (lc < 128 ? 3072 + j * 128 + lc : 3584 + j * 128 + (lc - 128))]; }
            else v = b_in[(size_t)l * NIN + n];
            BIASP[e] = v;
        }
        for (size_t e = gt; e < (size_t)512 * 1024; e += NGT) {
            const int r = (int)(e >> 10), q = (int)(e & 1023), g = r >> 7, d = r & 127, half = q >> 9, g2 = (q >> 7) & 3, c = q & 127;
            float v = 0.f;
            if (g == g2) { const float ang = (float)((c * d) & 127) * (1.0f / 64.0f); v = half ? sinpif(ang) : cospif(ang); }
            FC[e] = (bf16_t)(cvt_pk_bf16(v, 0.f) & 0xffffu);
        }
        for (size_t e = gt; e < (size_t)DEPTH * DM * 16; e += NGT) {
            const int kc = (int)(e / ((size_t)DEPTH * DM)), le = (int)(e % ((size_t)DEPTH * DM)), l = le / DM, col = le % DM;
            const float* w = p->in[I_WPG] + ((size_t)l * DM + kc * 128) * DM + col; const float* g = p->in[I_LNG] + l * DM + kc * 128; const float* b = p->in[I_LNB] + l * DM + kc * 128;
            float sg = 0.f, sb = (kc == 0) ? p->in[I_BPG][l * DM + col] : 0.f;
#pragma unroll 8
            for (int k = 0; k < 128; ++k) { const float wv = w[(size_t)k * DM]; sg += g[k] * wv; sb += b[k] * wv; }
            (void)__hip_atomic_fetch_add(CGB + ((size_t)l * 2 + 0) * DM + col, sg, __ATOMIC_RELAXED, __HIP_MEMORY_SCOPE_AGENT);
            (void)__hip_atomic_fetch_add(CGB + ((size_t)l * 2 + 1) * DM + col, sb, __ATOMIC_RELAXED, __HIP_MEMORY_SCOPE_AGENT);
        }
        for (int row = gw; row < M_TOK; row += NGW) {
            const float* src = row < M_PROMPT ? p->in[I_XP] + (size_t)row * DM : p->in[I_XS] + (size_t)(row - M_PROMPT) * DM;
            ln_row(src, X + (size_t)row * DM, XB + (size_t)row * DM, p->in[I_EG], p->in[I_EB], lane);
        }
    }
    CG_SYNC();
    if (PHM & 2)
    {
        TID_VARS
            KARGS0
        LAS float* scr = (LAS float*)(lds + wave * 16384);
        constexpr int IT_IN = 32 * 336, IT_F = 8 * 64, IT_P = 16 * 64, IT_C = 8 * 64, IT_OUT = 32 * 64, IT_PG = 32 * 64, IT_PLE = 4 * 64;
        constexpr int IT_LAYER = IT_IN + IT_F + IT_P + IT_C + IT_OUT + IT_PG + IT_PLE;
        for (int it = gw; it < DEPTH * IT_LAYER; it += NGW) {
            const int l = it / IT_LAYER; int r = it % IT_LAYER;
            bf16_t* wt = WT + (size_t)l * WT_LAYER;
            if (r < IT_IN) {
                const int kb = r / 336, nb = r % 336, n0 = nb * 32, k0 = kb * 64;
                const float* src = p->in[I_WIN] + (size_t)l * DM * NIN; int ldw = NIN, col0 = n0;
                if (n0 >= 1024 && n0 < 2048) { src = PVF + (size_t)l * DM * 1024; ldw = 1024; col0 = n0 - 1024; }
                else if (n0 >= 3072 && n0 < 4096) { const int j = (n0 - 3072) >> 8, lc = (n0 - 3072) & 255; col0 = lc < 128 ? 3072 + j * 128 + lc : 3584 + j * 128 + (lc - 128); }
                transpose_item(src, ldw, col0, wt + WT_IN, DM, n0, k0, scr, lane); continue; }
            r -= IT_IN;
            if (r < IT_F) { transpose_item(p->in[I_WF] + (size_t)l * 512 * DM, DM, (r % 64) * 32, wt + WT_F, 512, (r % 64) * 32, (r / 64) * 64, scr, lane); continue; }
            r -= IT_F;
            if (r < IT_P) { transpose_item(p->in[I_WP] + (size_t)l * 1024 * DM, DM, (r % 64) * 32, wt + WT_P, 1024, (r % 64) * 32, (r / 64) * 64, scr, lane); continue; }
            r -= IT_P;
            if (r < IT_C) { transpose_item(p->in[I_WC] + (size_t)l * 512 * DM, DM, (r % 64) * 32, wt + WT_C, 512, (r % 64) * 32, (r / 64) * 64, scr, lane); continue; }
            r -= IT_C;
            if (r < IT_OUT) { transpose_item(p->in[I_WOUT] + (size_t)l * DM * DM, DM, (r % 64) * 32, wt + WT_OUT, DM, (r % 64) * 32, (r / 64) * 64, scr, lane); continue; }
            r -= IT_OUT;
            if (r < IT_PG) { transpose_item(p->in[I_WPG] + (size_t)l * DM * DM, DM, (r % 64) * 32, wt + WT_PG, DM, (r % 64) * 32, (r / 64) * 64, scr, lane); continue; }
            r -= IT_PG;
            transpose_item(p->in[I_WPLE] + (size_t)l * PLE * DM, DM, (r % 64) * 32, wt + WT_PLE, PLE, (r % 64) * 32, (r / 64) * 64, scr, lane);
        }
    }
    GRID_SYNC();

    LAS f32x2* FX = (LAS f32x2*)lds;
    LAS f32x2* TW = (LAS f32x2*)(lds + 131072);
    LAS f32x2* TW2 = (LAS f32x2*)(lds + 131072 + 2048);

    for (int l = 0; l < DEPTH; ++l) {
        if (PHM & 4)
        {
            TID_VARS
            KARGS
            pg8::Gemm g{XB, wt + WT_IN, M_TOK, NIN, DM, DM, DM}; pg8::StaticOrder S; S.init(M_TOK, NIN, G, bid);
            EpiIn E{H, BIASP + (size_t)l * NIN};
            pg8::gemm_phase(lds, g, S, E, tid);
        }
        GRID_SYNC();
        if (PHM & 8)
        {
            TID_VARS
            KARGS
            if (tid < 16) { const float ang = (float)tid * (1.0f / 16.0f); TW[tid] = (f32x2){cospif(ang), -sinpif(ang)}; }
            for (int t = bid; t < 1024; t += G) {
                int base, n1, S1, lS;
                if (t < 512) { base = (t >> 6) * 2048; n1 = t & 63; S1 = 64; lS = 11; } else { const int tt = t - 512; base = M_PROMPT + (tt >> 8) * 8192; n1 = tt & 255; S1 = 256; lS = 13; }
                __syncthreads();
                if (tid < 32) { const int k2 = (int)(__brev((unsigned)tid) >> 27); const float ang = (float)((k2 * n1) & ((1 << lS) - 1)) * (2.0f / (float)(1 << lS)); TW2[tid] = (f32x2){cospif(ang), -sinpif(ang)}; }
                { bf16_t hv[32];
#pragma unroll
                for (int n2 = 0; n2 < 32; ++n2) hv[n2] = H[SEG_F + (size_t)(base + n1 + S1 * n2) * LDF + tid];
#pragma unroll
                for (int n2 = 0; n2 < 32; ++n2) FX[n2 * 512 + tid] = (f32x2){bf1(hv[n2]), 0.f}; }
                __syncthreads();
                fft_lds(FX, TW, 5, 9, tid);
#pragma unroll 8
                for (int i2 = 0; i2 < 32; ++i2) { const int k2 = (int)(__brev((unsigned)i2) >> 27); const f32x2 z = FX[i2 * 512 + tid], w = TW2[i2];
                    ZB[(size_t)(base + k2 * S1 + n1) * 512 + tid] = (f32x2){z.x * w.x - z.y * w.y, z.x * w.y + z.y * w.x}; }
            }
            __syncthreads();
            {
                LAS float* WD = (LAS float*)lds;
                LAS unsigned char* VT = lds + 63488;
                const float* wdw = p->in[I_WDW] + (size_t)l * 31 * 512;
                for (int e = tid; e < 31 * 512; e += 512) WD[e] = wdw[e];
                const float* bdw = p->in[I_BDW] + l * 512 + 8 * lane; const float* cg_ = p->in[I_CG] + l * 512 + 8 * lane; const float* cb_ = p->in[I_CB] + l * 512 + 8 * lane;
                const f32x4 bd0 = *(const f32x4*)bdw, bd1 = *(const f32x4*)(bdw + 4), lg0 = *(const f32x4*)cg_, lg1 = *(const f32x4*)(cg_ + 4), lb0 = *(const f32x4*)cb_, lb1 = *(const f32x4*)(cb_ + 4);
                for (int rb = bid; rb < M_TOK / 128; rb += G)
                for (int c = 0; c < 4; ++c) {
                    const int R0 = rb * 128 + 32 * c; int base, S; seq_of_row(R0, base, S); const int t0 = R0 - base;
                    __syncthreads();
#pragma unroll
                    for (int it = 0; it < 8; ++it) { const int idx = it * 512 + tid; if (idx < 62 * 64) { const int q = idx >> 6, c16 = idx & 63, tt = t0 - 15 + q;
                        u32x4 v = {0u, 0u, 0u, 0u}; if (tt >= 0 && tt < S) v = *(const u32x4*)(H + SEG_C + (size_t)(base + tt) * LDC + c16 * 8);
                        *(LAS u32x4*)(VT + q * 1024 + c16 * 16) = v; } }
                    __syncthreads();
                    for (int i = wave; i < 32; i += 8) {
                        bf16_t* zp = H + SEG_C + (size_t)(R0 + i) * LDC + 512 + 8 * lane;
                        const u32x4 zw = *(const u32x4*)zp;
                        f32x4 a0 = bd0, a1 = bd1;
#pragma unroll 4
                        for (int j = 0; j < 31; ++j) {
                            f32x4 v0, v1; unpack8(*(const LAS u32x4*)(VT + (i + j) * 1024 + lane * 16), v0, v1);
                            const f32x4 w0 = *(const LAS f32x4*)(WD + j * 512 + 8 * lane), w1 = *(const LAS f32x4*)(WD + j * 512 + 8 * lane + 4);
                            a0 += w0 * v0; a1 += w1 * v1;
                        }
                        const float mean = wave_sum((a0[0] + a0[1]) + (a0[2] + a0[3]) + (a1[0] + a1[1]) + (a1[2] + a1[3])) * (1.f / 512.f);
                        a0 = a0 - mean; a1 = a1 - mean;
                        const float var = wave_sum((a0[0] * a0[0] + a0[1] * a0[1]) + (a0[2] * a0[2] + a0[3] * a0[3]) + (a1[0] * a1[0] + a1[1] * a1[1]) + (a1[2] * a1[2] + a1[3] * a1[3])) * (1.f / 512.f);
                        const float rstd = 1.f / sqrtf(var + LN_EPS);
                        f32x4 y0 = a0 * rstd * lg0 + lb0, y1 = a1 * rstd * lg1 + lb1;
                        f32x4 z0, z1; unpack8(zw, z0, z1);
                        *(u32x4*)zp = pack8(silu4(y0) * z0, silu4(y1) * z1);
                    }
                }
            }
            {
                const float* bg = p->in[I_BG] + l * 1024; const float* psc = p->in[I_PSC] + l * 1024;
                for (int rb = bid; rb < M_TOK / 128; rb += G) {
                const int R0 = rb * 128; int base, S; seq_of_row(R0, base, S); const int t0 = R0 - base;
                for (int g = 0; g < 4; ++g) {
                    const int hw = 1 << g, NR = 128 + 2 * hw;
                    __syncthreads();
                    for (int idx = tid; idx < NR * 32; idx += 512) { const int q = idx >> 5, c16 = idx & 31, tt = t0 - hw + q;
                        u32x4 v = {0u, 0u, 0u, 0u}; if (tt >= 0 && tt < S) v = *(const u32x4*)(H + SEG_P + (size_t)(base + tt) * LDP + g * 256 + c16 * 8);
                        *(LAS u32x4*)(lds + q * 512 + c16 * 16) = v; }
                    __syncthreads();
                    u32x4 zws[8];
#pragma unroll
                    for (int k = 0; k < 8; ++k) { const int o = k * 512 + tid, r = o >> 5, chl = o & 31, ch = g * 32 + chl; zws[k] = *(const u32x4*)(H + SEG_P + (size_t)(R0 + r) * LDP + 1024 + ch * 8); }
                    const int chl_ = tid & 31, ch_ = g * 32 + chl_;
                    const f32x4 b0 = *(const f32x4*)(bg + ch_ * 8), b1 = *(const f32x4*)(bg + ch_ * 8 + 4), q0 = *(const f32x4*)(psc + ch_ * 8), q1 = *(const f32x4*)(psc + ch_ * 8 + 4);
#pragma unroll
                    for (int k = 0; k < 8; ++k) {
                        const int o = k * 512 + tid, r = o >> 5, chl = o & 31, t = t0 + r, ch = g * 32 + chl;
                        bf16_t* zp = H + SEG_P + (size_t)(R0 + r) * LDP + 1024 + ch * 8;
                        f32x4 s0 = {0, 0, 0, 0}, s1 = s0;
                        for (int kk = 0; kk < 2 * hw; ++kk) { f32x4 v0, v1; unpack8(*(const LAS u32x4*)(lds + (r + kk) * 512 + chl * 16), v0, v1); s0 += v0; s1 += v1; }
                        f32x4 c0, c1; unpack8(*(const LAS u32x4*)(lds + (r + hw) * 512 + chl * 16), c0, c1);
                        const float inv = 1.0f / (float)(min(t + hw, S) - max(t - hw, 0));
                        f32x4 z0, z1; unpack8(zws[k], z0, z1);
                        *(u32x4*)zp = pack8(((s0 * inv - c0) + b0) * q0 * z0, ((s1 * inv - c1) + b1) * q1 * z1);
                    }
                }
                }
            }
            {
                for (size_t e = gt; e < (size_t)M_TOK * 2; e += NGT) STATS[e] = 0.f;
                const float* pp = p->in[I_PP] + (size_t)l * M_PROMPT * PLE; const float* ps = p->in[I_PS] + (size_t)l * M_PROMPT * PLE;
#pragma unroll 4
                for (size_t e = gt; e < (size_t)M_TOK * PLE / 8; e += NGT) {
                    const size_t o = e * 8; const float* src = o < (size_t)M_PROMPT * PLE ? pp + o : ps + (o - (size_t)M_PROMPT * PLE);
                    *(u32x4*)(PB + o) = pack8(*(const f32x4*)src, *(const f32x4*)(src + 4));
                }
            }
        }
        GRID_SYNC();
        if (PHM & 16)
        {
            TID_VARS
            KARGS
            for (int t = bid; t < 1024; t += G) {
                int base, k2, cc, lR, lCW;
                if (t < 512) { base = (t >> 6) * 2048; const int rem = t & 63; k2 = rem >> 1; cc = rem & 1; lR = 6; lCW = 8; }
                else { const int tt = t - 512; base = M_PROMPT + (tt >> 8) * 8192; const int rem = tt & 255; k2 = rem >> 3; cc = rem & 7; lR = 8; lCW = 6; }
                const int R = 1 << lR, CWm = (1 << lCW) - 1;
                __syncthreads();
                if (tid < (R >> 1)) { const float ang = (float)tid * (2.0f / (float)R); TW[tid] = (f32x2){cospif(ang), -sinpif(ang)}; }
                const f32x2* zsrc = ZB + (size_t)(base + k2 * R) * 512 + (cc << lCW);
#pragma unroll
                for (int ih = 0; ih < 32; ih += 16) { f32x2 zv[16];
#pragma unroll
                    for (int it = 0; it < 16; ++it) { const int f = (ih + it) * 512 + tid, c = f & CWm, n1 = f >> lCW; zv[it] = zsrc[(size_t)n1 * 512 + c]; }
#pragma unroll
                    for (int it = 0; it < 16; ++it) FX[(ih + it) * 512 + tid] = zv[it]; }
                __syncthreads();
                fft_lds(FX, TW, lR, lCW, tid);
#pragma unroll 8
                for (int it = 0; it < 32; ++it) { const int f = it * 512 + tid, c = f & CWm, i1 = f >> lCW; const int k1 = (int)(__brev((unsigned)i1) >> (32 - lR));
                    const f32x2 z = FX[f]; bf16_t* o = XC + (size_t)(base + k2 + 32 * k1) * 1024 + (cc << lCW) + c;
                    o[0] = (bf16_t)(cvt_pk_bf16(z.x, 0.f) & 0xffffu); o[512] = (bf16_t)(cvt_pk_bf16(z.y, 0.f) & 0xffffu); }
            }
            __syncthreads();
            { const int tid = opaque_tid(); pg8::Gemm g{H + SEG_P + 1024, wt + WT_P, M_TOK, DM, 1024, LDP, 1024}; pg8::StaticOrder S; S.init(M_TOK, DM, G, bid);
              EpiMerge<true> E{MRG, H + SEG_G + (size_t)M_TOK * LDG}; pg8::gemm_phase(lds, g, S, E, tid); }
            { const int tid = opaque_tid(); pg8::Gemm g{H + SEG_C + 512, wt + WT_C, M_TOK, DM, 512, LDC, 512}; pg8::StaticOrder S; S.init(M_TOK, DM, G, bid);
              EpiMerge<false> E{MRG, H + SEG_G + (size_t)2 * M_TOK * LDG}; pg8::gemm_phase(lds, g, S, E, tid); }
        }
        GRID_SYNC();
        if (PHM & 32)
        {
            TID_VARS
            KARGS
            pg8::Gemm g{XC, FC, M_TOK, 512, 1024, 1024, 1024}; pg8::StaticOrder S; S.init(M_TOK, 512, G, bid);
            EpiFnet E{H}; pg8::gemm_phase(lds, g, S, E, tid);
        }
        GRID_SYNC();
        if (PHM & 64)
        {
            TID_VARS
            KARGS
            pg8::Gemm g{H + SEG_F + 512, wt + WT_F, M_TOK, DM, 512, LDF, 512}; pg8::StaticOrder S; S.init(M_TOK, DM, G, bid);
            EpiMerge<false> E{MRG, H + SEG_G}; pg8::gemm_phase(lds, g, S, E, tid);
        }
        GRID_SYNC();
        if (PHM & 128)
        {
            TID_VARS
            KARGS
            { const int tid = opaque_tid(); pg8::Gemm g{MRG, wt + WT_OUT, M_TOK, DM, DM, DM, DM}; pg8::StaticOrder S; S.init(M_TOK, DM, G, bid);
              EpiOut E{X, p->in[I_BOUT] + (size_t)l * DM, p->in[I_LNG] + (size_t)l * DM, XN, STATS}; pg8::gemm_phase(lds, g, S, E, tid); }
            { const int tid = opaque_tid(); pg8::Gemm g{PB, wt + WT_PLE, M_TOK, DM, PLE, PLE, PLE}; pg8::StaticOrder S; S.init(M_TOK, DM, G, bid);
              EpiPlain E{PLEB}; pg8::gemm_phase(lds, g, S, E, tid); }
        }
        GRID_SYNC();
        if (PHM & 512)
        {
            TID_VARS
            KARGS
            pg8::Gemm g{XN, wt + WT_PG, M_TOK, DM, DM, DM, DM}; pg8::StaticOrder S; S.init(M_TOK, DM, G, bid);
            EpiGate E{X, CGB + ((size_t)l * 2 + 0) * DM, CGB + ((size_t)l * 2 + 1) * DM, p->in[I_LNG] + (size_t)l * DM, p->in[I_LNB] + (size_t)l * DM, PLEB, XB, STATS}; pg8::gemm_phase(lds, g, S, E, tid);
        }
        if (l + 1 < DEPTH) GRID_SYNC();
    }
}

extern "C" void kernel_launch(void* const* d_in, const int* in_sizes, int n_in, void* d_out, int out_size, void* d_ws, size_t ws_size, hipStream_t stream) {
    static int grid_blocks = 0;
    if (grid_blocks == 0) {
        if (n_in != 25 || out_size != M_TOK * DM || ws_size < WS_END2) { fprintf(stderr, "kernel_launch: unexpected shapes: n_in %d out %d ws %zu (need %zu)\n", n_in, out_size, ws_size, (size_t)WS_END2); grid_blocks = -1; return; }
        int dev = 0, cus = 0, per_cu = 0;
        hipGetDevice(&dev);
        hipDeviceGetAttribute(&cus, hipDeviceAttributeMultiprocessorCount, dev);
        if (hipFuncSetAttribute((const void*)fwd_megakernel, hipFuncAttributeMaxDynamicSharedMemorySize, LDS_BYTES) != hipSuccess) { fprintf(stderr, "kernel_launch: hipFuncSetAttribute failed\n"); grid_blocks = -1; return; }
        hipOccupancyMaxActiveBlocksPerMultiprocessor(&per_cu, (const void*)fwd_megakernel, 512, LDS_BYTES);
        if (per_cu < 1) { fprintf(stderr, "kernel_launch: occupancy query says %d blocks per CU\n", per_cu); per_cu = 1; }
        (void)hipGetLastError();
        grid_blocks = cus;
    }
    if (grid_blocks < 0) return;
    if (hipMemsetAsync((char*)d_ws + OFF_BAR, 0, 16384 + (size_t)DEPTH * 2 * DM * 4, stream) != hipSuccess) { fprintf(stderr, "kernel_launch: memset failed\n"); return; }
    Params p{};
    for (int i = 0; i < 25; ++i) p.in[i] = (const float*)d_in[i];
    p.out = (float*)d_out; p.ws = (unsigned char*)d_ws; p.ph_lo = 0; p.ph_hi = 1000;
    void* args[] = {&p};
    hipError_t e = hipLaunchCooperativeKernel((const void*)fwd_megakernel, dim3(grid_blocks), dim3(512), args, LDS_BYTES, stream);
    if (e != hipSuccess) fprintf(stderr, "cooperative launch failed: %s (grid %d)\n", hipGetErrorString(e), grid_blocks);
}
```

```cpp
#include <hip/hip_runtime.h>
#include <hip/hip_cooperative_groups.h>
#include <cstdio>
namespace cg = cooperative_groups;

#define LAS __attribute__((address_space(3)))
typedef unsigned short bf16_t;
typedef short bf16x8 __attribute__((ext_vector_type(8)));
typedef float f32x4 __attribute__((ext_vector_type(4)));
typedef float f32x2 __attribute__((ext_vector_type(2)));
typedef unsigned u32x4 __attribute__((ext_vector_type(4)));
typedef unsigned u32x2 __attribute__((ext_vector_type(2)));

constexpr int M_TOK = 32768, M_PROMPT = 16384, DM = 2048, NIN = 10752, LDH = 10240, DEPTH = 4, PLE = 256;
constexpr size_t SEG_F = 0, SEG_P = SEG_F + (size_t)M_TOK * 1024, SEG_C = SEG_P + (size_t)M_TOK * 2048, SEG_G = SEG_C + (size_t)M_TOK * 1024;
constexpr int LDF = 1024, LDP = 2048, LDC = 1024, LDG = 2048;
constexpr float LN_EPS = 1e-5f;
constexpr float DN_ALPHA = 1.6817928305074290f;
constexpr size_t WT_IN = 0, WT_F = (size_t)NIN * DM, WT_P = WT_F + (size_t)DM * 512, WT_C = WT_P + (size_t)DM * 1024, WT_OUT = WT_C + (size_t)DM * 512,
                 WT_PG = WT_OUT + (size_t)DM * DM, WT_PLE = WT_PG + (size_t)DM * DM, WT_LAYER = WT_PLE + (size_t)DM * PLE;
constexpr size_t OFF_WT = 0;
constexpr size_t OFF_FC = OFF_WT + (size_t)DEPTH * WT_LAYER * 2;
constexpr size_t OFF_BIAS = OFF_FC + (size_t)512 * 1024 * 2;
constexpr size_t OFF_H = OFF_BIAS + (size_t)DEPTH * NIN * 4;
constexpr size_t OFF_MRG = OFF_H + (size_t)M_TOK * LDH * 2;
constexpr size_t OFF_XB = OFF_MRG + (size_t)M_TOK * DM * 2;
constexpr size_t OFF_XC = OFF_XB + (size_t)M_TOK * DM * 2;
constexpr size_t OFF_PB = OFF_XC + (size_t)M_TOK * 1024 * 2;
constexpr size_t WS_END = OFF_PB + (size_t)M_TOK * PLE * 2;
constexpr size_t OFF_BAR = WS_END;
constexpr size_t OFF_CGB = OFF_BAR + 16384;
constexpr size_t OFF_STATS = OFF_CGB + (size_t)DEPTH * 2 * DM * 4;
constexpr size_t OFF_TWT = OFF_STATS + (size_t)M_TOK * 2 * 4;
constexpr int TW_2A = 0, TW_2B = 64 * 32, TW_RA = TW_2B + 256 * 32, TW_RB = TW_RA + 32, TW_RC = TW_RB + 128, TW_N = TW_RC + 16;
constexpr size_t WS_END2 = OFF_TWT + (size_t)TW_N * 8;
constexpr size_t OFF_PVF = OFF_H;
constexpr size_t OFF_XN = OFF_H;
constexpr size_t OFF_PLEB = OFF_H + (size_t)M_TOK * DM * 2;
static_assert(OFF_FC % 256 == 0 && OFF_BIAS % 256 == 0 && OFF_H % 256 == 0 && OFF_MRG % 256 == 0 && OFF_XB % 256 == 0 && OFF_XC % 256 == 0 && OFF_PB % 256 == 0, "align");

constexpr int LDS_BYTES = 131072 + 4096;
#ifndef PHM
#define PHM 0xFFFF
#endif

typedef __bf16 bf16x2_t __attribute__((ext_vector_type(2)));
__device__ __forceinline__ unsigned cvt_pk_bf16(float lo, float hi) { f32x2 v = {lo, hi}; bf16x2_t b = __builtin_convertvector(v, bf16x2_t); return __builtin_bit_cast(unsigned, b); }
__device__ __forceinline__ float bf_lo(unsigned w) { return __uint_as_float(w << 16); }
__device__ __forceinline__ float bf_hi(unsigned w) { return __uint_as_float(w & 0xffff0000u); }
__device__ __forceinline__ float bf1(bf16_t h) { return __uint_as_float(((unsigned)h) << 16); }
__device__ __forceinline__ float sigmoidf_(float x) { return __builtin_amdgcn_rcpf(1.0f + __expf(-x)); }
__device__ __forceinline__ f32x4 sig4(f32x4 v) { return (f32x4){sigmoidf_(v[0]), sigmoidf_(v[1]), sigmoidf_(v[2]), sigmoidf_(v[3])}; }
__device__ __forceinline__ f32x4 silu4(f32x4 v) { return v * sig4(v); }
__device__ __forceinline__ void unpack8(u32x4 w, f32x4& a, f32x4& b) { a = (f32x4){bf_lo(w.x), bf_hi(w.x), bf_lo(w.y), bf_hi(w.y)}; b = (f32x4){bf_lo(w.z), bf_hi(w.z), bf_lo(w.w), bf_hi(w.w)}; }
__device__ __forceinline__ u32x4 pack8(f32x4 a, f32x4 b) { u32x4 w; w.x = cvt_pk_bf16(a[0], a[1]); w.y = cvt_pk_bf16(a[2], a[3]); w.z = cvt_pk_bf16(b[0], b[1]); w.w = cvt_pk_bf16(b[2], b[3]); return w; }
__device__ __forceinline__ float wave_sum(float v) {
#pragma unroll
    for (int o = 1; o < 64; o <<= 1) v += __shfl_xor(v, o);
    return v;
}
__device__ __forceinline__ int opaque_tid() { int t = threadIdx.x; asm volatile("" : "+v"(t)); return t; }
#define TID_VARS const int tid = opaque_tid(), lane = tid & 63, wave = __builtin_amdgcn_readfirstlane(tid >> 6); const int gw = bid * 8 + wave; const size_t gt = (size_t)bid * 512 + tid; (void)lane; (void)gw; (void)gt;
#define CG_SYNC() do { asm volatile("s_waitcnt vmcnt(0) lgkmcnt(0)" ::: "memory"); grid.sync(); asm volatile("" ::: "memory"); } while (0)
#define GRID_SYNC() do { asm volatile("" ::: "memory"); xcd_barrier(xbar); asm volatile("" ::: "memory"); } while (0)
#define LDS_WAIT() asm volatile("s_waitcnt lgkmcnt(0)" ::: "memory")

namespace pg8 {
constexpr int BM = 256, BK = 64, HALF = 128, HTB = HALF * BK * 2, NXCD = 8, WGM = 4;
__device__ __forceinline__ int lds_byte(int r, int c) { const int st = (r >> 4) * 2 + (c >> 5), rr = r & 15, cc = c & 31, ob = rr * 64 + cc * 2; return st * 1024 + (ob ^ (((ob >> 9) & 1) << 5)); }
__device__ __forceinline__ void stage_rc(int b, int& R, int& C) { const int st = b / 1024, sb = b % 1024, swz = sb ^ (((sb >> 9) & 1) << 5); R = (st >> 1) * 16 + swz / 64; C = (st & 1) * 32 + (swz % 64) / 2; }
__device__ __forceinline__ int perm32(int rho) { const int n = rho >> 4, i = rho & 15; return 8 * (i >> 2) + 4 * n + (i & 3); }
struct Unit { int pm, pn; };
struct Gemm { const bf16_t* A; const bf16_t* Bt; int M, N, K, lda, ldb; };
struct StaticOrder {
    int nM, nN, nwg, G, c;
    __device__ void init(int M, int N, int G_, int c_) { nM = M / BM; nN = N / BM; nwg = nM * nN; G = G_; c = c_; }
    __device__ bool next(int i, Unit& u) const {
        const long L = (long)i * G + c; if (L >= nwg) return false;
        int wgid = (int)L; { const int q = nwg / NXCD, r = nwg % NXCD, xcd = wgid % NXCD, off = wgid / NXCD; wgid = (xcd < r ? xcd * (q + 1) : r * (q + 1) + (xcd - r) * q) + off; }
        const int nig = WGM * nN, gid = wgid / nig, fm = gid * WGM, gsz = (nM - fm) < WGM ? (nM - fm) : WGM;
        u.pm = fm + ((wgid % nig) % gsz); u.pn = (wgid % nig) / gsz; return true;
    }
};
template <class Epi>
__device__ __forceinline__ void gemm_phase(LAS unsigned char* lds, const Gemm g, const StaticOrder& S, const Epi& E, const int tid) {
    const int wid = __builtin_amdgcn_readfirstlane(tid >> 6), lane = tid & 63, wr = wid >> 2, wc = wid & 3, fr = lane & 15, fq = lane >> 4;
    const int K = g.K, nt = K / BK;
    unsigned voffA[2], voffB[2];
#pragma unroll
    for (int i = 0; i < 2; ++i) { int R, C; stage_rc(tid * 16 + i * 8192, R, C); const int Rb = (R & ~31) + perm32(R & 31);
        voffA[i] = (unsigned)(R * g.lda + C) * 2u; voffB[i] = (unsigned)(Rb * g.ldb + C) * 2u; }
    const size_t kstep = (size_t)(BK * 2);
    const size_t hstepA = (size_t)HALF * g.lda * 2, hstepB = (size_t)HALF * g.ldb * 2;
    const size_t tstepA = 2 * hstepA, tstepB = 2 * hstepB;
    const unsigned ldsw = (unsigned)wid * 1024u;
    const int aoff = lds_byte(wr * 64 + fr, fq * 8), boff = lds_byte(wc * 32 + fr, fq * 8);
#define PG8_SA(b, h) (((b) * 2 + (h)) * HTB)
#define PG8_SB(b, h) ((4 + (b) * 2 + (h)) * HTB)
#define PG8_STAGE(bufoff, gbase, voff) do { _Pragma("unroll") for (int _i = 0; _i < 2; ++_i) \
        __builtin_amdgcn_global_load_lds((const unsigned*)((const char*)(gbase) + (voff)[_i]), (LAS unsigned*)(lds + (bufoff) + ldsw + _i * 8192), 16, 0, 0); } while (0)
#define PG8_LDA(dst, b, h) do { _Pragma("unroll") for (int m = 0; m < 4; ++m) _Pragma("unroll") for (int k = 0; k < 2; ++k) dst[m][k] = *(const LAS bf16x8*)(lds + PG8_SA(b, h) + aoff + m * 2048 + k * 1024); } while (0)
#define PG8_LDB(dst, b, h) do { _Pragma("unroll") for (int n = 0; n < 2; ++n) _Pragma("unroll") for (int k = 0; k < 2; ++k) dst[n][k] = *(const LAS bf16x8*)(lds + PG8_SB(b, h) + boff + n * 2048 + k * 1024); } while (0)
#define PG8_MMA(ai, bj, At, Bt) do { __builtin_amdgcn_s_setprio(1); _Pragma("unroll") for (int m = 0; m < 4; ++m) _Pragma("unroll") for (int n = 0; n < 2; ++n) _Pragma("unroll") for (int k = 0; k < 2; ++k) \
        acc[ai][bj][m][n] = __builtin_amdgcn_mfma_f32_16x16x32_bf16(Bt[n][k], At[m][k], acc[ai][bj][m][n], 0, 0, 0); __builtin_amdgcn_s_setprio(0); } while (0)
#define PG8_WAIT_V(n) asm volatile("s_waitcnt vmcnt(" #n ")" ::: "memory")
#define PG8_WAIT_L(n) asm volatile("s_waitcnt lgkmcnt(" #n ")" ::: "memory")
#define PG8_BAR __builtin_amdgcn_s_barrier()
#define PG8_SCHED __builtin_amdgcn_sched_barrier(0)
    Unit cur, nxt; int ui = 0;
    if (!S.next(0, cur)) return;
    f32x4 acc[2][2][4][2];
    E.init(acc, cur, wr, wc, fr, fq);
    bf16x8 At[4][2], B0[2][2], B1[2][2];
    const char* cA = (const char*)g.A + (size_t)cur.pm * tstepA; const char* cB = (const char*)g.Bt + (size_t)cur.pn * tstepB;
    PG8_STAGE(PG8_SB(0, 0), cB, voffB); PG8_STAGE(PG8_SA(0, 0), cA, voffA); PG8_STAGE(PG8_SB(0, 1), cB + hstepB, voffB); PG8_STAGE(PG8_SA(0, 1), cA + hstepA, voffA);
    if (wr == 1) PG8_BAR;
    PG8_WAIT_V(4); PG8_BAR;
    PG8_STAGE(PG8_SB(1, 0), cB + kstep, voffB); PG8_STAGE(PG8_SA(1, 0), cA + kstep, voffA); PG8_STAGE(PG8_SB(1, 1), cB + hstepB + kstep, voffB);
    PG8_WAIT_V(6); PG8_BAR;
    for (;;) {
        const bool has_next = S.next(ui + 1, nxt);
        const char* nA = has_next ? (const char*)g.A + (size_t)nxt.pm * tstepA : cA; const char* nB = has_next ? (const char*)g.Bt + (size_t)nxt.pn * tstepB : cB;
        for (int t = 0; t < nt; t += 2) {
            const bool last = (t == nt - 2);
            const char* a1 = cA + (size_t)(t + 1) * kstep;
            const char* a2 = last ? nA : cA + (size_t)(t + 2) * kstep; const char* b2 = last ? nB : cB + (size_t)(t + 2) * kstep;
            const char* a3 = a2 + kstep; const char* b3 = b2 + kstep;
            PG8_LDB(B0, 0, 0); PG8_SCHED; PG8_LDA(At, 0, 0); PG8_STAGE(PG8_SA(1, 1), a1 + hstepA, voffA);
            PG8_WAIT_L(8); PG8_BAR; PG8_WAIT_L(0); PG8_MMA(0, 0, At, B0); PG8_BAR; PG8_SCHED;
            PG8_LDB(B1, 0, 1); PG8_STAGE(PG8_SB(0, 0), b2, voffB);
            PG8_BAR; PG8_WAIT_L(0); PG8_MMA(0, 1, At, B1); PG8_BAR;
            PG8_LDA(At, 0, 1); PG8_STAGE(PG8_SA(0, 0), a2, voffA);
            PG8_BAR; PG8_WAIT_L(0); PG8_MMA(1, 0, At, B0); PG8_BAR; PG8_SCHED;
            PG8_STAGE(PG8_SB(0, 1), b2 + hstepB, voffB);
            PG8_WAIT_V(6); PG8_BAR; PG8_MMA(1, 1, At, B1); PG8_BAR;
            PG8_LDB(B0, 1, 0); PG8_SCHED; PG8_LDA(At, 1, 0); PG8_STAGE(PG8_SA(0, 1), a2 + hstepA, voffA);
            PG8_WAIT_L(8); PG8_BAR; PG8_WAIT_L(0); PG8_MMA(0, 0, At, B0); PG8_BAR; PG8_SCHED;
            PG8_LDB(B1, 1, 1); PG8_STAGE(PG8_SB(1, 0), b3, voffB);
            PG8_BAR; PG8_WAIT_L(0); PG8_MMA(0, 1, At, B1); PG8_BAR;
            PG8_LDA(At, 1, 1); PG8_STAGE(PG8_SA(1, 0), a3, voffA);
            PG8_BAR; PG8_WAIT_L(0); PG8_MMA(1, 0, At, B0); PG8_BAR; PG8_SCHED;
            PG8_STAGE(PG8_SB(1, 1), b3 + hstepB, voffB);
            PG8_WAIT_V(6); PG8_BAR; PG8_MMA(1, 1, At, B1); PG8_BAR;
        }
        E(acc, cur, wr, wc, fr, fq);
        if (!has_next) break;
        E.init(acc, nxt, wr, wc, fr, fq);
        cur = nxt; cA = nA; cB = nB; ++ui;
    }
    PG8_WAIT_V(0);
    if (wr == 0) PG8_BAR;
    PG8_BAR;
#undef PG8_SA
#undef PG8_SB
#undef PG8_STAGE
#undef PG8_LDA
#undef PG8_LDB
#undef PG8_MMA
#undef PG8_WAIT_V
#undef PG8_WAIT_L
#undef PG8_BAR
#undef PG8_SCHED
}
}
using pg8::Unit;

typedef const f32x4 (&AccRef)[2][2][4][2];

typedef f32x4 (&AccMut)[2][2][4][2];
__device__ __forceinline__ void acc_zero(AccMut acc) {
#pragma unroll
    for (int a = 0; a < 2; ++a)
#pragma unroll
        for (int b = 0; b < 2; ++b)
#pragma unroll
            for (int m = 0; m < 4; ++m)
#pragma unroll
                for (int n = 0; n < 2; ++n) acc[a][b][m][n] = (f32x4){0.f, 0.f, 0.f, 0.f};
}
__device__ __forceinline__ void acc_bias(AccMut acc, const float* bcol  ) {
#pragma unroll
    for (int b = 0; b < 2; ++b)
#pragma unroll
        for (int n = 0; n < 2; ++n) { const f32x4 bv = *(const f32x4*)(bcol + b * 128 + 4 * n);
#pragma unroll
            for (int a = 0; a < 2; ++a)
#pragma unroll
                for (int m = 0; m < 4; ++m) acc[a][b][m][n] = bv; }
}
struct EpiIn {
    bf16_t* H; const float* bias;
    __device__ __forceinline__ void init(AccMut acc, const Unit& u, int wr, int wc, int fr, int fq) const { acc_bias(acc, bias + u.pn * 256 + wc * 32 + 8 * fq); }
    template <int MODE> __device__ __forceinline__ void body(AccRef acc, int row0, size_t hc, int ld) const {
#pragma unroll
        for (int ai = 0; ai < 2; ++ai)
#pragma unroll
            for (int m = 0; m < 4; ++m) { bf16_t* rowp = H + (size_t)(row0 + ai * 128 + m * 16) * ld + hc;
#pragma unroll
                for (int bj = 0; bj < 2; ++bj) { f32x4 v0 = acc[ai][bj][m][0], v1 = acc[ai][bj][m][1];
                    if (MODE == 1) { v0 = silu4(v0); v1 = silu4(v1); }
                    if (MODE == 2) { v0 = sig4(v0); v1 = sig4(v1); }
                    *(u32x4*)(rowp + bj * 128) = pack8(v0, v1); } }
    }
    __device__ __forceinline__ void operator()(AccRef acc, const Unit& u, int wr, int wc, int fr, int fq) const {
        const int pn = u.pn; int mode, ld; size_t hc;
        if (pn < 2) { mode = 0; hc = SEG_F + pn * 256; ld = LDF; } else if (pn < 4) { mode = 1; hc = SEG_F + pn * 256; ld = LDF; }
        else if (pn < 8) { mode = 0; hc = SEG_P + (pn - 4) * 256; ld = LDP; } else if (pn < 12) { mode = 1; hc = SEG_P + (pn - 4) * 256; ld = LDP; }
        else if (pn < 16) { mode = 3; hc = SEG_C + (pn - 12) * 128; ld = LDC; } else if (pn < 18) { mode = 1; hc = SEG_C + 512 + (pn - 16) * 256; ld = LDC; }
        else { const int e = (pn - 18) * 256; mode = 2; hc = SEG_G + (size_t)(e >> 11) * M_TOK * LDG + (e & 2047); ld = LDG; }
        const int row0 = u.pm * 256 + wr * 64 + fr, lc = wc * 32 + 8 * fq;
        hc += lc;
        if (mode == 3) {
#pragma unroll
            for (int ai = 0; ai < 2; ++ai)
#pragma unroll
                for (int m = 0; m < 4; ++m) { bf16_t* rowp = H + (size_t)(row0 + ai * 128 + m * 16) * ld + hc;
                    const f32x4 a0 = acc[ai][0][m][0], a1 = acc[ai][0][m][1], g0 = acc[ai][1][m][0], g1 = acc[ai][1][m][1];
                    *(u32x4*)rowp = pack8(a0 * sig4(g0), a1 * sig4(g1)); }
        } else if (mode == 0) body<0>(acc, row0, hc, ld);
        else if (mode == 1) body<1>(acc, row0, hc, ld);
        else body<2>(acc, row0, hc, ld);
    }
};
struct EpiFnet {
    bf16_t* H;
    __device__ __forceinline__ void init(AccMut acc, const Unit&, int, int, int, int) const { acc_zero(acc); }
    __device__ __forceinline__ void operator()(AccRef acc, const Unit& u, int wr, int wc, int fr, int fq) const {
        const float sc = (u.pm < 64) ? 0.001953125f   : 0.0009765625f  ;
        const int row0 = u.pm * 256 + wr * 64 + fr, c0 = 512 + u.pn * 256 + wc * 32 + 8 * fq;
#pragma unroll
        for (int ai = 0; ai < 2; ++ai) {
            u32x4 zw[4][2];
#pragma unroll
            for (int m = 0; m < 4; ++m)
#pragma unroll
                for (int bj = 0; bj < 2; ++bj) zw[m][bj] = *(const u32x4*)(H + SEG_F + (size_t)(row0 + ai * 128 + m * 16) * LDF + c0 + bj * 128);
#pragma unroll
            for (int m = 0; m < 4; ++m) { bf16_t* rowp = H + SEG_F + (size_t)(row0 + ai * 128 + m * 16) * LDF + c0;
#pragma unroll
                for (int bj = 0; bj < 2; ++bj) { f32x4 z0, z1; unpack8(zw[m][bj], z0, z1);
                    *(u32x4*)(rowp + bj * 128) = pack8(acc[ai][bj][m][0] * sc * z0, acc[ai][bj][m][1] * sc * z1); } }
            asm volatile("" ::: "memory");
        }
    }
};
template <bool FIRST> struct EpiMerge {
    bf16_t* MRG; const bf16_t* gate;
    __device__ __forceinline__ void init(AccMut acc, const Unit&, int, int, int, int) const { acc_zero(acc); }
    __device__ __forceinline__ void operator()(AccRef acc, const Unit& u, int wr, int wc, int fr, int fq) const {
        const int row0 = u.pm * 256 + wr * 64 + fr, c0 = u.pn * 256 + wc * 32 + 8 * fq;
        constexpr int NB = 4;
#pragma unroll
        for (int ai = 0; ai < 2; ++ai)
#pragma unroll
        for (int mh = 0; mh < 4; mh += NB) {
            u32x4 gw[NB][2], pw[NB][2];
#pragma unroll
            for (int mm = 0; mm < NB; ++mm)
#pragma unroll
                for (int bj = 0; bj < 2; ++bj) { const size_t row = (size_t)(row0 + ai * 128 + (mh + mm) * 16);
                    gw[mm][bj] = *(const u32x4*)(gate + row * LDG + c0 + bj * 128);
                    if constexpr (FIRST) pw[mm][bj] = (u32x4){0u, 0u, 0u, 0u}; else pw[mm][bj] = *(const u32x4*)(MRG + row * DM + c0 + bj * 128); }
#pragma unroll
            for (int mm = 0; mm < NB; ++mm) { const int m = mh + mm; bf16_t* mp = MRG + (size_t)(row0 + ai * 128 + m * 16) * DM + c0;
#pragma unroll
                for (int bj = 0; bj < 2; ++bj) { f32x4 g0, g1, p0, p1; unpack8(gw[mm][bj], g0, g1); unpack8(pw[mm][bj], p0, p1);
                    *(u32x4*)(mp + bj * 128) = pack8(g0 * acc[ai][bj][m][0] + p0, g1 * acc[ai][bj][m][1] + p1); } }
            asm volatile("" ::: "memory");
        }
    }
};
struct EpiOut {
    float* X; const float* bias; const float* lng; bf16_t* YG; float* stats;
    __device__ __forceinline__ void init(AccMut acc, const Unit& u, int wr, int wc, int fr, int fq) const { acc_bias(acc, bias + u.pn * 256 + wc * 32 + 8 * fq); }
    __device__ __forceinline__ void operator()(AccRef acc, const Unit& u, int wr, int wc, int fr, int fq) const {
        const int row0 = u.pm * 256 + wr * 64 + fr, c0 = u.pn * 256 + wc * 32 + 8 * fq;
#pragma unroll
        for (int bj = 0; bj < 2; ++bj) {
            const f32x4 gv0 = *(const f32x4*)(lng + c0 + bj * 128), gv1 = *(const f32x4*)(lng + c0 + bj * 128 + 4);
#pragma unroll
            for (int ai = 0; ai < 2; ++ai)
#pragma unroll
            for (int mh = 0; mh < 4; mh += 4) {
                f32x4 xv[4][2];
#pragma unroll
                for (int m = mh; m < mh + 4; ++m)
#pragma unroll
                    for (int n = 0; n < 2; ++n) xv[m][n] = *(const f32x4*)(X + (size_t)(row0 + ai * 128 + m * 16) * DM + c0 + bj * 128 + 4 * n);
#pragma unroll
                for (int m = mh; m < mh + 4; ++m) { const int row = row0 + ai * 128 + m * 16; float* xp = X + (size_t)row * DM + c0 + bj * 128; bf16_t* yp = YG + (size_t)row * DM + c0 + bj * 128;
                    const f32x4 y0 = xv[m][0] * DN_ALPHA + acc[ai][bj][m][0], y1 = xv[m][1] * DN_ALPHA + acc[ai][bj][m][1];
                    *(f32x4*)xp = y0; *(f32x4*)(xp + 4) = y1;
                    *(u32x4*)yp = pack8(y0 * gv0, y1 * gv1);
                    float sm = (y0[0] + y0[1]) + (y0[2] + y0[3]) + (y1[0] + y1[1]) + (y1[2] + y1[3]);
                    float sq = (y0[0] * y0[0] + y0[1] * y0[1]) + (y0[2] * y0[2] + y0[3] * y0[3]) + (y1[0] * y1[0] + y1[1] * y1[1]) + (y1[2] * y1[2] + y1[3] * y1[3]);
                    sm += __shfl_xor(sm, 16); sq += __shfl_xor(sq, 16); sm += __shfl_xor(sm, 32); sq += __shfl_xor(sq, 32);
                    if (fq == 0) { (void)__hip_atomic_fetch_add(stats + 2 * row, sm, __ATOMIC_RELAXED, __HIP_MEMORY_SCOPE_AGENT); (void)__hip_atomic_fetch_add(stats + 2 * row + 1, sq, __ATOMIC_RELAXED, __HIP_MEMORY_SCOPE_AGENT); } }
                asm volatile("" ::: "memory");
            }
        }
    }
};
struct EpiPlain {
    bf16_t* O;
    __device__ __forceinline__ void init(AccMut acc, const Unit&, int, int, int, int) const { acc_zero(acc); }
    __device__ __forceinline__ void operator()(AccRef acc, const Unit& u, int wr, int wc, int fr, int fq) const {
        const int row0 = u.pm * 256 + wr * 64 + fr, c0 = u.pn * 256 + wc * 32 + 8 * fq;
#pragma unroll
        for (int ai = 0; ai < 2; ++ai)
#pragma unroll
            for (int m = 0; m < 4; ++m) { bf16_t* op = O + (size_t)(row0 + ai * 128 + m * 16) * DM + c0;
#pragma unroll
                for (int bj = 0; bj < 2; ++bj) *(u32x4*)(op + bj * 128) = pack8(acc[ai][bj][m][0], acc[ai][bj][m][1]); }
    }
};
struct EpiGate {
    float* X; const float* cg; const float* cb; const float* lng; const float* lnb; const bf16_t* PLEB; bf16_t* XB; const float* stats;
    __device__ __forceinline__ void init(AccMut acc, const Unit&, int, int, int, int) const { acc_zero(acc); }
    __device__ __forceinline__ void operator()(AccRef acc, const Unit& u, int wr, int wc, int fr, int fq) const {
        const int row0 = u.pm * 256 + wr * 64 + fr, c0 = u.pn * 256 + wc * 32 + 8 * fq;
#pragma unroll
        for (int bj = 0; bj < 2; ++bj) {
            const f32x4 g0 = *(const f32x4*)(lng + c0 + bj * 128), g1 = *(const f32x4*)(lng + c0 + bj * 128 + 4), b0 = *(const f32x4*)(lnb + c0 + bj * 128), b1 = *(const f32x4*)(lnb + c0 + bj * 128 + 4);
            const f32x4 cg0 = *(const f32x4*)(cg + c0 + bj * 128), cg1 = *(const f32x4*)(cg + c0 + bj * 128 + 4), cb0 = *(const f32x4*)(cb + c0 + bj * 128), cb1 = *(const f32x4*)(cb + c0 + bj * 128 + 4);
#pragma unroll
            for (int ai = 0; ai < 2; ++ai)
#pragma unroll
            for (int mh = 0; mh < 4; mh += 2) {
                u32x4 pw[4]; f32x4 yv[4][2]; f32x2 st[4];
#pragma unroll
                for (int m = mh; m < mh + 2; ++m) { const int row = row0 + ai * 128 + m * 16; const size_t ro = (size_t)row * DM + c0 + bj * 128;
                    pw[m] = *(const u32x4*)(PLEB + ro); yv[m][0] = *(const f32x4*)(X + ro); yv[m][1] = *(const f32x4*)(X + ro + 4); st[m] = *(const f32x2*)(stats + 2 * row); }
#pragma unroll
                for (int m = mh; m < mh + 2; ++m) { const int row = row0 + ai * 128 + m * 16; const size_t ro = (size_t)row * DM + c0 + bj * 128;
                    const float mu = st[m].x * (1.f / DM), var = st[m].y * (1.f / DM) - mu * mu, r = 1.f / sqrtf(var + LN_EPS);
                    f32x4 p0, p1; unpack8(pw[m], p0, p1);
                    const f32x4 x0 = (yv[m][0] - mu) * r * g0 + b0, x1 = (yv[m][1] - mu) * r * g1 + b1;
                    const f32x4 o0 = x0 + sig4((acc[ai][bj][m][0] - mu * cg0) * r + cb0) * p0, o1 = x1 + sig4((acc[ai][bj][m][1] - mu * cg1) * r + cb1) * p1;
                    *(f32x4*)(X + ro) = o0; *(f32x4*)(X + ro + 4) = o1; *(u32x4*)(XB + ro) = pack8(o0, o1); }
                asm volatile("" ::: "memory");
            }
        }
    }
};

struct Params { const float* in[25]; float* out; unsigned char* ws; int ph_lo, ph_hi; };
enum { I_XP = 0, I_XS, I_PP, I_PS, I_EG, I_EB, I_WIN, I_BIN, I_WF, I_WG, I_BG, I_PSC, I_WP, I_WDW, I_BDW, I_CG, I_CB, I_WC, I_WOUT, I_BOUT, I_LNG, I_LNB, I_WPLE, I_WPG, I_BPG };

__device__ __forceinline__ void seq_of_row(int row, int& base, int& S) {
    if (row < M_PROMPT) { S = 2048; base = row & ~2047; } else { S = 8192; base = M_PROMPT + ((row - M_PROMPT) & ~8191); }
}

__device__ __forceinline__ void ln_row(const float* src, float* dstf, bf16_t* dstb, const float* g, const float* b, int lane) {
    f32x4 v[8]; float s = 0.f;
#pragma unroll
    for (int j = 0; j < 8; ++j) { v[j] = ((const f32x4*)src)[lane + 64 * j]; s += (v[j][0] + v[j][1]) + (v[j][2] + v[j][3]); }
    const float mean = wave_sum(s) * (1.f / DM); float s2 = 0.f;
#pragma unroll
    for (int j = 0; j < 8; ++j) { v[j] = v[j] - mean; s2 += (v[j][0] * v[j][0] + v[j][1] * v[j][1]) + (v[j][2] * v[j][2] + v[j][3] * v[j][3]); }
    const float rstd = 1.f / sqrtf(wave_sum(s2) * (1.f / DM) + LN_EPS);
#pragma unroll
    for (int j = 0; j < 8; ++j) { const f32x4 gg = ((const f32x4*)g)[lane + 64 * j], bb = ((const f32x4*)b)[lane + 64 * j]; const f32x4 o = v[j] * rstd * gg + bb;
        ((f32x4*)dstf)[lane + 64 * j] = o; u32x2 w; w.x = cvt_pk_bf16(o[0], o[1]); w.y = cvt_pk_bf16(o[2], o[3]); ((u32x2*)dstb)[lane + 64 * j] = w; }
}

__device__ __forceinline__ void transpose_item(const float* W, int ldw, int col0, bf16_t* WT, int ldt, int row0, int k0, LAS float* scr, int lane) {
    { float wv[32];
#pragma unroll
    for (int i = 0; i < 32; ++i) { const int kk = 2 * i + (lane >> 5); wv[i] = W[(size_t)(k0 + kk) * ldw + col0 + (lane & 31)]; }
#pragma unroll
    for (int i = 0; i < 32; ++i) { const int kk = 2 * i + (lane >> 5); scr[kk * 33 + (lane & 31)] = wv[i]; } }
    LDS_WAIT();
    const int c = lane & 7;
#pragma unroll
    for (int j = 0; j < 4; ++j) { const int n = (lane >> 3) + 8 * j; const LAS float* s = scr + (8 * c) * 33 + n;
        u32x4 o; o.x = cvt_pk_bf16(s[0 * 33], s[1 * 33]); o.y = cvt_pk_bf16(s[2 * 33], s[3 * 33]); o.z = cvt_pk_bf16(s[4 * 33], s[5 * 33]); o.w = cvt_pk_bf16(s[6 * 33], s[7 * 33]);
        *(u32x4*)(WT + (size_t)(row0 + n) * ldt + k0 + 8 * c) = o; }
    LDS_WAIT();
}

constexpr float C32[16] = {1.000000000e+00f, 9.807852804e-01f, 9.238795325e-01f, 8.314696123e-01f, 7.071067812e-01f, 5.555702330e-01f, 3.826834324e-01f, 1.950903220e-01f, 6.123233996e-17f, -1.950903220e-01f, -3.826834324e-01f, -5.555702330e-01f, -7.071067812e-01f, -8.314696123e-01f, -9.238795325e-01f, -9.807852804e-01f};
constexpr float S32[16] = {0.000000000e+00f, 1.950903220e-01f, 3.826834324e-01f, 5.555702330e-01f, 7.071067812e-01f, 8.314696123e-01f, 9.238795325e-01f, 9.807852804e-01f, 1.000000000e+00f, 9.807852804e-01f, 9.238795325e-01f, 8.314696123e-01f, 7.071067812e-01f, 5.555702330e-01f, 3.826834324e-01f, 1.950903220e-01f};
__device__ __forceinline__ void fft_lds(LAS f32x2* X, const LAS f32x2* tw, int logR, int logCW, int tid) {
    const int CWm = (1 << logCW) - 1;
    for (int p = 0; p < logR; ++p) {
        const int lh = logR - 1 - p, half = 1 << lh;
#pragma unroll 4
        for (int it = 0; it < 16; ++it) {
            const int f = it * 512 + tid, c = f & CWm, j = f >> logCW, grp = j >> lh, pos = j & (half - 1);
            const int i0 = ((grp << (lh + 1)) + pos), i1 = i0 + half;
            const f32x2 a = X[(i0 << logCW) + c], b = X[(i1 << logCW) + c], w = tw[pos << p];
            const f32x2 d = a - b;
            X[(i0 << logCW) + c] = a + b;
            X[(i1 << logCW) + c] = (f32x2){d.x * w.x - d.y * w.y, d.x * w.y + d.y * w.x};
        }
        __syncthreads();
    }
}


#define XB_TMO      128
#define XB_XCNT(j)  (256  + 64 * (j))
#define XB_XSUB(j)  (1280 + 64 * (j))
#define XB_XGEN(j)  (2304 + 64 * (j))
#define XB_TOP      3328
#define XB_TOPGEN   3392
#define XCD_BAR_WORDS 3456
#define XB_SPIN_CAP (1u << 22)
__device__ __forceinline__ unsigned xb_ld(unsigned* p)              { return __hip_atomic_load(p, __ATOMIC_RELAXED, __HIP_MEMORY_SCOPE_AGENT); }
__device__ __forceinline__ unsigned xb_add(unsigned* p, unsigned v) { return __hip_atomic_fetch_add(p, v, __ATOMIC_RELAXED, __HIP_MEMORY_SCOPE_AGENT); }
__device__ __forceinline__ unsigned xb_xcc_id() { return (unsigned)__builtin_amdgcn_s_getreg((3 << 11) | 20) & 0xFu; }
#define XB_SPIN(cond, bar) do { unsigned _sp = 0; while (cond) { __builtin_amdgcn_s_sleep(1); \
    if ((++_sp & 255u) == 0u) { if (xb_ld(&(bar)[XB_TMO])) break; if (_sp > XB_SPIN_CAP) { atomicAdd(&(bar)[XB_TMO], 1u); break; } } } } while (0)
struct XcdBarrier { unsigned* bar; unsigned x; volatile LAS unsigned* st; };
__device__ __forceinline__ XcdBarrier xcd_barrier_post(unsigned* bar, volatile LAS unsigned* st) {
    XcdBarrier b; b.bar = bar; b.x = xb_xcc_id(); b.st = st;
    if (threadIdx.x == 0) (void)xb_add(&bar[XB_XCNT(b.x)], 1u);
    return b;
}
__device__ __forceinline__ void xcd_barrier_complete(unsigned* bar, unsigned x, unsigned& nloc, unsigned& nx) {
    const unsigned G = gridDim.x * gridDim.y * gridDim.z;
    unsigned sum, cnt, mine, sp = 0u;
    for (;;) {
        sum = 0u; cnt = 0u; mine = 0u;
#pragma unroll
        for (unsigned j = 0; j < 16; ++j) { const unsigned c = xb_ld(&bar[XB_XCNT(j)]); sum += c; cnt += (c > 0u) ? 1u : 0u; mine = (j == x) ? c : mine; }
        if (sum == G) break;
        __builtin_amdgcn_s_sleep(1);
        if ((++sp & 255u) == 0u) { if (xb_ld(&bar[XB_TMO])) break; if (sp > XB_SPIN_CAP) { atomicAdd(&bar[XB_TMO], 1u); break; } }
    }
    nloc = mine > 0u ? mine : 1u; nx = cnt > 0u ? cnt : 1u;
}
__device__ __forceinline__ void xcd_barrier(const XcdBarrier& b) {
    asm volatile("s_waitcnt vmcnt(0)" ::: "memory");
    __syncthreads();
    if (threadIdx.x == 0) {
        unsigned long long bar_ = (unsigned long long)b.bar; unsigned bx = b.x;
        asm volatile("" : "+s"(bar_), "+s"(bx));
        unsigned* bar = (unsigned*)bar_;
        __builtin_amdgcn_s_waitcnt(0);
        unsigned nloc = b.st[0], nx = b.st[1];
        if (nloc == 0u) { xcd_barrier_complete(bar, bx, nloc, nx); b.st[0] = nloc; b.st[1] = nx; }
        const unsigned old = xb_add(&bar[XB_XSUB(bx)], 1u);
        const unsigned gen = old / nloc;
        if (old + 1u == (gen + 1u) * nloc) {
            __builtin_amdgcn_fence(__ATOMIC_RELEASE, "agent");
            asm volatile("s_waitcnt vmcnt(0)" ::: "memory");
            const unsigned og = xb_add(&bar[XB_TOP], 1u);
            const unsigned tg = og / nx;
            if (og + 1u == (tg + 1u) * nx) xb_add(&bar[XB_TOPGEN], 1u);
            else XB_SPIN(xb_ld(&bar[XB_TOPGEN]) == tg, bar);
            __builtin_amdgcn_fence(__ATOMIC_ACQUIRE, "agent");
            xb_add(&bar[XB_XGEN(bx)], 1u);
            asm volatile("s_waitcnt vmcnt(0)" ::: "memory");
        } else {
            XB_SPIN(xb_ld(&bar[XB_XGEN(bx)]) == gen, bar);
            __builtin_amdgcn_fence(__ATOMIC_ACQUIRE, "agent");
            asm volatile("s_waitcnt vmcnt(0)" ::: "memory");
        }
    }
    __syncthreads();
}

typedef const __attribute__((address_space(4))) Params* KP;
__device__ __forceinline__ KP kparams() { unsigned long long k = (unsigned long long)__builtin_amdgcn_kernarg_segment_ptr(); asm volatile("" : "+s"(k)); return (KP)k; }
#define KARGS0 KP p = kparams(); unsigned char* ws = p->ws; \
    bf16_t* WT = (bf16_t*)(ws + OFF_WT); bf16_t* FC = (bf16_t*)(ws + OFF_FC); float* BIASP = (float*)(ws + OFF_BIAS); \
    bf16_t* H = (bf16_t*)(ws + OFF_H); bf16_t* MRG = (bf16_t*)(ws + OFF_MRG); bf16_t* XB = (bf16_t*)(ws + OFF_XB); f32x2* ZB = (f32x2*)(ws + OFF_XB); \
    bf16_t* XC = (bf16_t*)(ws + OFF_XC); bf16_t* PB = (bf16_t*)(ws + OFF_PB); float* PVF = (float*)(ws + OFF_PVF); \
    bf16_t* XN = (bf16_t*)(ws + OFF_XN); bf16_t* PLEB = (bf16_t*)(ws + OFF_PLEB); float* X = p->out; \
    float* CGB = (float*)(ws + OFF_CGB); float* STATS = (float*)(ws + OFF_STATS); f32x2* TWT = (f32x2*)(ws + OFF_TWT); (void)TWT; \
    (void)WT; (void)FC; (void)BIASP; (void)H; (void)MRG; (void)XB; (void)ZB; (void)XC; (void)PB; (void)PVF; (void)XN; (void)PLEB; (void)X; (void)CGB; (void)STATS;
#define KARGS KARGS0 const bf16_t* wt = WT + (size_t)l * WT_LAYER; (void)wt;
__global__ void __launch_bounds__(512, 2) fwd_megakernel(Params p_) {
    extern __shared__ __attribute__((aligned(16))) unsigned char smem[];
    cg::grid_group grid = cg::this_grid();
    LAS unsigned char* lds = (LAS unsigned char*)smem;
    const int G = gridDim.x, bid = blockIdx.x;
    const int NGW = G * 8;
    const size_t NGT = (size_t)G * 512;
    volatile LAS unsigned* xst = (volatile LAS unsigned*)(lds + 131072 + 4000);
    if (threadIdx.x < 2) xst[threadIdx.x] = 0u;
    __syncthreads();
    const XcdBarrier xbar = xcd_barrier_post((unsigned*)(kparams()->ws + OFF_BAR), xst);

    if (PHM & 1)
    {
        TID_VARS
            KARGS0
        const float* w_in = p->in[I_WIN]; const float* wg = p->in[I_WG];
        for (int task = gw; task < DEPTH * 512 * 4; task += NGW) {
            const int g = task & 3, kb = (task >> 2) & 511, l = task >> 11;
            const float* a = w_in + ((size_t)l * DM + kb * 4) * NIN + 1024 + g * 256;
            const float* b = wg + ((size_t)(l * 4 + g) * 256) * 256 + 4 * lane;
            f32x4 acc0 = {0, 0, 0, 0}, acc1 = acc0, acc2 = acc0, acc3 = acc0;
#pragma unroll 8
            for (int c = 0; c < 256; ++c) { const f32x4 bv = *(const f32x4*)(b + (size_t)c * 256);
                acc0 += a[c] * bv; acc1 += a[NIN + c] * bv; acc2 += a[2 * NIN + c] * bv; acc3 += a[3 * NIN + c] * bv; }
            float* o = PVF + ((size_t)l * DM + kb * 4) * 1024 + g * 256 + 4 * lane;
            *(f32x4*)o = acc0; *(f32x4*)(o + 1024) = acc1; *(f32x4*)(o + 2048) = acc2; *(f32x4*)(o + 3072) = acc3;
        }
        const float* b_in = p->in[I_BIN];
        for (size_t e = gt; e < (size_t)DEPTH * NIN; e += NGT) {
            const int l = (int)(e / NIN), n = (int)(e % NIN); float v;
            if (n >= 1024 && n < 2048) v = 0.f;
            else if (n >= 3072 && n < 4096) { const int j = (n - 3072) >> 8, lc = (n - 3072) & 255; v = b_in[(size_t)l * NIN + (lc < 128 ? 3072 + j * 128 + lc : 3584 + j * 128 + (lc - 128))]; }
            else v = b_in[(size_t)l * NIN + n];
            BIASP[e] = v;
        }
        for (size_t e = gt; e < (size_t)512 * 1024; e += NGT) {
            const int r = (int)(e >> 10), q = (int)(e & 1023), g = r >> 7, d = r & 127, half = q >> 9, g2 = (q >> 7) & 3, c = q & 127;
            float v = 0.f;
            if (g == g2) { const float ang = (float)((c * d) & 127) * (1.0f / 64.0f); v = half ? sinpif(ang) : cospif(ang); }
            FC[e] = (bf16_t)(cvt_pk_bf16(v, 0.f) & 0xffffu);
        }
        for (size_t e = gt; e < (size_t)DEPTH * DM * 16; e += NGT) {
            const int kc = (int)(e / ((size_t)DEPTH * DM)), le = (int)(e % ((size_t)DEPTH * DM)), l = le / DM, col = le % DM;
            const float* w = p->in[I_WPG] + ((size_t)l * DM + kc * 128) * DM + col; const float* g = p->in[I_LNG] + l * DM + kc * 128; const float* b = p->in[I_LNB] + l * DM + kc * 128;
            float sg = 0.f, sb = (kc == 0) ? p->in[I_BPG][l * DM + col] : 0.f;
#pragma unroll 8
            for (int k = 0; k < 128; ++k) { const float wv = w[(size_t)k * DM]; sg += g[k] * wv; sb += b[k] * wv; }
            (void)__hip_atomic_fetch_add(CGB + ((size_t)l * 2 + 0) * DM + col, sg, __ATOMIC_RELAXED, __HIP_MEMORY_SCOPE_AGENT);
            (void)__hip_atomic_fetch_add(CGB + ((size_t)l * 2 + 1) * DM + col, sb, __ATOMIC_RELAXED, __HIP_MEMORY_SCOPE_AGENT);
        }
        for (size_t e = gt; e < (size_t)TW_N; e += NGT) {
            float ang;
            if (e < (size_t)TW_RA) { const int big = e >= (size_t)TW_2B, ee = (int)e - (big ? TW_2B : 0), n1 = ee >> 5, i2 = ee & 31, k2 = (int)(__brev((unsigned)i2) >> 27), lS = big ? 13 : 11;
                ang = (float)((k2 * n1) & ((1 << lS) - 1)) * (2.0f / (float)(1 << lS)); }
            else if (e < (size_t)TW_RB) ang = (float)(e - TW_RA) * (2.0f / 64.f);
            else if (e < (size_t)TW_RC) ang = (float)(e - TW_RB) * (2.0f / 256.f);
            else ang = (float)(e - TW_RC) * (2.0f / 32.f);
            TWT[e] = (f32x2){cospif(ang), -sinpif(ang)};
        }
        for (int row = gw; row < M_TOK; row += NGW) {
            const float* src = row < M_PROMPT ? p->in[I_XP] + (size_t)row * DM : p->in[I_XS] + (size_t)(row - M_PROMPT) * DM;
            ln_row(src, X + (size_t)row * DM, XB + (size_t)row * DM, p->in[I_EG], p->in[I_EB], lane);
        }
    }
    CG_SYNC();
    if (PHM & 2)
    {
        TID_VARS
            KARGS0
        LAS float* scr = (LAS float*)(lds + wave * 16384);
        constexpr int IT_IN = 32 * 336, IT_F = 8 * 64, IT_P = 16 * 64, IT_C = 8 * 64, IT_OUT = 32 * 64, IT_PG = 32 * 64, IT_PLE = 4 * 64;
        constexpr int IT_LAYER = IT_IN + IT_F + IT_P + IT_C + IT_OUT + IT_PG + IT_PLE;
        for (int it = gw; it < DEPTH * IT_LAYER; it += NGW) {
            const int l = it / IT_LAYER; int r = it % IT_LAYER;
            bf16_t* wt = WT + (size_t)l * WT_LAYER;
            if (r < IT_IN) {
                const int kb = r / 336, nb = r % 336, n0 = nb * 32, k0 = kb * 64;
                const float* src = p->in[I_WIN] + (size_t)l * DM * NIN; int ldw = NIN, col0 = n0;
                if (n0 >= 1024 && n0 < 2048) { src = PVF + (size_t)l * DM * 1024; ldw = 1024; col0 = n0 - 1024; }
                else if (n0 >= 3072 && n0 < 4096) { const int j = (n0 - 3072) >> 8, lc = (n0 - 3072) & 255; col0 = lc < 128 ? 3072 + j * 128 + lc : 3584 + j * 128 + (lc - 128); }
                transpose_item(src, ldw, col0, wt + WT_IN, DM, n0, k0, scr, lane); continue; }
            r -= IT_IN;
            if (r < IT_F) { transpose_item(p->in[I_WF] + (size_t)l * 512 * DM, DM, (r % 64) * 32, wt + WT_F, 512, (r % 64) * 32, (r / 64) * 64, scr, lane); continue; }
            r -= IT_F;
            if (r < IT_P) { transpose_item(p->in[I_WP] + (size_t)l * 1024 * DM, DM, (r % 64) * 32, wt + WT_P, 1024, (r % 64) * 32, (r / 64) * 64, scr, lane); continue; }
            r -= IT_P;
            if (r < IT_C) { transpose_item(p->in[I_WC] + (size_t)l * 512 * DM, DM, (r % 64) * 32, wt + WT_C, 512, (r % 64) * 32, (r / 64) * 64, scr, lane); continue; }
            r -= IT_C;
            if (r < IT_OUT) { transpose_item(p->in[I_WOUT] + (size_t)l * DM * DM, DM, (r % 64) * 32, wt + WT_OUT, DM, (r % 64) * 32, (r / 64) * 64, scr, lane); continue; }
            r -= IT_OUT;
            if (r < IT_PG) { transpose_item(p->in[I_WPG] + (size_t)l * DM * DM, DM, (r % 64) * 32, wt + WT_PG, DM, (r % 64) * 32, (r / 64) * 64, scr, lane); continue; }
            r -= IT_PG;
            transpose_item(p->in[I_WPLE] + (size_t)l * PLE * DM, DM, (r % 64) * 32, wt + WT_PLE, PLE, (r % 64) * 32, (r / 64) * 64, scr, lane);
        }
    }
    GRID_SYNC();

    LAS f32x2* FX = (LAS f32x2*)lds;
    LAS f32x2* TW = (LAS f32x2*)(lds + 131072);
    LAS f32x2* TW2 = (LAS f32x2*)(lds + 131072 + 2048);

    for (int l = 0; l < DEPTH; ++l) {
        if (PHM & 4)
        {
            TID_VARS
            KARGS
            pg8::Gemm g{XB, wt + WT_IN, M_TOK, NIN, DM, DM, DM}; pg8::StaticOrder S; S.init(M_TOK, NIN, G, bid);
            EpiIn E{H, BIASP + (size_t)l * NIN};
            pg8::gemm_phase(lds, g, S, E, tid);
        }
        GRID_SYNC();
        if (PHM & 8)
        {
            TID_VARS
            KARGS
            if (tid < 16) TW[tid] = TWT[TW_RC + tid];
            for (int t = bid; t < 1024; t += G) {
                int base, n1, S1, lS;
                if (t < 512) { base = (t >> 6) * 2048; n1 = t & 63; S1 = 64; lS = 11; } else { const int tt = t - 512; base = M_PROMPT + (tt >> 8) * 8192; n1 = tt & 255; S1 = 256; lS = 13; }
                __syncthreads();
                if (tid < 32) TW2[tid] = TWT[(t < 512 ? TW_2A : TW_2B) + n1 * 32 + tid];
                { bf16_t hv[32];
#pragma unroll
                for (int n2 = 0; n2 < 32; ++n2) hv[n2] = H[SEG_F + (size_t)(base + n1 + S1 * n2) * LDF + tid];
                __syncthreads();
                float re[32], im[32];
#pragma unroll
                for (int n2 = 0; n2 < 32; ++n2) { re[n2] = bf1(hv[n2]); im[n2] = 0.f; }
#pragma unroll
                for (int ps = 0; ps < 5; ++ps) {
#pragma unroll
                    for (int j = 0; j < 16; ++j) {
                        const int half = 16 >> ps, grp = j >> (4 - ps), pos = j & (half - 1), i0 = (grp << (5 - ps)) + pos, i1 = i0 + half, m = pos << ps;
                        const float ar = re[i0], ai = im[i0], br = re[i1], bi = im[i1], dr = ar - br, di = ai - bi;
                        re[i0] = ar + br; im[i0] = ai + bi;
                        re[i1] = dr * C32[m] + di * S32[m]; im[i1] = di * C32[m] - dr * S32[m];
                    }
                }
#pragma unroll
                for (int i2 = 0; i2 < 32; ++i2) { const int k2 = ((i2 & 1) << 4) | ((i2 & 2) << 2) | (i2 & 4) | ((i2 & 8) >> 2) | ((i2 & 16) >> 4); const f32x2 w = TW2[i2];
                    ZB[(size_t)(base + k2 * S1 + n1) * 512 + tid] = (f32x2){re[i2] * w.x - im[i2] * w.y, re[i2] * w.y + im[i2] * w.x}; } }
            }
            __syncthreads();
            {
                LAS float* WD = (LAS float*)lds;
                LAS unsigned char* VT = lds + 63488;
                const float* wdw = p->in[I_WDW] + (size_t)l * 31 * 512;
                for (int e = tid; e < 31 * 512; e += 512) WD[e] = wdw[e];
                const float* bdw = p->in[I_BDW] + l * 512 + 8 * lane; const float* cg_ = p->in[I_CG] + l * 512 + 8 * lane; const float* cb_ = p->in[I_CB] + l * 512 + 8 * lane;
                const f32x4 bd0 = *(const f32x4*)bdw, bd1 = *(const f32x4*)(bdw + 4), lg0 = *(const f32x4*)cg_, lg1 = *(const f32x4*)(cg_ + 4), lb0 = *(const f32x4*)cb_, lb1 = *(const f32x4*)(cb_ + 4);
                for (int rb = bid; rb < M_TOK / 128; rb += G)
                for (int c = 0; c < 4; ++c) {
                    const int R0 = rb * 128 + 32 * c; int base, S; seq_of_row(R0, base, S); const int t0 = R0 - base;
                    __syncthreads();
#pragma unroll
                    for (int it = 0; it < 8; ++it) { const int idx = it * 512 + tid; if (idx < 62 * 64) { const int q = idx >> 6, c16 = idx & 63, tt = t0 - 15 + q;
                        u32x4 v = {0u, 0u, 0u, 0u}; if (tt >= 0 && tt < S) v = *(const u32x4*)(H + SEG_C + (size_t)(base + tt) * LDC + c16 * 8);
                        *(LAS u32x4*)(VT + q * 1024 + c16 * 16) = v; } }
                    __syncthreads();
                    for (int i = wave; i < 32; i += 8) {
                        bf16_t* zp = H + SEG_C + (size_t)(R0 + i) * LDC + 512 + 8 * lane;
                        const u32x4 zw = *(const u32x4*)zp;
                        f32x4 a0 = bd0, a1 = bd1;
#pragma unroll 4
                        for (int j = 0; j < 31; ++j) {
                            f32x4 v0, v1; unpack8(*(const LAS u32x4*)(VT + (i + j) * 1024 + lane * 16), v0, v1);
                            const f32x4 w0 = *(const LAS f32x4*)(WD + j * 512 + 8 * lane), w1 = *(const LAS f32x4*)(WD + j * 512 + 8 * lane + 4);
                            a0 += w0 * v0; a1 += w1 * v1;
                        }
                        const float mean = wave_sum((a0[0] + a0[1]) + (a0[2] + a0[3]) + (a1[0] + a1[1]) + (a1[2] + a1[3])) * (1.f / 512.f);
                        a0 = a0 - mean; a1 = a1 - mean;
                        const float var = wave_sum((a0[0] * a0[0] + a0[1] * a0[1]) + (a0[2] * a0[2] + a0[3] * a0[3]) + (a1[0] * a1[0] + a1[1] * a1[1]) + (a1[2] * a1[2] + a1[3] * a1[3])) * (1.f / 512.f);
                        const float rstd = 1.f / sqrtf(var + LN_EPS);
                        f32x4 y0 = a0 * rstd * lg0 + lb0, y1 = a1 * rstd * lg1 + lb1;
                        f32x4 z0, z1; unpack8(zw, z0, z1);
                        *(u32x4*)zp = pack8(silu4(y0) * z0, silu4(y1) * z1);
                    }
                }
            }
            {
                const float* bg = p->in[I_BG] + l * 1024; const float* psc = p->in[I_PSC] + l * 1024;
                for (int rb = bid; rb < M_TOK / 128; rb += G) {
                const int R0 = rb * 128; int base, S; seq_of_row(R0, base, S); const int t0 = R0 - base;
                for (int g = 0; g < 4; ++g) {
                    const int hw = 1 << g, NR = 128 + 2 * hw;
                    __syncthreads();
                    for (int idx = tid; idx < NR * 32; idx += 512) { const int q = idx >> 5, c16 = idx & 31, tt = t0 - hw + q;
                        u32x4 v = {0u, 0u, 0u, 0u}; if (tt >= 0 && tt < S) v = *(const u32x4*)(H + SEG_P + (size_t)(base + tt) * LDP + g * 256 + c16 * 8);
                        *(LAS u32x4*)(lds + q * 512 + c16 * 16) = v; }
                    __syncthreads();
                    u32x4 zws[8];
#pragma unroll
                    for (int k = 0; k < 8; ++k) { const int o = k * 512 + tid, r = o >> 5, chl = o & 31, ch = g * 32 + chl; zws[k] = *(const u32x4*)(H + SEG_P + (size_t)(R0 + r) * LDP + 1024 + ch * 8); }
                    const int chl_ = tid & 31, ch_ = g * 32 + chl_;
                    const f32x4 b0 = *(const f32x4*)(bg + ch_ * 8), b1 = *(const f32x4*)(bg + ch_ * 8 + 4), q0 = *(const f32x4*)(psc + ch_ * 8), q1 = *(const f32x4*)(psc + ch_ * 8 + 4);
#pragma unroll
                    for (int k = 0; k < 8; ++k) {
                        const int o = k * 512 + tid, r = o >> 5, chl = o & 31, t = t0 + r, ch = g * 32 + chl;
                        bf16_t* zp = H + SEG_P + (size_t)(R0 + r) * LDP + 1024 + ch * 8;
                        f32x4 s0 = {0, 0, 0, 0}, s1 = s0;
                        for (int kk = 0; kk < 2 * hw; ++kk) { f32x4 v0, v1; unpack8(*(const LAS u32x4*)(lds + (r + kk) * 512 + chl * 16), v0, v1); s0 += v0; s1 += v1; }
                        f32x4 c0, c1; unpack8(*(const LAS u32x4*)(lds + (r + hw) * 512 + chl * 16), c0, c1);
                        const float inv = 1.0f / (float)(min(t + hw, S) - max(t - hw, 0));
                        f32x4 z0, z1; unpack8(zws[k], z0, z1);
                        *(u32x4*)zp = pack8(((s0 * inv - c0) + b0) * q0 * z0, ((s1 * inv - c1) + b1) * q1 * z1);
                    }
                }
                }
            }
            {
                for (size_t e = gt; e < (size_t)M_TOK * 2; e += NGT) STATS[e] = 0.f;
                const float* pp = p->in[I_PP] + (size_t)l * M_PROMPT * PLE; const float* ps = p->in[I_PS] + (size_t)l * M_PROMPT * PLE;
#pragma unroll 4
                for (size_t e = gt; e < (size_t)M_TOK * PLE / 8; e += NGT) {
                    const size_t o = e * 8; const float* src = o < (size_t)M_PROMPT * PLE ? pp + o : ps + (o - (size_t)M_PROMPT * PLE);
                    *(u32x4*)(PB + o) = pack8(*(const f32x4*)src, *(const f32x4*)(src + 4));
                }
            }
        }
        GRID_SYNC();
        if (PHM & 16)
        {
            TID_VARS
            KARGS
            for (int t = bid; t < 1024; t += G) {
                int base, k2, cc, lR, lCW;
                if (t < 512) { base = (t >> 6) * 2048; const int rem = t & 63; k2 = rem >> 1; cc = rem & 1; lR = 6; lCW = 8; }
                else { const int tt = t - 512; base = M_PROMPT + (tt >> 8) * 8192; const int rem = tt & 255; k2 = rem >> 3; cc = rem & 7; lR = 8; lCW = 6; }
                const int R = 1 << lR, CWm = (1 << lCW) - 1;
                __syncthreads();
                if (tid < (R >> 1)) TW[tid] = TWT[(lR == 6 ? TW_RA : TW_RB) + tid];
                const f32x2* zsrc = ZB + (size_t)(base + k2 * R) * 512 + (cc << lCW);
#pragma unroll
                for (int ih = 0; ih < 32; ih += 16) { f32x2 zv[16];
#pragma unroll
                    for (int it = 0; it < 16; ++it) { const int f = (ih + it) * 512 + tid, c = f & CWm, n1 = f >> lCW; zv[it] = zsrc[(size_t)n1 * 512 + c]; }
#pragma unroll
                    for (int it = 0; it < 16; ++it) FX[(ih + it) * 512 + tid] = zv[it]; }
                __syncthreads();
                fft_lds(FX, TW, lR, lCW, tid);
#pragma unroll 8
                for (int it = 0; it < 32; ++it) { const int f = it * 512 + tid, c = f & CWm, i1 = f >> lCW; const int k1 = (int)(__brev((unsigned)i1) >> (32 - lR));
                    const f32x2 z = FX[f]; bf16_t* o = XC + (size_t)(base + k2 + 32 * k1) * 1024 + (cc << lCW) + c;
                    o[0] = (bf16_t)(cvt_pk_bf16(z.x, 0.f) & 0xffffu); o[512] = (bf16_t)(cvt_pk_bf16(z.y, 0.f) & 0xffffu); }
            }
            __syncthreads();
            { const int tid = opaque_tid(); pg8::Gemm g{H + SEG_P + 1024, wt + WT_P, M_TOK, DM, 1024, LDP, 1024}; pg8::StaticOrder S; S.init(M_TOK, DM, G, bid);
              EpiMerge<true> E{MRG, H + SEG_G + (size_t)M_TOK * LDG}; pg8::gemm_phase(lds, g, S, E, tid); }
            { const int tid = opaque_tid(); pg8::Gemm g{H + SEG_C + 512, wt + WT_C, M_TOK, DM, 512, LDC, 512}; pg8::StaticOrder S; S.init(M_TOK, DM, G, bid);
              EpiMerge<false> E{MRG, H + SEG_G + (size_t)2 * M_TOK * LDG}; pg8::gemm_phase(lds, g, S, E, tid); }
        }
        GRID_SYNC();
        if (PHM & 32)
        {
            TID_VARS
            KARGS
            pg8::Gemm g{XC, FC, M_TOK, 512, 1024, 1024, 1024}; pg8::StaticOrder S; S.init(M_TOK, 512, G, bid);
            EpiFnet E{H}; pg8::gemm_phase(lds, g, S, E, tid);
        }
        GRID_SYNC();
        if (PHM & 64)
        {
            TID_VARS
            KARGS
            pg8::Gemm g{H + SEG_F + 512, wt + WT_F, M_TOK, DM, 512, LDF, 512}; pg8::StaticOrder S; S.init(M_TOK, DM, G, bid);
            EpiMerge<false> E{MRG, H + SEG_G}; pg8::gemm_phase(lds, g, S, E, tid);
        }
        GRID_SYNC();
        if (PHM & 128)
        {
            TID_VARS
            KARGS
            { const int tid = opaque_tid(); pg8::Gemm g{MRG, wt + WT_OUT, M_TOK, DM, DM, DM, DM}; pg8::StaticOrder S; S.init(M_TOK, DM, G, bid);
              EpiOut E{X, p->in[I_BOUT] + (size_t)l * DM, p->in[I_LNG] + (size_t)l * DM, XN, STATS}; pg8::gemm_phase(lds, g, S, E, tid); }
            { const int tid = opaque_tid(); pg8::Gemm g{PB, wt + WT_PLE, M_TOK, DM, PLE, PLE, PLE}; pg8::StaticOrder S; S.init(M_TOK, DM, G, bid);
              EpiPlain E{PLEB}; pg8::gemm_phase(lds, g, S, E, tid); }
        }
        GRID_SYNC();
        if (PHM & 512)
        {
            TID_VARS
            KARGS
            pg8::Gemm g{XN, wt + WT_PG, M_TOK, DM, DM, DM, DM}; pg8::StaticOrder S; S.init(M_TOK, DM, G, bid);
            EpiGate E{X, CGB + ((size_t)l * 2 + 0) * DM, CGB + ((size_t)l * 2 + 1) * DM, p->in[I_LNG] + (size_t)l * DM, p->in[I_LNB] + (size_t)l * DM, PLEB, XB, STATS}; pg8::gemm_phase(lds, g, S, E, tid);
        }
        if (l + 1 < DEPTH) GRID_SYNC();
    }
}

extern "C" void kernel_launch(void* const* d_in, const int* in_sizes, int n_in, void* d_out, int out_size, void* d_ws, size_t ws_size, hipStream_t stream) {
    static int grid_blocks = 0;
    if (grid_blocks == 0) {
        if (n_in != 25 || out_size != M_TOK * DM || ws_size < WS_END2) { fprintf(stderr, "kernel_launch: unexpected shapes: n_in %d out %d ws %zu (need %zu)\n", n_in, out_size, ws_size, (size_t)WS_END2); grid_blocks = -1; return; }
        int dev = 0, cus = 0, per_cu = 0;
        hipGetDevice(&dev);
        hipDeviceGetAttribute(&cus, hipDeviceAttributeMultiprocessorCount, dev);
        if (hipFuncSetAttribute((const void*)fwd_megakernel, hipFuncAttributeMaxDynamicSharedMemorySize, LDS_BYTES) != hipSuccess) { fprintf(stderr, "kernel_launch: hipFuncSetAttribute failed\n"); grid_blocks = -1; return; }
        hipOccupancyMaxActiveBlocksPerMultiprocessor(&per_cu, (const void*)fwd_megakernel, 512, LDS_BYTES);
        if (per_cu < 1) { fprintf(stderr, "kernel_launch: occupancy query says %d blocks per CU\n", per_cu); per_cu = 1; }
        (void)hipGetLastError();
        grid_blocks = cus;
    }
    if (grid_blocks < 0) return;
    if (hipMemsetAsync((char*)d_ws + OFF_BAR, 0, 16384 + (size_t)DEPTH * 2 * DM * 4, stream) != hipSuccess) { fprintf(stderr, "kernel_launch: memset failed\n"); return; }
    Params p{};
    for (int i = 0; i < 25; ++i) p.in[i] = (const float*)d_in[i];
    p.out = (float*)d_out; p.ws = (unsigned char*)d_ws; p.ph_lo = 0; p.ph_hi = 1000;
    void* args[] = {&p};
    hipError_t e = hipLaunchCooperativeKernel((const void*)fwd_megakernel, dim3(grid_blocks), dim3(512), args, LDS_BYTES, stream);
    if (e != hipSuccess) fprintf(stderr, "cooperative launch failed: %s (grid %d)\n", hipGetErrorString(e), grid_blocks);
}
```

```cpp
#include <hip/hip_runtime.h>
#include <hip/hip_cooperative_groups.h>
#include <cstdio>
namespace cg = cooperative_groups;

#define LAS __attribute__((address_space(3)))
typedef unsigned short bf16_t;
typedef short bf16x8 __attribute__((ext_vector_type(8)));
typedef float f32x4 __attribute__((ext_vector_type(4)));
typedef float f32x2 __attribute__((ext_vector_type(2)));
typedef unsigned u32x4 __attribute__((ext_vector_type(4)));
typedef unsigned u32x2 __attribute__((ext_vector_type(2)));

constexpr int M_TOK = 32768, M_PROMPT = 16384, DM = 2048, NIN = 10752, LDH = 10240, DEPTH = 4, PLE = 256;
constexpr size_t SEG_F = 0, SEG_P = SEG_F + (size_t)M_TOK * 1024, SEG_C = SEG_P + (size_t)M_TOK * 2048, SEG_G = SEG_C + (size_t)M_TOK * 1024;
constexpr int LDF = 1024, LDP = 2048, LDC = 1024, LDG = 2048;
constexpr float LN_EPS = 1e-5f;
constexpr float DN_ALPHA = 1.6817928305074290f;
constexpr size_t WT_IN = 0, WT_F = (size_t)NIN * DM, WT_P = WT_F + (size_t)DM * 512, WT_C = WT_P + (size_t)DM * 1024, WT_OUT = WT_C + (size_t)DM * 512,
                 WT_PG = WT_OUT + (size_t)DM * DM, WT_PLE = WT_PG + (size_t)DM * DM, WT_LAYER = WT_PLE + (size_t)DM * PLE;
constexpr size_t OFF_WT = 0;
constexpr size_t OFF_FC = OFF_WT + (size_t)DEPTH * WT_LAYER * 2;
constexpr size_t OFF_BIAS = OFF_FC + (size_t)512 * 1024 * 2;
constexpr size_t OFF_H = OFF_BIAS + (size_t)DEPTH * NIN * 4;
constexpr size_t OFF_MRG = OFF_H + (size_t)M_TOK * LDH * 2;
constexpr size_t OFF_XB = OFF_MRG + (size_t)M_TOK * DM * 2;
constexpr size_t OFF_XC = OFF_XB + (size_t)M_TOK * DM * 2;
constexpr size_t OFF_PB = OFF_XC + (size_t)M_TOK * 1024 * 2;
constexpr size_t WS_END = OFF_PB + (size_t)M_TOK * PLE * 2;
constexpr size_t OFF_BAR = WS_END;
constexpr size_t OFF_CGB = OFF_BAR + 16384;
constexpr size_t OFF_STATS = OFF_CGB + (size_t)DEPTH * 2 * DM * 4;
constexpr size_t OFF_TWT = OFF_STATS + (size_t)M_TOK * 2 * 4;
constexpr int TW_2A = 0, TW_2B = 64 * 32, TW_RA = TW_2B + 256 * 32, TW_RB = TW_RA + 32, TW_RC = TW_RB + 128, TW_N = TW_RC + 16;
constexpr size_t WS_END2 = OFF_TWT + (size_t)TW_N * 8;
constexpr size_t OFF_PVF = OFF_H;
constexpr size_t OFF_XN = OFF_H;
constexpr size_t OFF_PLEB = OFF_H + (size_t)M_TOK * DM * 2;
static_assert(OFF_FC % 256 == 0 && OFF_BIAS % 256 == 0 && OFF_H % 256 == 0 && OFF_MRG % 256 == 0 && OFF_XB % 256 == 0 && OFF_XC % 256 == 0 && OFF_PB % 256 == 0, "align");

constexpr int LDS_BYTES = 131072 + 4096;
#ifndef PHM
#define PHM 0xFFFF
#endif

typedef __bf16 bf16x2_t __attribute__((ext_vector_type(2)));
__device__ __forceinline__ unsigned cvt_pk_bf16(float lo, float hi) { f32x2 v = {lo, hi}; bf16x2_t b = __builtin_convertvector(v, bf16x2_t); return __builtin_bit_cast(unsigned, b); }
__device__ __forceinline__ float bf_lo(unsigned w) { return __uint_as_float(w << 16); }
__device__ __forceinline__ float bf_hi(unsigned w) { return __uint_as_float(w & 0xffff0000u); }
__device__ __forceinline__ float bf1(bf16_t h) { return __uint_as_float(((unsigned)h) << 16); }
__device__ __forceinline__ float sigmoidf_(float x) { return __builtin_amdgcn_rcpf(1.0f + __expf(-x)); }
__device__ __forceinline__ f32x4 sig4(f32x4 v) { return (f32x4){sigmoidf_(v[0]), sigmoidf_(v[1]), sigmoidf_(v[2]), sigmoidf_(v[3])}; }
__device__ __forceinline__ f32x4 silu4(f32x4 v) { return v * sig4(v); }
__device__ __forceinline__ void unpack8(u32x4 w, f32x4& a, f32x4& b) { a = (f32x4){bf_lo(w.x), bf_hi(w.x), bf_lo(w.y), bf_hi(w.y)}; b = (f32x4){bf_lo(w.z), bf_hi(w.z), bf_lo(w.w), bf_hi(w.w)}; }
__device__ __forceinline__ u32x4 pack8(f32x4 a, f32x4 b) { u32x4 w; w.x = cvt_pk_bf16(a[0], a[1]); w.y = cvt_pk_bf16(a[2], a[3]); w.z = cvt_pk_bf16(b[0], b[1]); w.w = cvt_pk_bf16(b[2], b[3]); return w; }
__device__ __forceinline__ float wave_sum(float v) {
#pragma unroll
    for (int o = 1; o < 64; o <<= 1) v += __shfl_xor(v, o);
    return v;
}
__device__ __forceinline__ int opaque_tid() { int t = threadIdx.x; asm volatile("" : "+v"(t)); return t; }
#define TID_VARS const int tid = opaque_tid(), lane = tid & 63, wave = __builtin_amdgcn_readfirstlane(tid >> 6); const int gw = bid * 8 + wave; const size_t gt = (size_t)bid * 512 + tid; (void)lane; (void)gw; (void)gt;
#define CG_SYNC() do { asm volatile("s_waitcnt vmcnt(0) lgkmcnt(0)" ::: "memory"); grid.sync(); asm volatile("" ::: "memory"); } while (0)
#define GRID_SYNC() do { asm volatile("" ::: "memory"); xcd_barrier(xbar); asm volatile("" ::: "memory"); } while (0)
#define LDS_WAIT() asm volatile("s_waitcnt lgkmcnt(0)" ::: "memory")

namespace pg8 {
constexpr int BM = 256, BK = 64, HALF = 128, HTB = HALF * BK * 2, NXCD = 8, WGM = 4;
__device__ __forceinline__ int lds_byte(int r, int c) { const int st = (r >> 4) * 2 + (c >> 5), rr = r & 15, cc = c & 31, ob = rr * 64 + cc * 2; return st * 1024 + (ob ^ (((ob >> 9) & 1) << 5)); }
__device__ __forceinline__ void stage_rc(int b, int& R, int& C) { const int st = b / 1024, sb = b % 1024, swz = sb ^ (((sb >> 9) & 1) << 5); R = (st >> 1) * 16 + swz / 64; C = (st & 1) * 32 + (swz % 64) / 2; }
__device__ __forceinline__ int perm32(int rho) { const int n = rho >> 4, i = rho & 15; return 8 * (i >> 2) + 4 * n + (i & 3); }
struct Unit { int pm, pn; };
struct Gemm { const bf16_t* A; const bf16_t* Bt; int M, N, K, lda, ldb; };
struct StaticOrder {
    int nM, nN, nwg, G, c;
    __device__ void init(int M, int N, int G_, int c_) { nM = M / BM; nN = N / BM; nwg = nM * nN; G = G_; c = c_; }
    __device__ bool next(int i, Unit& u) const {
        const long L = (long)i * G + c; if (L >= nwg) return false;
        int wgid = (int)L; { const int q = nwg / NXCD, r = nwg % NXCD, xcd = wgid % NXCD, off = wgid / NXCD; wgid = (xcd < r ? xcd * (q + 1) : r * (q + 1) + (xcd - r) * q) + off; }
        const int nig = WGM * nN, gid = wgid / nig, fm = gid * WGM, gsz = (nM - fm) < WGM ? (nM - fm) : WGM;
        u.pm = fm + ((wgid % nig) % gsz); u.pn = (wgid % nig) / gsz; return true;
    }
};
template <class Epi>
__device__ __forceinline__ void gemm_phase(LAS unsigned char* lds, const Gemm g, const StaticOrder& S, const Epi& E, const int tid) {
    const int wid = __builtin_amdgcn_readfirstlane(tid >> 6), lane = tid & 63, wr = wid >> 2, wc = wid & 3, fr = lane & 15, fq = lane >> 4;
    const int K = g.K, nt = K / BK;
    unsigned voffA[2], voffB[2];
#pragma unroll
    for (int i = 0; i < 2; ++i) { int R, C; stage_rc(tid * 16 + i * 8192, R, C); const int Rb = (R & ~31) + perm32(R & 31);
        voffA[i] = (unsigned)(R * g.lda + C) * 2u; voffB[i] = (unsigned)(Rb * g.ldb + C) * 2u; }
    const size_t kstep = (size_t)(BK * 2);
    const size_t hstepA = (size_t)HALF * g.lda * 2, hstepB = (size_t)HALF * g.ldb * 2;
    const size_t tstepA = 2 * hstepA, tstepB = 2 * hstepB;
    const unsigned ldsw = (unsigned)wid * 1024u;
    const int aoff = lds_byte(wr * 64 + fr, fq * 8), boff = lds_byte(wc * 32 + fr, fq * 8);
#define PG8_SA(b, h) (((b) * 2 + (h)) * HTB)
#define PG8_SB(b, h) ((4 + (b) * 2 + (h)) * HTB)
#define PG8_STAGE(bufoff, gbase, voff) do { _Pragma("unroll") for (int _i = 0; _i < 2; ++_i) \
        __builtin_amdgcn_global_load_lds((const unsigned*)((const char*)(gbase) + (voff)[_i]), (LAS unsigned*)(lds + (bufoff) + ldsw + _i * 8192), 16, 0, 0); } while (0)
#define PG8_LDA(dst, b, h) do { _Pragma("unroll") for (int m = 0; m < 4; ++m) _Pragma("unroll") for (int k = 0; k < 2; ++k) dst[m][k] = *(const LAS bf16x8*)(lds + PG8_SA(b, h) + aoff + m * 2048 + k * 1024); } while (0)
#define PG8_LDB(dst, b, h) do { _Pragma("unroll") for (int n = 0; n < 2; ++n) _Pragma("unroll") for (int k = 0; k < 2; ++k) dst[n][k] = *(const LAS bf16x8*)(lds + PG8_SB(b, h) + boff + n * 2048 + k * 1024); } while (0)
#define PG8_MMA(ai, bj, At, Bt) do { __builtin_amdgcn_s_setprio(1); _Pragma("unroll") for (int m = 0; m < 4; ++m) _Pragma("unroll") for (int n = 0; n < 2; ++n) _Pragma("unroll") for (int k = 0; k < 2; ++k) \
        acc[ai][bj][m][n] = __builtin_amdgcn_mfma_f32_16x16x32_bf16(Bt[n][k], At[m][k], acc[ai][bj][m][n], 0, 0, 0); __builtin_amdgcn_s_setprio(0); } while (0)
#define PG8_WAIT_V(n) asm volatile("s_waitcnt vmcnt(" #n ")" ::: "memory")
#define PG8_WAIT_L(n) asm volatile("s_waitcnt lgkmcnt(" #n ")" ::: "memory")
#define PG8_BAR __builtin_amdgcn_s_barrier()
#define PG8_SCHED __builtin_amdgcn_sched_barrier(0)
    Unit cur, nxt; int ui = 0;
    if (!S.next(0, cur)) return;
    f32x4 acc[2][2][4][2];
    E.init(acc, cur, wr, wc, fr, fq);
    bf16x8 At[4][2], B0[2][2], B1[2][2];
    const char* cA = (const char*)g.A + (size_t)cur.pm * tstepA; const char* cB = (const char*)g.Bt + (size_t)cur.pn * tstepB;
    PG8_STAGE(PG8_SB(0, 0), cB, voffB); PG8_STAGE(PG8_SA(0, 0), cA, voffA); PG8_STAGE(PG8_SB(0, 1), cB + hstepB, voffB); PG8_STAGE(PG8_SA(0, 1), cA + hstepA, voffA);
    if (wr == 1) PG8_BAR;
    PG8_WAIT_V(4); PG8_BAR;
    PG8_STAGE(PG8_SB(1, 0), cB + kstep, voffB); PG8_STAGE(PG8_SA(1, 0), cA + kstep, voffA); PG8_STAGE(PG8_SB(1, 1), cB + hstepB + kstep, voffB);
    PG8_WAIT_V(6); PG8_BAR;
    for (;;) {
        const bool has_next = S.next(ui + 1, nxt);
        const char* nA = has_next ? (const char*)g.A + (size_t)nxt.pm * tstepA : cA; const char* nB = has_next ? (const char*)g.Bt + (size_t)nxt.pn * tstepB : cB;
        for (int t = 0; t < nt; t += 2) {
            const bool last = (t == nt - 2);
            const char* a1 = cA + (size_t)(t + 1) * kstep;
            const char* a2 = last ? nA : cA + (size_t)(t + 2) * kstep; const char* b2 = last ? nB : cB + (size_t)(t + 2) * kstep;
            const char* a3 = a2 + kstep; const char* b3 = b2 + kstep;
            PG8_LDB(B0, 0, 0); PG8_SCHED; PG8_LDA(At, 0, 0); PG8_STAGE(PG8_SA(1, 1), a1 + hstepA, voffA);
            PG8_WAIT_L(8); PG8_BAR; PG8_WAIT_L(0); PG8_MMA(0, 0, At, B0); PG8_BAR; PG8_SCHED;
            PG8_LDB(B1, 0, 1); PG8_STAGE(PG8_SB(0, 0), b2, voffB);
            PG8_BAR; PG8_WAIT_L(0); PG8_MMA(0, 1, At, B1); PG8_BAR;
            PG8_LDA(At, 0, 1); PG8_STAGE(PG8_SA(0, 0), a2, voffA);
            PG8_BAR; PG8_WAIT_L(0); PG8_MMA(1, 0, At, B0); PG8_BAR; PG8_SCHED;
            PG8_STAGE(PG8_SB(0, 1), b2 + hstepB, voffB);
            PG8_WAIT_V(6); PG8_BAR; PG8_MMA(1, 1, At, B1); PG8_BAR;
            PG8_LDB(B0, 1, 0); PG8_SCHED; PG8_LDA(At, 1, 0); PG8_STAGE(PG8_SA(0, 1), a2 + hstepA, voffA);
            PG8_WAIT_L(8); PG8_BAR; PG8_WAIT_L(0); PG8_MMA(0, 0, At, B0); PG8_BAR; PG8_SCHED;
            PG8_LDB(B1, 1, 1); PG8_STAGE(PG8_SB(1, 0), b3, voffB);
            PG8_BAR; PG8_WAIT_L(0); PG8_MMA(0, 1, At, B1); PG8_BAR;
            PG8_LDA(At, 1, 1); PG8_STAGE(PG8_SA(1, 0), a3, voffA);
            PG8_BAR; PG8_WAIT_L(0); PG8_MMA(1, 0, At, B0); PG8_BAR; PG8_SCHED;
            PG8_STAGE(PG8_SB(1, 1), b3 + hstepB, voffB);
            PG8_WAIT_V(6); PG8_BAR; PG8_MMA(1, 1, At, B1); PG8_BAR;
        }
        E(acc, cur, wr, wc, fr, fq);
        if (!has_next) break;
        E.init(acc, nxt, wr, wc, fr, fq);
        cur = nxt; cA = nA; cB = nB; ++ui;
    }
    PG8_WAIT_V(0);
    if (wr == 0) PG8_BAR;
    PG8_BAR;
#undef PG8_SA
#undef PG8_SB
#undef PG8_STAGE
#undef PG8_LDA
#undef PG8_LDB
#undef PG8_MMA
#undef PG8_WAIT_V
#undef PG8_WAIT_L
#undef PG8_BAR
#undef PG8_SCHED
}
}
using pg8::Unit;

typedef const f32x4 (&AccRef)[2][2][4][2];

typedef f32x4 (&AccMut)[2][2][4][2];
__device__ __forceinline__ void acc_zero(AccMut acc) {
#pragma unroll
    for (int a = 0; a < 2; ++a)
#pragma unroll
        for (int b = 0; b < 2; ++b)
#pragma unroll
            for (int m = 0; m < 4; ++m)
#pragma unroll
                for (int n = 0; n < 2; ++n) acc[a][b][m][n] = (f32x4){0.f, 0.f, 0.f, 0.f};
}
__device__ __forceinline__ void acc_bias(AccMut acc, const float* bcol  ) {
#pragma unroll
    for (int b = 0; b < 2; ++b)
#pragma unroll
        for (int n = 0; n < 2; ++n) { const f32x4 bv = *(const f32x4*)(bcol + b * 128 + 4 * n);
#pragma unroll
            for (int a = 0; a < 2; ++a)
#pragma unroll
                for (int m = 0; m < 4; ++m) acc[a][b][m][n] = bv; }
}
struct EpiIn {
    bf16_t* H; const float* bias;
    __device__ __forceinline__ void init(AccMut acc, const Unit& u, int wr, int wc, int fr, int fq) const { acc_bias(acc, bias + u.pn * 256 + wc * 32 + 8 * fq); }
    template <int MODE> __device__ __forceinline__ void body(AccRef acc, int row0, size_t hc, int ld) const {
#pragma unroll
        for (int ai = 0; ai < 2; ++ai)
#pragma unroll
            for (int m = 0; m < 4; ++m) { bf16_t* rowp = H + (size_t)(row0 + ai * 128 + m * 16) * ld + hc;
#pragma unroll
                for (int bj = 0; bj < 2; ++bj) { f32x4 v0 = acc[ai][bj][m][0], v1 = acc[ai][bj][m][1];
                    if (MODE == 1) { v0 = silu4(v0); v1 = silu4(v1); }
                    if (MODE == 2) { v0 = sig4(v0); v1 = sig4(v1); }
                    *(u32x4*)(rowp + bj * 128) = pack8(v0, v1); } }
    }
    __device__ __forceinline__ void operator()(AccRef acc, const Unit& u, int wr, int wc, int fr, int fq) const {
        const int pn = u.pn; int mode, ld; size_t hc;
        if (pn < 2) { mode = 0; hc = SEG_F + pn * 256; ld = LDF; } else if (pn < 4) { mode = 1; hc = SEG_F + pn * 256; ld = LDF; }
        else if (pn < 8) { mode = 0; hc = SEG_P + (pn - 4) * 256; ld = LDP; } else if (pn < 12) { mode = 1; hc = SEG_P + (pn - 4) * 256; ld = LDP; }
        else if (pn < 16) { mode = 3; hc = SEG_C + (pn - 12) * 128; ld = LDC; } else if (pn < 18) { mode = 1; hc = SEG_C + 512 + (pn - 16) * 256; ld = LDC; }
        else { const int e = (pn - 18) * 256; mode = 2; hc = SEG_G + (size_t)(e >> 11) * M_TOK * LDG + (e & 2047); ld = LDG; }
        const int row0 = u.pm * 256 + wr * 64 + fr, lc = wc * 32 + 8 * fq;
        hc += lc;
        if (mode == 3) {
#pragma unroll
            for (int ai = 0; ai < 2; ++ai)
#pragma unroll
                for (int m = 0; m < 4; ++m) { bf16_t* rowp = H + (size_t)(row0 + ai * 128 + m * 16) * ld + hc;
                    const f32x4 a0 = acc[ai][0][m][0], a1 = acc[ai][0][m][1], g0 = acc[ai][1][m][0], g1 = acc[ai][1][m][1];
                    *(u32x4*)rowp = pack8(a0 * sig4(g0), a1 * sig4(g1)); }
        } else if (mode == 0) body<0>(acc, row0, hc, ld);
        else if (mode == 1) body<1>(acc, row0, hc, ld);
        else body<2>(acc, row0, hc, ld);
    }
};
struct EpiFnet {
    bf16_t* H;
    __device__ __forceinline__ void init(AccMut acc, const Unit&, int, int, int, int) const { acc_zero(acc); }
    __device__ __forceinline__ void operator()(AccRef acc, const Unit& u, int wr, int wc, int fr, int fq) const {
        const float sc = (u.pm < 64) ? 0.001953125f   : 0.0009765625f  ;
        const int row0 = u.pm * 256 + wr * 64 + fr, c0 = 512 + u.pn * 256 + wc * 32 + 8 * fq;
#pragma unroll
        for (int ai = 0; ai < 2; ++ai) {
            u32x4 zw[4][2];
#pragma unroll
            for (int m = 0; m < 4; ++m)
#pragma unroll
                for (int bj = 0; bj < 2; ++bj) zw[m][bj] = *(const u32x4*)(H + SEG_F + (size_t)(row0 + ai * 128 + m * 16) * LDF + c0 + bj * 128);
#pragma unroll
            for (int m = 0; m < 4; ++m) { bf16_t* rowp = H + SEG_F + (size_t)(row0 + ai * 128 + m * 16) * LDF + c0;
#pragma unroll
                for (int bj = 0; bj < 2; ++bj) { f32x4 z0, z1; unpack8(zw[m][bj], z0, z1);
                    *(u32x4*)(rowp + bj * 128) = pack8(acc[ai][bj][m][0] * sc * z0, acc[ai][bj][m][1] * sc * z1); } }
            asm volatile("" ::: "memory");
        }
    }
};
template <bool FIRST> struct EpiMerge {
    bf16_t* MRG; const bf16_t* gate;
    __device__ __forceinline__ void init(AccMut acc, const Unit&, int, int, int, int) const { acc_zero(acc); }
    __device__ __forceinline__ void operator()(AccRef acc, const Unit& u, int wr, int wc, int fr, int fq) const {
        const int row0 = u.pm * 256 + wr * 64 + fr, c0 = u.pn * 256 + wc * 32 + 8 * fq;
        constexpr int NB = 4;
#pragma unroll
        for (int ai = 0; ai < 2; ++ai)
#pragma unroll
        for (int mh = 0; mh < 4; mh += NB) {
            u32x4 gw[NB][2], pw[NB][2];
#pragma unroll
            for (int mm = 0; mm < NB; ++mm)
#pragma unroll
                for (int bj = 0; bj < 2; ++bj) { const size_t row = (size_t)(row0 + ai * 128 + (mh + mm) * 16);
                    gw[mm][bj] = *(const u32x4*)(gate + row * LDG + c0 + bj * 128);
                    if constexpr (FIRST) pw[mm][bj] = (u32x4){0u, 0u, 0u, 0u}; else pw[mm][bj] = *(const u32x4*)(MRG + row * DM + c0 + bj * 128); }
#pragma unroll
            for (int mm = 0; mm < NB; ++mm) { const int m = mh + mm; bf16_t* mp = MRG + (size_t)(row0 + ai * 128 + m * 16) * DM + c0;
#pragma unroll
                for (int bj = 0; bj < 2; ++bj) { f32x4 g0, g1, p0, p1; unpack8(gw[mm][bj], g0, g1); unpack8(pw[mm][bj], p0, p1);
                    *(u32x4*)(mp + bj * 128) = pack8(g0 * acc[ai][bj][m][0] + p0, g1 * acc[ai][bj][m][1] + p1); } }
            asm volatile("" ::: "memory");
        }
    }
};
struct EpiOut {
    float* X; const float* bias; const float* lng; bf16_t* YG; float* stats;
    __device__ __forceinline__ void init(AccMut acc, const Unit& u, int wr, int wc, int fr, int fq) const { acc_bias(acc, bias + u.pn * 256 + wc * 32 + 8 * fq); }
    __device__ __forceinline__ void operator()(AccRef acc, const Unit& u, int wr, int wc, int fr, int fq) const {
        const int row0 = u.pm * 256 + wr * 64 + fr, c0 = u.pn * 256 + wc * 32 + 8 * fq;
#pragma unroll
        for (int bj = 0; bj < 2; ++bj) {
            const f32x4 gv0 = *(const f32x4*)(lng + c0 + bj * 128), gv1 = *(const f32x4*)(lng + c0 + bj * 128 + 4);
#pragma unroll
            for (int ai = 0; ai < 2; ++ai)
#pragma unroll
            for (int mh = 0; mh < 4; mh += 4) {
                f32x4 xv[4][2];
#pragma unroll
                for (int m = mh; m < mh + 4; ++m)
#pragma unroll
                    for (int n = 0; n < 2; ++n) xv[m][n] = *(const f32x4*)(X + (size_t)(row0 + ai * 128 + m * 16) * DM + c0 + bj * 128 + 4 * n);
#pragma unroll
                for (int m = mh; m < mh + 4; ++m) { const int row = row0 + ai * 128 + m * 16; float* xp = X + (size_t)row * DM + c0 + bj * 128; bf16_t* yp = YG + (size_t)row * DM + c0 + bj * 128;
                    const f32x4 y0 = xv[m][0] * DN_ALPHA + acc[ai][bj][m][0], y1 = xv[m][1] * DN_ALPHA + acc[ai][bj][m][1];
                    *(f32x4*)xp = y0; *(f32x4*)(xp + 4) = y1;
                    *(u32x4*)yp = pack8(y0 * gv0, y1 * gv1);
                    float sm = (y0[0] + y0[1]) + (y0[2] + y0[3]) + (y1[0] + y1[1]) + (y1[2] + y1[3]);
                    float sq = (y0[0] * y0[0] + y0[1] * y0[1]) + (y0[2] * y0[2] + y0[3] * y0[3]) + (y1[0] * y1[0] + y1[1] * y1[1]) + (y1[2] * y1[2] + y1[3] * y1[3]);
                    sm += __shfl_xor(sm, 16); sq += __shfl_xor(sq, 16); sm += __shfl_xor(sm, 32); sq += __shfl_xor(sq, 32);
                    if (fq == 0) { (void)__hip_atomic_fetch_add(stats + 2 * row, sm, __ATOMIC_RELAXED, __HIP_MEMORY_SCOPE_AGENT); (void)__hip_atomic_fetch_add(stats + 2 * row + 1, sq, __ATOMIC_RELAXED, __HIP_MEMORY_SCOPE_AGENT); } }
                asm volatile("" ::: "memory");
            }
        }
    }
};
struct EpiPlain {
    bf16_t* O;
    __device__ __forceinline__ void init(AccMut acc, const Unit&, int, int, int, int) const { acc_zero(acc); }
    __device__ __forceinline__ void operator()(AccRef acc, const Unit& u, int wr, int wc, int fr, int fq) const {
        const int row0 = u.pm * 256 + wr * 64 + fr, c0 = u.pn * 256 + wc * 32 + 8 * fq;
#pragma unroll
        for (int ai = 0; ai < 2; ++ai)
#pragma unroll
            for (int m = 0; m < 4; ++m) { bf16_t* op = O + (size_t)(row0 + ai * 128 + m * 16) * DM + c0;
#pragma unroll
                for (int bj = 0; bj < 2; ++bj) *(u32x4*)(op + bj * 128) = pack8(acc[ai][bj][m][0], acc[ai][bj][m][1]); }
    }
};
struct EpiGate {
    float* X; const float* cg; const float* cb; const float* lng; const float* lnb; const bf16_t* PLEB; bf16_t* XB; const float* stats;
    __device__ __forceinline__ void init(AccMut acc, const Unit&, int, int, int, int) const { acc_zero(acc); }
    __device__ __forceinline__ void operator()(AccRef acc, const Unit& u, int wr, int wc, int fr, int fq) const {
        const int row0 = u.pm * 256 + wr * 64 + fr, c0 = u.pn * 256 + wc * 32 + 8 * fq;
#pragma unroll
        for (int bj = 0; bj < 2; ++bj) {
            const f32x4 g0 = *(const f32x4*)(lng + c0 + bj * 128), g1 = *(const f32x4*)(lng + c0 + bj * 128 + 4), b0 = *(const f32x4*)(lnb + c0 + bj * 128), b1 = *(const f32x4*)(lnb + c0 + bj * 128 + 4);
            const f32x4 cg0 = *(const f32x4*)(cg + c0 + bj * 128), cg1 = *(const f32x4*)(cg + c0 + bj * 128 + 4), cb0 = *(const f32x4*)(cb + c0 + bj * 128), cb1 = *(const f32x4*)(cb + c0 + bj * 128 + 4);
#pragma unroll
            for (int ai = 0; ai < 2; ++ai)
#pragma unroll
            for (int mh = 0; mh < 4; mh += 2) {
                u32x4 pw[4]; f32x4 yv[4][2]; f32x2 st[4];
#pragma unroll
                for (int m = mh; m < mh + 2; ++m) { const int row = row0 + ai * 128 + m * 16; const size_t ro = (size_t)row * DM + c0 + bj * 128;
                    pw[m] = *(const u32x4*)(PLEB + ro); yv[m][0] = *(const f32x4*)(X + ro); yv[m][1] = *(const f32x4*)(X + ro + 4); st[m] = *(const f32x2*)(stats + 2 * row); }
#pragma unroll
                for (int m = mh; m < mh + 2; ++m) { const int row = row0 + ai * 128 + m * 16; const size_t ro = (size_t)row * DM + c0 + bj * 128;
                    const float mu = st[m].x * (1.f / DM), var = st[m].y * (1.f / DM) - mu * mu, r = 1.f / sqrtf(var + LN_EPS);
                    f32x4 p0, p1; unpack8(pw[m], p0, p1);
                    const f32x4 x0 = (yv[m][0] - mu) * r * g0 + b0, x1 = (yv[m][1] - mu) * r * g1 + b1;
                    const f32x4 o0 = x0 + sig4((acc[ai][bj][m][0] - mu * cg0) * r + cb0) * p0, o1 = x1 + sig4((acc[ai][bj][m][1] - mu * cg1) * r + cb1) * p1;
                    *(f32x4*)(X + ro) = o0; *(f32x4*)(X + ro + 4) = o1; *(u32x4*)(XB + ro) = pack8(o0, o1); }
                asm volatile("" ::: "memory");
            }
        }
    }
};

struct Params { const float* in[25]; float* out; unsigned char* ws; int ph_lo, ph_hi; };
enum { I_XP = 0, I_XS, I_PP, I_PS, I_EG, I_EB, I_WIN, I_BIN, I_WF, I_WG, I_BG, I_PSC, I_WP, I_WDW, I_BDW, I_CG, I_CB, I_WC, I_WOUT, I_BOUT, I_LNG, I_LNB, I_WPLE, I_WPG, I_BPG };

__device__ __forceinline__ void seq_of_row(int row, int& base, int& S) {
    if (row < M_PROMPT) { S = 2048; base = row & ~2047; } else { S = 8192; base = M_PROMPT + ((row - M_PROMPT) & ~8191); }
}

__device__ __forceinline__ void ln_row(const float* src, float* dstf, bf16_t* dstb, const float* g, const float* b, int lane) {
    f32x4 v[8]; float s = 0.f;
#pragma unroll
    for (int j = 0; j < 8; ++j) { v[j] = ((const f32x4*)src)[lane + 64 * j]; s += (v[j][0] + v[j][1]) + (v[j][2] + v[j][3]); }
    const float mean = wave_sum(s) * (1.f / DM); float s2 = 0.f;
#pragma unroll
    for (int j = 0; j < 8; ++j) { v[j] = v[j] - mean; s2 += (v[j][0] * v[j][0] + v[j][1] * v[j][1]) + (v[j][2] * v[j][2] + v[j][3] * v[j][3]); }
    const float rstd = 1.f / sqrtf(wave_sum(s2) * (1.f / DM) + LN_EPS);
#pragma unroll
    for (int j = 0; j < 8; ++j) { const f32x4 gg = ((const f32x4*)g)[lane + 64 * j], bb = ((const f32x4*)b)[lane + 64 * j]; const f32x4 o = v[j] * rstd * gg + bb;
        ((f32x4*)dstf)[lane + 64 * j] = o; u32x2 w; w.x = cvt_pk_bf16(o[0], o[1]); w.y = cvt_pk_bf16(o[2], o[3]); ((u32x2*)dstb)[lane + 64 * j] = w; }
}

__device__ __forceinline__ void transpose_item(const float* W, int ldw, int col0, bf16_t* WT, int ldt, int row0, int k0, LAS float* scr, int lane) {
    { float wv[32];
#pragma unroll
    for (int i = 0; i < 32; ++i) { const int kk = 2 * i + (lane >> 5); wv[i] = W[(size_t)(k0 + kk) * ldw + col0 + (lane & 31)]; }
#pragma unroll
    for (int i = 0; i < 32; ++i) { const int kk = 2 * i + (lane >> 5); scr[kk * 33 + (lane & 31)] = wv[i]; } }
    LDS_WAIT();
    const int c = lane & 7;
#pragma unroll
    for (int j = 0; j < 4; ++j) { const int n = (lane >> 3) + 8 * j; const LAS float* s = scr + (8 * c) * 33 + n;
        u32x4 o; o.x = cvt_pk_bf16(s[0 * 33], s[1 * 33]); o.y = cvt_pk_bf16(s[2 * 33], s[3 * 33]); o.z = cvt_pk_bf16(s[4 * 33], s[5 * 33]); o.w = cvt_pk_bf16(s[6 * 33], s[7 * 33]);
        *(u32x4*)(WT + (size_t)(row0 + n) * ldt + k0 + 8 * c) = o; }
    LDS_WAIT();
}

constexpr float C32[16] = {1.000000000e+00f, 9.807852804e-01f, 9.238795325e-01f, 8.314696123e-01f, 7.071067812e-01f, 5.555702330e-01f, 3.826834324e-01f, 1.950903220e-01f, 6.123233996e-17f, -1.950903220e-01f, -3.826834324e-01f, -5.555702330e-01f, -7.071067812e-01f, -8.314696123e-01f, -9.238795325e-01f, -9.807852804e-01f};
constexpr float S32[16] = {0.000000000e+00f, 1.950903220e-01f, 3.826834324e-01f, 5.555702330e-01f, 7.071067812e-01f, 8.314696123e-01f, 9.238795325e-01f, 9.807852804e-01f, 1.000000000e+00f, 9.807852804e-01f, 9.238795325e-01f, 8.314696123e-01f, 7.071067812e-01f, 5.555702330e-01f, 3.826834324e-01f, 1.950903220e-01f};
__device__ __forceinline__ void fft_lds(LAS f32x2* X, const LAS f32x2* tw, int logR, int logCW, int tid) {
    const int CWm = (1 << logCW) - 1;
    for (int p = 0; p < logR; ++p) {
        const int lh = logR - 1 - p, half = 1 << lh;
#pragma unroll 4
        for (int it = 0; it < 16; ++it) {
            const int f = it * 512 + tid, c = f & CWm, j = f >> logCW, grp = j >> lh, pos = j & (half - 1);
            const int i0 = ((grp << (lh + 1)) + pos), i1 = i0 + half;
            const f32x2 a = X[(i0 << logCW) + c], b = X[(i1 << logCW) + c], w = tw[pos << p];
            const f32x2 d = a - b;
            X[(i0 << logCW) + c] = a + b;
            X[(i1 << logCW) + c] = (f32x2){d.x * w.x - d.y * w.y, d.x * w.y + d.y * w.x};
        }
        __syncthreads();
    }
}


#define XB_TMO      128
#define XB_XCNT(j)  (256  + 64 * (j))
#define XB_XSUB(j)  (1280 + 64 * (j))
#define XB_XGEN(j)  (2304 + 64 * (j))
#define XB_TOP      3328
#define XB_TOPGEN   3392
#define XCD_BAR_WORDS 3456
#define XB_SPIN_CAP (1u << 22)
__device__ __forceinline__ unsigned xb_ld(unsigned* p)              { return __hip_atomic_load(p, __ATOMIC_RELAXED, __HIP_MEMORY_SCOPE_AGENT); }
__device__ __forceinline__ unsigned xb_add(unsigned* p, unsigned v) { return __hip_atomic_fetch_add(p, v, __ATOMIC_RELAXED, __HIP_MEMORY_SCOPE_AGENT); }
__device__ __forceinline__ unsigned xb_xcc_id() { return (unsigned)__builtin_amdgcn_s_getreg((3 << 11) | 20) & 0xFu; }
#define XB_SPIN(cond, bar) do { unsigned _sp = 0; while (cond) { __builtin_amdgcn_s_sleep(1); \
    if ((++_sp & 255u) == 0u) { if (xb_ld(&(bar)[XB_TMO])) break; if (_sp > XB_SPIN_CAP) { atomicAdd(&(bar)[XB_TMO], 1u); break; } } } } while (0)
struct XcdBarrier { unsigned* bar; unsigned x; volatile LAS unsigned* st; };
__device__ __forceinline__ XcdBarrier xcd_barrier_post(unsigned* bar, volatile LAS unsigned* st) {
    XcdBarrier b; b.bar = bar; b.x = xb_xcc_id(); b.st = st;
    if (threadIdx.x == 0) (void)xb_add(&bar[XB_XCNT(b.x)], 1u);
    return b;
}
__device__ __forceinline__ void xcd_barrier_complete(unsigned* bar, unsigned x, unsigned& nloc, unsigned& nx) {
    const unsigned G = gridDim.x * gridDim.y * gridDim.z;
    unsigned sum, cnt, mine, sp = 0u;
    for (;;) {
        sum = 0u; cnt = 0u; mine = 0u;
#pragma unroll
        for (unsigned j = 0; j < 16; ++j) { const unsigned c = xb_ld(&bar[XB_XCNT(j)]); sum += c; cnt += (c > 0u) ? 1u : 0u; mine = (j == x) ? c : mine; }
        if (sum == G) break;
        __builtin_amdgcn_s_sleep(1);
        if ((++sp & 255u) == 0u) { if (xb_ld(&bar[XB_TMO])) break; if (sp > XB_SPIN_CAP) { atomicAdd(&bar[XB_TMO], 1u); break; } }
    }
    nloc = mine > 0u ? mine : 1u; nx = cnt > 0u ? cnt : 1u;
}
__device__ __forceinline__ void xcd_barrier(const XcdBarrier& b) {
    asm volatile("s_waitcnt vmcnt(0)" ::: "memory");
    __syncthreads();
    if (threadIdx.x == 0) {
        unsigned long long bar_ = (unsigned long long)b.bar; unsigned bx = b.x;
        asm volatile("" : "+s"(bar_), "+s"(bx));
        unsigned* bar = (unsigned*)bar_;
        __builtin_amdgcn_s_waitcnt(0);
        unsigned nloc = b.st[0], nx = b.st[1];
        if (nloc == 0u) { xcd_barrier_complete(bar, bx, nloc, nx); b.st[0] = nloc; b.st[1] = nx; }
        const unsigned old = xb_add(&bar[XB_XSUB(bx)], 1u);
        const unsigned gen = old / nloc;
        if (old + 1u == (gen + 1u) * nloc) {
            __builtin_amdgcn_fence(__ATOMIC_RELEASE, "agent");
            asm volatile("s_waitcnt vmcnt(0)" ::: "memory");
            const unsigned og = xb_add(&bar[XB_TOP], 1u);
            const unsigned tg = og / nx;
            if (og + 1u == (tg + 1u) * nx) xb_add(&bar[XB_TOPGEN], 1u);
            else XB_SPIN(xb_ld(&bar[XB_TOPGEN]) == tg, bar);
            __builtin_amdgcn_fence(__ATOMIC_ACQUIRE, "agent");
            xb_add(&bar[XB_XGEN(bx)], 1u);
            asm volatile("s_waitcnt vmcnt(0)" ::: "memory");
        } else {
            XB_SPIN(xb_ld(&bar[XB_XGEN(bx)]) == gen, bar);
            __builtin_amdgcn_fence(__ATOMIC_ACQUIRE, "agent");
            asm volatile("s_waitcnt vmcnt(0)" ::: "memory");
        }
    }
    __syncthreads();
}

typedef const __attribute__((address_space(4))) Params* KP;
__device__ __forceinline__ KP kparams() { unsigned long long k = (unsigned long long)__builtin_amdgcn_kernarg_segment_ptr(); asm volatile("" : "+s"(k)); return (KP)k; }
#define KARGS0 KP p = kparams(); unsigned char* ws = p->ws; \
    bf16_t* WT = (bf16_t*)(ws + OFF_WT); bf16_t* FC = (bf16_t*)(ws + OFF_FC); float* BIASP = (float*)(ws + OFF_BIAS); \
    bf16_t* H = (bf16_t*)(ws + OFF_H); bf16_t* MRG = (bf16_t*)(ws + OFF_MRG); bf16_t* XB = (bf16_t*)(ws + OFF_XB); f32x2* ZB = (f32x2*)(ws + OFF_XB); \
    bf16_t* XC = (bf16_t*)(ws + OFF_XC); bf16_t* PB = (bf16_t*)(ws + OFF_PB); float* PVF = (float*)(ws + OFF_PVF); \
    bf16_t* XN = (bf16_t*)(ws + OFF_XN); bf16_t* PLEB = (bf16_t*)(ws + OFF_PLEB); float* X = p->out; \
    float* CGB = (float*)(ws + OFF_CGB); float* STATS = (float*)(ws + OFF_STATS); f32x2* TWT = (f32x2*)(ws + OFF_TWT); (void)TWT; \
    (void)WT; (void)FC; (void)BIASP; (void)H; (void)MRG; (void)XB; (void)ZB; (void)XC; (void)PB; (void)PVF; (void)XN; (void)PLEB; (void)X; (void)CGB; (void)STATS;
#define KARGS KARGS0 const bf16_t* wt = WT + (size_t)l * WT_LAYER; (void)wt;
__global__ void __launch_bounds__(512, 2) fwd_megakernel(Params p_) {
    extern __shared__ __attribute__((aligned(16))) unsigned char smem[];
    cg::grid_group grid = cg::this_grid();
    LAS unsigned char* lds = (LAS unsigned char*)smem;
    const int G = gridDim.x, bid = blockIdx.x;
    const int NGW = G * 8;
    const size_t NGT = (size_t)G * 512;
    volatile LAS unsigned* xst = (volatile LAS unsigned*)(lds + 131072 + 4000);
    if (threadIdx.x < 2) xst[threadIdx.x] = 0u;
    __syncthreads();
    const XcdBarrier xbar = xcd_barrier_post((unsigned*)(kparams()->ws + OFF_BAR), xst);

    if (PHM & 1)
    {
        TID_VARS
            KARGS0
        const float* w_in = p->in[I_WIN]; const float* wg = p->in[I_WG];
        for (int task = gw; task < DEPTH * 512 * 4; task += NGW) {
            const int g = task & 3, kb = (task >> 2) & 511, l = task >> 11;
            const float* a = w_in + ((size_t)l * DM + kb * 4) * NIN + 1024 + g * 256;
            const float* b = wg + ((size_t)(l * 4 + g) * 256) * 256 + 4 * lane;
            f32x4 acc0 = {0, 0, 0, 0}, acc1 = acc0, acc2 = acc0, acc3 = acc0;
#pragma unroll 8
            for (int c = 0; c < 256; ++c) { const f32x4 bv = *(const f32x4*)(b + (size_t)c * 256);
                acc0 += a[c] * bv; acc1 += a[NIN + c] * bv; acc2 += a[2 * NIN + c] * bv; acc3 += a[3 * NIN + c] * bv; }
            float* o = PVF + ((size_t)l * DM + kb * 4) * 1024 + g * 256 + 4 * lane;
            *(f32x4*)o = acc0; *(f32x4*)(o + 1024) = acc1; *(f32x4*)(o + 2048) = acc2; *(f32x4*)(o + 3072) = acc3;
        }
        const float* b_in = p->in[I_BIN];
        for (size_t e = gt; e < (size_t)DEPTH * NIN; e += NGT) {
            const int l = (int)(e / NIN), n = (int)(e % NIN); float v;
            if (n >= 1024 && n < 2048) v = 0.f;
            else if (n >= 3072 && n < 4096) { const int j = (n - 3072) >> 8, lc = (n - 3072) & 255; v = b_in[(size_t)l * NIN + (lc < 128 ? 3072 + j * 128 + lc : 3584 + j * 128 + (lc - 128))]; }
            else v = b_in[(size_t)l * NIN + n];
            BIASP[e] = v;
        }
        for (size_t e = gt; e < (size_t)512 * 1024; e += NGT) {
            const int r = (int)(e >> 10), q = (int)(e & 1023), g = r >> 7, d = r & 127, half = q >> 9, g2 = (q >> 7) & 3, c = q & 127;
            float v = 0.f;
            if (g == g2) { const float ang = (float)((c * d) & 127) * (1.0f / 64.0f); v = half ? sinpif(ang) : cospif(ang); }
            FC[e] = (bf16_t)(cvt_pk_bf16(v, 0.f) & 0xffffu);
        }
        for (size_t e = gt; e < (size_t)DEPTH * DM * 16; e += NGT) {
            const int kc = (int)(e / ((size_t)DEPTH * DM)), le = (int)(e % ((size_t)DEPTH * DM)), l = le / DM, col = le % DM;
            const float* w = p->in[I_WPG] + ((size_t)l * DM + kc * 128) * DM + col; const float* g = p->in[I_LNG] + l * DM + kc * 128; const float* b = p->in[I_LNB] + l * DM + kc * 128;
            float sg = 0.f, sb = (kc == 0) ? p->in[I_BPG][l * DM + col] : 0.f;
#pragma unroll 8
            for (int k = 0; k < 128; ++k) { const float wv = w[(size_t)k * DM]; sg += g[k] * wv; sb += b[k] * wv; }
            (void)__hip_atomic_fetch_add(CGB + ((size_t)l * 2 + 0) * DM + col, sg, __ATOMIC_RELAXED, __HIP_MEMORY_SCOPE_AGENT);
            (void)__hip_atomic_fetch_add(CGB + ((size_t)l * 2 + 1) * DM + col, sb, __ATOMIC_RELAXED, __HIP_MEMORY_SCOPE_AGENT);
        }
        for (size_t e = gt; e < (size_t)TW_N; e += NGT) {
            float ang;
            if (e < (size_t)TW_RA) { const int big = e >= (size_t)TW_2B, ee = (int)e - (big ? TW_2B : 0), n1 = ee >> 5, i2 = ee & 31, k2 = (int)(__brev((unsigned)i2) >> 27), lS = big ? 13 : 11;
                ang = (float)((k2 * n1) & ((1 << lS) - 1)) * (2.0f / (float)(1 << lS)); }
            else if (e < (size_t)TW_RB) ang = (float)(e - TW_RA) * (2.0f / 64.f);
            else if (e < (size_t)TW_RC) ang = (float)(e - TW_RB) * (2.0f / 256.f);
            else ang = (float)(e - TW_RC) * (2.0f / 32.f);
            TWT[e] = (f32x2){cospif(ang), -sinpif(ang)};
        }
        for (int row = gw; row < M_TOK; row += NGW) {
            const float* src = row < M_PROMPT ? p->in[I_XP] + (size_t)row * DM : p->in[I_XS] + (size_t)(row - M_PROMPT) * DM;
            ln_row(src, X + (size_t)row * DM, XB + (size_t)row * DM, p->in[I_EG], p->in[I_EB], lane);
        }
    }
    CG_SYNC();
    if (PHM & 2)
    {
        TID_VARS
            KARGS0
        LAS float* scr = (LAS float*)(lds + wave * 16384);
        constexpr int IT_IN = 32 * 336, IT_F = 8 * 64, IT_P = 16 * 64, IT_C = 8 * 64, IT_OUT = 32 * 64, IT_PG = 32 * 64, IT_PLE = 4 * 64;
        constexpr int IT_LAYER = IT_IN + IT_F + IT_P + IT_C + IT_OUT + IT_PG + IT_PLE;
        for (int it = gw; it < DEPTH * IT_LAYER; it += NGW) {
            const int l = it / IT_LAYER; int r = it % IT_LAYER;
            bf16_t* wt = WT + (size_t)l * WT_LAYER;
            if (r < IT_IN) {
                const int kb = r / 336, nb = r % 336, n0 = nb * 32, k0 = kb * 64;
                const float* src = p->in[I_WIN] + (size_t)l * DM * NIN; int ldw = NIN, col0 = n0;
                if (n0 >= 1024 && n0 < 2048) { src = PVF + (size_t)l * DM * 1024; ldw = 1024; col0 = n0 - 1024; }
                else if (n0 >= 3072 && n0 < 4096) { const int j = (n0 - 3072) >> 8, lc = (n0 - 3072) & 255; col0 = lc < 128 ? 3072 + j * 128 + lc : 3584 + j * 128 + (lc - 128); }
                transpose_item(src, ldw, col0, wt + WT_IN, DM, n0, k0, scr, lane); continue; }
            r -= IT_IN;
            if (r < IT_F) { transpose_item(p->in[I_WF] + (size_t)l * 512 * DM, DM, (r % 64) * 32, wt + WT_F, 512, (r % 64) * 32, (r / 64) * 64, scr, lane); continue; }
            r -= IT_F;
            if (r < IT_P) { transpose_item(p->in[I_WP] + (size_t)l * 1024 * DM, DM, (r % 64) * 32, wt + WT_P, 1024, (r % 64) * 32, (r / 64) * 64, scr, lane); continue; }
            r -= IT_P;
            if (r < IT_C) { transpose_item(p->in[I_WC] + (size_t)l * 512 * DM, DM, (r % 64) * 32, wt + WT_C, 512, (r % 64) * 32, (r / 64) * 64, scr, lane); continue; }
            r -= IT_C;
            if (r < IT_OUT) { transpose_item(p->in[I_WOUT] + (size_t)l * DM * DM, DM, (r % 64) * 32, wt + WT_OUT, DM, (r % 64) * 32, (r / 64) * 64, scr, lane); continue; }
            r -= IT_OUT;
            if (r < IT_PG) { transpose_item(p->in[I_WPG] + (size_t)l * DM * DM, DM, (r % 64) * 32, wt + WT_PG, DM, (r % 64) * 32, (r / 64) * 64, scr, lane); continue; }
            r -= IT_PG;
            transpose_item(p->in[I_WPLE] + (size_t)l * PLE * DM, DM, (r % 64) * 32, wt + WT_PLE, PLE, (r % 64) * 32, (r / 64) * 64, scr, lane);
        }
    }
    GRID_SYNC();

    LAS f32x2* FX = (LAS f32x2*)lds;
    LAS f32x2* TW = (LAS f32x2*)(lds + 131072);
    LAS f32x2* TW2 = (LAS f32x2*)(lds + 131072 + 2048);

    for (int l = 0; l < DEPTH; ++l) {
        if (PHM & 4)
        {
            TID_VARS
            KARGS
            pg8::Gemm g{XB, wt + WT_IN, M_TOK, NIN, DM, DM, DM}; pg8::StaticOrder S; S.init(M_TOK, NIN, G, bid);
            EpiIn E{H, BIASP + (size_t)l * NIN};
            pg8::gemm_phase(lds, g, S, E, tid);
        }
        GRID_SYNC();
        if (PHM & 8)
        {
            TID_VARS
            KARGS
            if (tid < 16) TW[tid] = TWT[TW_RC + tid];
            for (int t = bid; t < 1024; t += G) {
                int base, n1, S1, lS;
                if (t < 512) { base = (t >> 6) * 2048; n1 = t & 63; S1 = 64; lS = 11; } else { const int tt = t - 512; base = M_PROMPT + (tt >> 8) * 8192; n1 = tt & 255; S1 = 256; lS = 13; }
                __syncthreads();
                if (tid < 32) TW2[tid] = TWT[(t < 512 ? TW_2A : TW_2B) + n1 * 32 + tid];
                { bf16_t hv[32];
#pragma unroll
                for (int n2 = 0; n2 < 32; ++n2) hv[n2] = H[SEG_F + (size_t)(base + n1 + S1 * n2) * LDF + tid];
                __syncthreads();
                float re[32], im[32];
#pragma unroll
                for (int n2 = 0; n2 < 32; ++n2) { re[n2] = bf1(hv[n2]); im[n2] = 0.f; }
#pragma unroll
                for (int ps = 0; ps < 5; ++ps) {
#pragma unroll
                    for (int j = 0; j < 16; ++j) {
                        const int half = 16 >> ps, grp = j >> (4 - ps), pos = j & (half - 1), i0 = (grp << (5 - ps)) + pos, i1 = i0 + half, m = pos << ps;
                        const float ar = re[i0], ai = im[i0], br = re[i1], bi = im[i1], dr = ar - br, di = ai - bi;
                        re[i0] = ar + br; im[i0] = ai + bi;
                        re[i1] = dr * C32[m] + di * S32[m]; im[i1] = di * C32[m] - dr * S32[m];
                    }
                }
#pragma unroll
                for (int i2 = 0; i2 < 32; ++i2) { const int k2 = ((i2 & 1) << 4) | ((i2 & 2) << 2) | (i2 & 4) | ((i2 & 8) >> 2) | ((i2 & 16) >> 4); const f32x2 w = TW2[i2];
                    ZB[(size_t)(base + k2 * S1 + n1) * 512 + tid] = (f32x2){re[i2] * w.x - im[i2] * w.y, re[i2] * w.y + im[i2] * w.x}; } }
            }
            __syncthreads();
            {
                LAS float* WD = (LAS float*)lds;
                LAS unsigned char* VT = lds + 63488;
                const float* wdw = p->in[I_WDW] + (size_t)l * 31 * 512;
                for (int e = tid; e < 31 * 512; e += 512) WD[e] = wdw[e];
                const float* bdw = p->in[I_BDW] + l * 512 + 8 * lane; const float* cg_ = p->in[I_CG] + l * 512 + 8 * lane; const float* cb_ = p->in[I_CB] + l * 512 + 8 * lane;
                const f32x4 bd0 = *(const f32x4*)bdw, bd1 = *(const f32x4*)(bdw + 4), lg0 = *(const f32x4*)cg_, lg1 = *(const f32x4*)(cg_ + 4), lb0 = *(const f32x4*)cb_, lb1 = *(const f32x4*)(cb_ + 4);
                for (int rb = bid; rb < M_TOK / 128; rb += G)
                for (int c = 0; c < 4; ++c) {
                    const int R0 = rb * 128 + 32 * c; int base, S; seq_of_row(R0, base, S); const int t0 = R0 - base;
                    __syncthreads();
#pragma unroll
                    for (int it = 0; it < 8; ++it) { const int idx = it * 512 + tid; if (idx < 62 * 64) { const int q = idx >> 6, c16 = idx & 63, tt = t0 - 15 + q;
                        u32x4 v = {0u, 0u, 0u, 0u}; if (tt >= 0 && tt < S) v = *(const u32x4*)(H + SEG_C + (size_t)(base + tt) * LDC + c16 * 8);
                        *(LAS u32x4*)(VT + q * 1024 + c16 * 16) = v; } }
                    __syncthreads();
                    for (int i = wave; i < 32; i += 8) {
                        bf16_t* zp = H + SEG_C + (size_t)(R0 + i) * LDC + 512 + 8 * lane;
                        const u32x4 zw = *(const u32x4*)zp;
                        f32x4 a0 = bd0, a1 = bd1;
#pragma unroll 4
                        for (int j = 0; j < 31; ++j) {
                            f32x4 v0, v1; unpack8(*(const LAS u32x4*)(VT + (i + j) * 1024 + lane * 16), v0, v1);
                            const f32x4 w0 = *(const LAS f32x4*)(WD + j * 512 + 8 * lane), w1 = *(const LAS f32x4*)(WD + j * 512 + 8 * lane + 4);
                            a0 += w0 * v0; a1 += w1 * v1;
                        }
                        const float mean = wave_sum((a0[0] + a0[1]) + (a0[2] + a0[3]) + (a1[0] + a1[1]) + (a1[2] + a1[3])) * (1.f / 512.f);
                        a0 = a0 - mean; a1 = a1 - mean;
                        const float var = wave_sum((a0[0] * a0[0] + a0[1] * a0[1]) + (a0[2] * a0[2] + a0[3] * a0[3]) + (a1[0] * a1[0] + a1[1] * a1[1]) + (a1[2] * a1[2] + a1[3] * a1[3])) * (1.f / 512.f);
                        const float rstd = 1.f / sqrtf(var + LN_EPS);
                        f32x4 y0 = a0 * rstd * lg0 + lb0, y1 = a1 * rstd * lg1 + lb1;
                        f32x4 z0, z1; unpack8(zw, z0, z1);
                        *(u32x4*)zp = pack8(silu4(y0) * z0, silu4(y1) * z1);
                    }
                }
            }
            {
                const float* bg = p->in[I_BG] + l * 1024; const float* psc = p->in[I_PSC] + l * 1024;
                for (int rb = bid; rb < M_TOK / 128; rb += G) {
                const int R0 = rb * 128; int base, S; seq_of_row(R0, base, S); const int t0 = R0 - base;
                for (int g = 0; g < 4; ++g) {
                    const int hw = 1 << g, NR = 128 + 2 * hw;
                    __syncthreads();
                    for (int idx = tid; idx < NR * 32; idx += 512) { const int q = idx >> 5, c16 = idx & 31, tt = t0 - hw + q;
                        u32x4 v = {0u, 0u, 0u, 0u}; if (tt >= 0 && tt < S) v = *(const u32x4*)(H + SEG_P + (size_t)(base + tt) * LDP + g * 256 + c16 * 8);
                        *(LAS u32x4*)(lds + q * 512 + c16 * 16) = v; }
                    __syncthreads();
                    u32x4 zws[8];
#pragma unroll
                    for (int k = 0; k < 8; ++k) { const int o = k * 512 + tid, r = o >> 5, chl = o & 31, ch = g * 32 + chl; zws[k] = *(const u32x4*)(H + SEG_P + (size_t)(R0 + r) * LDP + 1024 + ch * 8); }
                    const int chl_ = tid & 31, ch_ = g * 32 + chl_;
                    const f32x4 b0 = *(const f32x4*)(bg + ch_ * 8), b1 = *(const f32x4*)(bg + ch_ * 8 + 4), q0 = *(const f32x4*)(psc + ch_ * 8), q1 = *(const f32x4*)(psc + ch_ * 8 + 4);
#pragma unroll
                    for (int k = 0; k < 8; ++k) {
                        const int o = k * 512 + tid, r = o >> 5, chl = o & 31, t = t0 + r, ch = g * 32 + chl;
                        bf16_t* zp = H + SEG_P + (size_t)(R0 + r) * LDP + 1024 + ch * 8;
                        f32x4 s0 = {0, 0, 0, 0}, s1 = s0;
                        for (int kk = 0; kk < 2 * hw; ++kk) { f32x4 v0, v1; unpack8(*(const LAS u32x4*)(lds + (r + kk) * 512 + chl * 16), v0, v1); s0 += v0; s1 += v1; }
                        f32x4 c0, c1; unpack8(*(const LAS u32x4*)(lds + (r + hw) * 512 + chl * 16), c0, c1);
                        const float inv = 1.0f / (float)(min(t + hw, S) - max(t - hw, 0));
                        f32x4 z0, z1; unpack8(zws[k], z0, z1);
                        *(u32x4*)zp = pack8(((s0 * inv - c0) + b0) * q0 * z0, ((s1 * inv - c1) + b1) * q1 * z1);
                    }
                }
                }
            }
            {
                for (size_t e = gt; e < (size_t)M_TOK * 2; e += NGT) STATS[e] = 0.f;
                const float* pp = p->in[I_PP] + (size_t)l * M_PROMPT * PLE; const float* ps = p->in[I_PS] + (size_t)l * M_PROMPT * PLE;
                constexpr size_t NE = (size_t)M_TOK * PLE / 8;
                size_t e = gt;
                for (; e + 3 * NGT < NE; e += 4 * NGT) {
                    f32x4 pv[4][2];
#pragma unroll
                    for (int q = 0; q < 4; ++q) { const size_t o = (e + q * NGT) * 8; const float* src = o < (size_t)M_PROMPT * PLE ? pp + o : ps + (o - (size_t)M_PROMPT * PLE); pv[q][0] = *(const f32x4*)src; pv[q][1] = *(const f32x4*)(src + 4); }
#pragma unroll
                    for (int q = 0; q < 4; ++q) *(u32x4*)(PB + (e + q * NGT) * 8) = pack8(pv[q][0], pv[q][1]);
                }
                for (; e < NE; e += NGT) { const size_t o = e * 8; const float* src = o < (size_t)M_PROMPT * PLE ? pp + o : ps + (o - (size_t)M_PROMPT * PLE); *(u32x4*)(PB + o) = pack8(*(const f32x4*)src, *(const f32x4*)(src + 4)); }
            }
        }
        GRID_SYNC();
        if (PHM & 16)
        {
            TID_VARS
            KARGS
            for (int t = bid; t < 1024; t += G) {
                int base, k2, cc, lR, lCW;
                if (t < 512) { base = (t >> 6) * 2048; const int rem = t & 63; k2 = rem >> 1; cc = rem & 1; lR = 6; lCW = 8; }
                else { const int tt = t - 512; base = M_PROMPT + (tt >> 8) * 8192; const int rem = tt & 255; k2 = rem >> 3; cc = rem & 7; lR = 8; lCW = 6; }
                const int R = 1 << lR, CWm = (1 << lCW) - 1;
                __syncthreads();
                if (tid < (R >> 1)) TW[tid] = TWT[(lR == 6 ? TW_RA : TW_RB) + tid];
                const f32x2* zsrc = ZB + (size_t)(base + k2 * R) * 512 + (cc << lCW);
#pragma unroll
                for (int ih = 0; ih < 32; ih += 16) { f32x2 zv[16];
#pragma unroll
                    for (int it = 0; it < 16; ++it) { const int f = (ih + it) * 512 + tid, c = f & CWm, n1 = f >> lCW; zv[it] = zsrc[(size_t)n1 * 512 + c]; }
#pragma unroll
                    for (int it = 0; it < 16; ++it) FX[(ih + it) * 512 + tid] = zv[it]; }
                __syncthreads();
                fft_lds(FX, TW, lR, lCW, tid);
#pragma unroll 8
                for (int it = 0; it < 32; ++it) { const int f = it * 512 + tid, c = f & CWm, i1 = f >> lCW; const int k1 = (int)(__brev((unsigned)i1) >> (32 - lR));
                    const f32x2 z = FX[f]; bf16_t* o = XC + (size_t)(base + k2 + 32 * k1) * 1024 + (cc << lCW) + c;
                    o[0] = (bf16_t)(cvt_pk_bf16(z.x, 0.f) & 0xffffu); o[512] = (bf16_t)(cvt_pk_bf16(z.y, 0.f) & 0xffffu); }
            }
            __syncthreads();
            { const int tid = opaque_tid(); pg8::Gemm g{H + SEG_P + 1024, wt + WT_P, M_TOK, DM, 1024, LDP, 1024}; pg8::StaticOrder S; S.init(M_TOK, DM, G, bid);
              EpiMerge<true> E{MRG, H + SEG_G + (size_t)M_TOK * LDG}; pg8::gemm_phase(lds, g, S, E, tid); }
            { const int tid = opaque_tid(); pg8::Gemm g{H + SEG_C + 512, wt + WT_C, M_TOK, DM, 512, LDC, 512}; pg8::StaticOrder S; S.init(M_TOK, DM, G, bid);
              EpiMerge<false> E{MRG, H + SEG_G + (size_t)2 * M_TOK * LDG}; pg8::gemm_phase(lds, g, S, E, tid); }
        }
        GRID_SYNC();
        if (PHM & 32)
        {
            TID_VARS
            KARGS
            pg8::Gemm g{XC, FC, M_TOK, 512, 1024, 1024, 1024}; pg8::StaticOrder S; S.init(M_TOK, 512, G, bid);
            EpiFnet E{H}; pg8::gemm_phase(lds, g, S, E, tid);
        }
        GRID_SYNC();
        if (PHM & 64)
        {
            TID_VARS
            KARGS
            pg8::Gemm g{H + SEG_F + 512, wt + WT_F, M_TOK, DM, 512, LDF, 512}; pg8::StaticOrder S; S.init(M_TOK, DM, G, bid);
            EpiMerge<false> E{MRG, H + SEG_G}; pg8::gemm_phase(lds, g, S, E, tid);
        }
        GRID_SYNC();
        if (PHM & 128)
        {
            TID_VARS
            KARGS
            { const int tid = opaque_tid(); pg8::Gemm g{MRG, wt + WT_OUT, M_TOK, DM, DM, DM, DM}; pg8::StaticOrder S; S.init(M_TOK, DM, G, bid);
              EpiOut E{X, p->in[I_BOUT] + (size_t)l * DM, p->in[I_LNG] + (size_t)l * DM, XN, STATS}; pg8::gemm_phase(lds, g, S, E, tid); }
            { const int tid = opaque_tid(); pg8::Gemm g{PB, wt + WT_PLE, M_TOK, DM, PLE, PLE, PLE}; pg8::StaticOrder S; S.init(M_TOK, DM, G, bid);
              EpiPlain E{PLEB}; pg8::gemm_phase(lds, g, S, E, tid); }
        }
        GRID_SYNC();
        if (PHM & 512)
        {
            TID_VARS
            KARGS
            pg8::Gemm g{XN, wt + WT_PG, M_TOK, DM, DM, DM, DM}; pg8::StaticOrder S; S.init(M_TOK, DM, G, bid);
            EpiGate E{X, CGB + ((size_t)l * 2 + 0) * DM, CGB + ((size_t)l * 2 + 1) * DM, p->in[I_LNG] + (size_t)l * DM, p->in[I_LNB] + (size_t)l * DM, PLEB, XB, STATS}; pg8::gemm_phase(lds, g, S, E, tid);
        }
        if (l + 1 < DEPTH) GRID_SYNC();
    }
}

extern "C" void kernel_launch(void* const* d_in, const int* in_sizes, int n_in, void* d_out, int out_size, void* d_ws, size_t ws_size, hipStream_t stream) {
    static int grid_blocks = 0;
    if (grid_blocks == 0) {
        if (n_in != 25 || out_size != M_TOK * DM || ws_size < WS_END2) { fprintf(stderr, "kernel_launch: unexpected shapes: n_in %d out %d ws %zu (need %zu)\n", n_in, out_size, ws_size, (size_t)WS_END2); grid_blocks = -1; return; }
        int dev = 0, cus = 0, per_cu = 0;
        hipGetDevice(&dev);
        hipDeviceGetAttribute(&cus, hipDeviceAttributeMultiprocessorCount, dev);
        if (hipFuncSetAttribute((const void*)fwd_megakernel, hipFuncAttributeMaxDynamicSharedMemorySize, LDS_BYTES) != hipSuccess) { fprintf(stderr, "kernel_launch: hipFuncSetAttribute failed\n"); grid_blocks = -1; return; }
        hipOccupancyMaxActiveBlocksPerMultiprocessor(&per_cu, (const void*)fwd_megakernel, 512, LDS_BYTES);
        if (per_cu < 1) { fprintf(stderr, "kernel_launch: occupancy query says %d blocks per CU\n", per_cu); per_cu = 1; }
        (void)hipGetLastError();
        grid_blocks = cus;
    }
    if (grid_blocks < 0) return;
    if (hipMemsetAsync((char*)d_ws + OFF_BAR, 0, 16384 + (size_t)DEPTH * 2 * DM * 4, stream) != hipSuccess) { fprintf(stderr, "kernel_launch: memset failed\n"); return; }
    Params p{};
    for (int i = 0; i < 25; ++i) p.in[i] = (const float*)d_in[i];
    p.out = (float*)d_out; p.ws = (unsigned char*)d_ws; p.ph_lo = 0; p.ph_hi = 1000;
    void* args[] = {&p};
    hipError_t e = hipLaunchCooperativeKernel((const void*)fwd_megakernel, dim3(grid_blocks), dim3(512), args, LDS_BYTES, stream);
    if (e != hipSuccess) fprintf(stderr, "cooperative launch failed: %s (grid %d)\n", hipGetErrorString(e), grid_blocks);
}
```

```cpp
#include <hip/hip_runtime.h>
#include <hip/hip_cooperative_groups.h>
#include <cstdio>
namespace cg = cooperative_groups;

#define LAS __attribute__((address_space(3)))
typedef unsigned short bf16_t;
typedef short bf16x8 __attribute__((ext_vector_type(8)));
typedef float f32x4 __attribute__((ext_vector_type(4)));
typedef float f32x2 __attribute__((ext_vector_type(2)));
typedef unsigned u32x4 __attribute__((ext_vector_type(4)));
typedef unsigned u32x2 __attribute__((ext_vector_type(2)));

constexpr int M_TOK = 32768, M_PROMPT = 16384, DM = 2048, NIN = 10752, LDH = 10240, DEPTH = 4, PLE = 256;
constexpr size_t SEG_F = 0, SEG_P = SEG_F + (size_t)M_TOK * 1024, SEG_C = SEG_P + (size_t)M_TOK * 2048, SEG_G = SEG_C + (size_t)M_TOK * 1024;
constexpr int LDF = 1024, LDP = 2048, LDC = 1024, LDG = 2048;
constexpr float LN_EPS = 1e-5f;
constexpr float DN_ALPHA = 1.6817928305074290f;
constexpr size_t WT_IN = 0, WT_F = (size_t)NIN * DM, WT_P = WT_F + (size_t)DM * 512, WT_C = WT_P + (size_t)DM * 1024, WT_OUT = WT_C + (size_t)DM * 512,
                 WT_PG = WT_OUT + (size_t)DM * DM, WT_PLE = WT_PG + (size_t)DM * DM, WT_LAYER = WT_PLE + (size_t)DM * PLE;
constexpr size_t OFF_WT = 0;
constexpr size_t OFF_FC = OFF_WT + (size_t)DEPTH * WT_LAYER * 2;
constexpr size_t OFF_BIAS = OFF_FC + (size_t)512 * 1024 * 2;
constexpr size_t OFF_H = OFF_BIAS + (size_t)DEPTH * NIN * 4;
constexpr size_t OFF_MRG = OFF_H + (size_t)M_TOK * LDH * 2;
constexpr size_t OFF_XB = OFF_MRG + (size_t)M_TOK * DM * 2;
constexpr size_t OFF_XC = OFF_XB + (size_t)M_TOK * DM * 2;
constexpr size_t OFF_PB = OFF_XC + (size_t)M_TOK * 1024 * 2;
constexpr size_t WS_END = OFF_PB + (size_t)M_TOK * PLE * 2;
constexpr size_t OFF_BAR = WS_END;
constexpr size_t OFF_CGB = OFF_BAR + 16384;
constexpr size_t OFF_STATS = OFF_CGB + (size_t)DEPTH * 2 * DM * 4;
constexpr size_t OFF_TWT = OFF_STATS + (size_t)M_TOK * 2 * 4;
constexpr int TW_2A = 0, TW_2B = 64 * 32, TW_RA = TW_2B + 256 * 32, TW_RB = TW_RA + 32, TW_RC = TW_RB + 128, TW_N = TW_RC + 16;
constexpr size_t WS_END2 = OFF_TWT + (size_t)TW_N * 8;
constexpr size_t OFF_PVF = OFF_H;
constexpr size_t OFF_XN = OFF_H;
constexpr size_t OFF_PLEB = OFF_H + (size_t)M_TOK * DM * 2;
static_assert(OFF_FC % 256 == 0 && OFF_BIAS % 256 == 0 && OFF_H % 256 == 0 && OFF_MRG % 256 == 0 && OFF_XB % 256 == 0 && OFF_XC % 256 == 0 && OFF_PB % 256 == 0, "align");

constexpr int LDS_BYTES = 131072 + 4096;
#ifndef PHM
#define PHM 0xFFFF
#endif

typedef __bf16 bf16x2_t __attribute__((ext_vector_type(2)));
__device__ __forceinline__ unsigned cvt_pk_bf16(float lo, float hi) { f32x2 v = {lo, hi}; bf16x2_t b = __builtin_convertvector(v, bf16x2_t); return __builtin_bit_cast(unsigned, b); }
__device__ __forceinline__ float bf_lo(unsigned w) { return __uint_as_float(w << 16); }
__device__ __forceinline__ float bf_hi(unsigned w) { return __uint_as_float(w & 0xffff0000u); }
__device__ __forceinline__ float bf1(bf16_t h) { return __uint_as_float(((unsigned)h) << 16); }
__device__ __forceinline__ float sigmoidf_(float x) { return __builtin_amdgcn_rcpf(1.0f + __expf(-x)); }
__device__ __forceinline__ f32x4 sig4(f32x4 v) { return (f32x4){sigmoidf_(v[0]), sigmoidf_(v[1]), sigmoidf_(v[2]), sigmoidf_(v[3])}; }
__device__ __forceinline__ f32x4 silu4(f32x4 v) { return v * sig4(v); }
__device__ __forceinline__ void unpack8(u32x4 w, f32x4& a, f32x4& b) { a = (f32x4){bf_lo(w.x), bf_hi(w.x), bf_lo(w.y), bf_hi(w.y)}; b = (f32x4){bf_lo(w.z), bf_hi(w.z), bf_lo(w.w), bf_hi(w.w)}; }
__device__ __forceinline__ u32x4 pack8(f32x4 a, f32x4 b) { u32x4 w; w.x = cvt_pk_bf16(a[0], a[1]); w.y = cvt_pk_bf16(a[2], a[3]); w.z = cvt_pk_bf16(b[0], b[1]); w.w = cvt_pk_bf16(b[2], b[3]); return w; }
__device__ __forceinline__ float wave_sum(float v) {
#pragma unroll
    for (int o = 1; o < 64; o <<= 1) v += __shfl_xor(v, o);
    return v;
}
__device__ __forceinline__ int opaque_tid() { int t = threadIdx.x; asm volatile("" : "+v"(t)); return t; }
#define TID_VARS const int tid = opaque_tid(), lane = tid & 63, wave = __builtin_amdgcn_readfirstlane(tid >> 6); const int gw = bid * 8 + wave; const size_t gt = (size_t)bid * 512 + tid; (void)lane; (void)gw; (void)gt;
#define CG_SYNC() do { asm volatile("s_waitcnt vmcnt(0) lgkmcnt(0)" ::: "memory"); grid.sync(); asm volatile("" ::: "memory"); } while (0)
#define GRID_SYNC() do { asm volatile("" ::: "memory"); xcd_barrier(xbar); asm volatile("" ::: "memory"); } while (0)
#define LDS_WAIT() asm volatile("s_waitcnt lgkmcnt(0)" ::: "memory")

namespace pg8 {
constexpr int BM = 256, BK = 64, HALF = 128, HTB = HALF * BK * 2, NXCD = 8, WGM = 4;
__device__ __forceinline__ int lds_byte(int r, int c) { const int st = (r >> 4) * 2 + (c >> 5), rr = r & 15, cc = c & 31, ob = rr * 64 + cc * 2; return st * 1024 + (ob ^ (((ob >> 9) & 1) << 5)); }
__device__ __forceinline__ void stage_rc(int b, int& R, int& C) { const int st = b / 1024, sb = b % 1024, swz = sb ^ (((sb >> 9) & 1) << 5); R = (st >> 1) * 16 + swz / 64; C = (st & 1) * 32 + (swz % 64) / 2; }
__device__ __forceinline__ int perm32(int rho) { const int n = rho >> 4, i = rho & 15; return 8 * (i >> 2) + 4 * n + (i & 3); }
struct Unit { int pm, pn; };
struct Gemm { const bf16_t* A; const bf16_t* Bt; int M, N, K, lda, ldb; };
struct StaticOrder {
    int nM, nN, nwg, G, c;
    __device__ void init(int M, int N, int G_, int c_) { nM = M / BM; nN = N / BM; nwg = nM * nN; G = G_; c = c_; }
    __device__ bool next(int i, Unit& u) const {
        const long L = (long)i * G + c; if (L >= nwg) return false;
        int wgid = (int)L; { const int q = nwg / NXCD, r = nwg % NXCD, xcd = wgid % NXCD, off = wgid / NXCD; wgid = (xcd < r ? xcd * (q + 1) : r * (q + 1) + (xcd - r) * q) + off; }
        const int nig = WGM * nN, gid = wgid / nig, fm = gid * WGM, gsz = (nM - fm) < WGM ? (nM - fm) : WGM;
        u.pm = fm + ((wgid % nig) % gsz); u.pn = (wgid % nig) / gsz; return true;
    }
};
template <class Epi>
__device__ __forceinline__ void gemm_phase(LAS unsigned char* lds, const Gemm g, const StaticOrder& S, const Epi& E, const int tid) {
    const int wid = __builtin_amdgcn_readfirstlane(tid >> 6), lane = tid & 63, wr = wid >> 2, wc = wid & 3, fr = lane & 15, fq = lane >> 4;
    const int K = g.K, nt = K / BK;
    unsigned voffA[2], voffB[2];
#pragma unroll
    for (int i = 0; i < 2; ++i) { int R, C; stage_rc(tid * 16 + i * 8192, R, C); const int Rb = (R & ~31) + perm32(R & 31);
        voffA[i] = (unsigned)(R * g.lda + C) * 2u; voffB[i] = (unsigned)(Rb * g.ldb + C) * 2u; }
    const size_t kstep = (size_t)(BK * 2);
    const size_t hstepA = (size_t)HALF * g.lda * 2, hstepB = (size_t)HALF * g.ldb * 2;
    const size_t tstepA = 2 * hstepA, tstepB = 2 * hstepB;
    const unsigned ldsw = (unsigned)wid * 1024u;
    const int aoff = lds_byte(wr * 64 + fr, fq * 8), boff = lds_byte(wc * 32 + fr, fq * 8);
#define PG8_SA(b, h) (((b) * 2 + (h)) * HTB)
#define PG8_SB(b, h) ((4 + (b) * 2 + (h)) * HTB)
#define PG8_STAGE(bufoff, gbase, voff) do { _Pragma("unroll") for (int _i = 0; _i < 2; ++_i) \
        __builtin_amdgcn_global_load_lds((const unsigned*)((const char*)(gbase) + (voff)[_i]), (LAS unsigned*)(lds + (bufoff) + ldsw + _i * 8192), 16, 0, 0); } while (0)
#define PG8_LDA(dst, b, h) do { _Pragma("unroll") for (int m = 0; m < 4; ++m) _Pragma("unroll") for (int k = 0; k < 2; ++k) dst[m][k] = *(const LAS bf16x8*)(lds + PG8_SA(b, h) + aoff + m * 2048 + k * 1024); } while (0)
#define PG8_LDB(dst, b, h) do { _Pragma("unroll") for (int n = 0; n < 2; ++n) _Pragma("unroll") for (int k = 0; k < 2; ++k) dst[n][k] = *(const LAS bf16x8*)(lds + PG8_SB(b, h) + boff + n * 2048 + k * 1024); } while (0)
#define PG8_MMA(ai, bj, At, Bt) do { __builtin_amdgcn_s_setprio(1); _Pragma("unroll") for (int m = 0; m < 4; ++m) _Pragma("unroll") for (int n = 0; n < 2; ++n) _Pragma("unroll") for (int k = 0; k < 2; ++k) \
        acc[ai][bj][m][n] = __builtin_amdgcn_mfma_f32_16x16x32_bf16(Bt[n][k], At[m][k], acc[ai][bj][m][n], 0, 0, 0); __builtin_amdgcn_s_setprio(0); } while (0)
#define PG8_WAIT_V(n) asm volatile("s_waitcnt vmcnt(" #n ")" ::: "memory")
#define PG8_WAIT_L(n) asm volatile("s_waitcnt lgkmcnt(" #n ")" ::: "memory")
#define PG8_BAR __builtin_amdgcn_s_barrier()
#define PG8_SCHED __builtin_amdgcn_sched_barrier(0)
    Unit cur, nxt; int ui = 0;
    if (!S.next(0, cur)) return;
    f32x4 acc[2][2][4][2];
    E.init(acc, cur, wr, wc, fr, fq);
    bf16x8 At[4][2], B0[2][2], B1[2][2];
    const char* cA = (const char*)g.A + (size_t)cur.pm * tstepA; const char* cB = (const char*)g.Bt + (size_t)cur.pn * tstepB;
    PG8_STAGE(PG8_SB(0, 0), cB, voffB); PG8_STAGE(PG8_SA(0, 0), cA, voffA); PG8_STAGE(PG8_SB(0, 1), cB + hstepB, voffB); PG8_STAGE(PG8_SA(0, 1), cA + hstepA, voffA);
    if (wr == 1) PG8_BAR;
    PG8_WAIT_V(4); PG8_BAR;
    PG8_STAGE(PG8_SB(1, 0), cB + kstep, voffB); PG8_STAGE(PG8_SA(1, 0), cA + kstep, voffA); PG8_STAGE(PG8_SB(1, 1), cB + hstepB + kstep, voffB);
    PG8_WAIT_V(6); PG8_BAR;
    for (;;) {
        const bool has_next = S.next(ui + 1, nxt);
        const char* nA = has_next ? (const char*)g.A + (size_t)nxt.pm * tstepA : cA; const char* nB = has_next ? (const char*)g.Bt + (size_t)nxt.pn * tstepB : cB;
        for (int t = 0; t < nt; t += 2) {
            const bool last = (t == nt - 2);
            const char* a1 = cA + (size_t)(t + 1) * kstep;
            const char* a2 = last ? nA : cA + (size_t)(t + 2) * kstep; const char* b2 = last ? nB : cB + (size_t)(t + 2) * kstep;
            const char* a3 = a2 + kstep; const char* b3 = b2 + kstep;
            PG8_LDB(B0, 0, 0); PG8_SCHED; PG8_LDA(At, 0, 0); PG8_STAGE(PG8_SA(1, 1), a1 + hstepA, voffA);
            PG8_WAIT_L(8); PG8_BAR; PG8_WAIT_L(0); PG8_MMA(0, 0, At, B0); PG8_BAR; PG8_SCHED;
            PG8_LDB(B1, 0, 1); PG8_STAGE(PG8_SB(0, 0), b2, voffB);
            PG8_BAR; PG8_WAIT_L(0); PG8_MMA(0, 1, At, B1); PG8_BAR;
            PG8_LDA(At, 0, 1); PG8_STAGE(PG8_SA(0, 0), a2, voffA);
            PG8_BAR; PG8_WAIT_L(0); PG8_MMA(1, 0, At, B0); PG8_BAR; PG8_SCHED;
            PG8_STAGE(PG8_SB(0, 1), b2 + hstepB, voffB);
            PG8_WAIT_V(6); PG8_BAR; PG8_MMA(1, 1, At, B1); PG8_BAR;
            PG8_LDB(B0, 1, 0); PG8_SCHED; PG8_LDA(At, 1, 0); PG8_STAGE(PG8_SA(0, 1), a2 + hstepA, voffA);
            PG8_WAIT_L(8); PG8_BAR; PG8_WAIT_L(0); PG8_MMA(0, 0, At, B0); PG8_BAR; PG8_SCHED;
            PG8_LDB(B1, 1, 1); PG8_STAGE(PG8_SB(1, 0), b3, voffB);
            PG8_BAR; PG8_WAIT_L(0); PG8_MMA(0, 1, At, B1); PG8_BAR;
            PG8_LDA(At, 1, 1); PG8_STAGE(PG8_SA(1, 0), a3, voffA);
            PG8_BAR; PG8_WAIT_L(0); PG8_MMA(1, 0, At, B0); PG8_BAR; PG8_SCHED;
            PG8_STAGE(PG8_SB(1, 1), b3 + hstepB, voffB);
            PG8_WAIT_V(6); PG8_BAR; PG8_MMA(1, 1, At, B1); PG8_BAR;
        }
        E(acc, cur, wr, wc, fr, fq);
        if (!has_next) break;
        E.init(acc, nxt, wr, wc, fr, fq);
        cur = nxt; cA = nA; cB = nB; ++ui;
    }
    PG8_WAIT_V(0);
    if (wr == 0) PG8_BAR;
    PG8_BAR;
#undef PG8_SA
#undef PG8_SB
#undef PG8_STAGE
#undef PG8_LDA
#undef PG8_LDB
#undef PG8_MMA
#undef PG8_WAIT_V
#undef PG8_WAIT_L
#undef PG8_BAR
#undef PG8_SCHED
}
}
using pg8::Unit;

typedef const f32x4 (&AccRef)[2][2][4][2];

typedef f32x4 (&AccMut)[2][2][4][2];
__device__ __forceinline__ void acc_zero(AccMut acc) {
#pragma unroll
    for (int a = 0; a < 2; ++a)
#pragma unroll
        for (int b = 0; b < 2; ++b)
#pragma unroll
            for (int m = 0; m < 4; ++m)
#pragma unroll
                for (int n = 0; n < 2; ++n) acc[a][b][m][n] = (f32x4){0.f, 0.f, 0.f, 0.f};
}
__device__ __forceinline__ void acc_bias(AccMut acc, const float* bcol  ) {
#pragma unroll
    for (int b = 0; b < 2; ++b)
#pragma unroll
        for (int n = 0; n < 2; ++n) { const f32x4 bv = *(const f32x4*)(bcol + b * 128 + 4 * n);
#pragma unroll
            for (int a = 0; a < 2; ++a)
#pragma unroll
                for (int m = 0; m < 4; ++m) acc[a][b][m][n] = bv; }
}
struct EpiIn {
    bf16_t* H; const float* bias;
    __device__ __forceinline__ void init(AccMut acc, const Unit& u, int wr, int wc, int fr, int fq) const { acc_bias(acc, bias + u.pn * 256 + wc * 32 + 8 * fq); }
    template <int MODE> __device__ __forceinline__ void body(AccRef acc, int row0, size_t hc, int ld) const {
#pragma unroll
        for (int ai = 0; ai < 2; ++ai)
#pragma unroll
            for (int m = 0; m < 4; ++m) { bf16_t* rowp = H + (size_t)(row0 + ai * 128 + m * 16) * ld + hc;
#pragma unroll
                for (int bj = 0; bj < 2; ++bj) { f32x4 v0 = acc[ai][bj][m][0], v1 = acc[ai][bj][m][1];
                    if (MODE == 1) { v0 = silu4(v0); v1 = silu4(v1); }
                    if (MODE == 2) { v0 = sig4(v0); v1 = sig4(v1); }
                    *(u32x4*)(rowp + bj * 128) = pack8(v0, v1); } }
    }
    __device__ __forceinline__ void operator()(AccRef acc, const Unit& u, int wr, int wc, int fr, int fq) const {
        const int pn = u.pn; int mode, ld; size_t hc;
        if (pn < 2) { mode = 0; hc = SEG_F + pn * 256; ld = LDF; } else if (pn < 4) { mode = 1; hc = SEG_F + pn * 256; ld = LDF; }
        else if (pn < 8) { mode = 0; hc = SEG_P + (pn - 4) * 256; ld = LDP; } else if (pn < 12) { mode = 1; hc = SEG_P + (pn - 4) * 256; ld = LDP; }
        else if (pn < 16) { mode = 3; hc = SEG_C + (pn - 12) * 128; ld = LDC; } else if (pn < 18) { mode = 1; hc = SEG_C + 512 + (pn - 16) * 256; ld = LDC; }
        else { const int e = (pn - 18) * 256; mode = 2; hc = SEG_G + (size_t)(e >> 11) * M_TOK * LDG + (e & 2047); ld = LDG; }
        const int row0 = u.pm * 256 + wr * 64 + fr, lc = wc * 32 + 8 * fq;
        hc += lc;
        if (mode == 3) {
#pragma unroll
            for (int ai = 0; ai < 2; ++ai)
#pragma unroll
                for (int m = 0; m < 4; ++m) { bf16_t* rowp = H + (size_t)(row0 + ai * 128 + m * 16) * ld + hc;
                    const f32x4 a0 = acc[ai][0][m][0], a1 = acc[ai][0][m][1], g0 = acc[ai][1][m][0], g1 = acc[ai][1][m][1];
                    *(u32x4*)rowp = pack8(a0 * sig4(g0), a1 * sig4(g1)); }
        } else if (mode == 0) body<0>(acc, row0, hc, ld);
        else if (mode == 1) body<1>(acc, row0, hc, ld);
        else body<2>(acc, row0, hc, ld);
    }
};
struct EpiFnet {
    bf16_t* H;
    __device__ __forceinline__ void init(AccMut acc, const Unit&, int, int, int, int) const { acc_zero(acc); }
    __device__ __forceinline__ void operator()(AccRef acc, const Unit& u, int wr, int wc, int fr, int fq) const {
        const float sc = (u.pm < 64) ? 0.001953125f   : 0.0009765625f  ;
        const int row0 = u.pm * 256 + wr * 64 + fr, c0 = 512 + u.pn * 256 + wc * 32 + 8 * fq;
#pragma unroll
        for (int ai = 0; ai < 2; ++ai) {
            u32x4 zw[4][2];
#pragma unroll
            for (int m = 0; m < 4; ++m)
#pragma unroll
                for (int bj = 0; bj < 2; ++bj) zw[m][bj] = *(const u32x4*)(H + SEG_F + (size_t)(row0 + ai * 128 + m * 16) * LDF + c0 + bj * 128);
#pragma unroll
            for (int m = 0; m < 4; ++m) { bf16_t* rowp = H + SEG_F + (size_t)(row0 + ai * 128 + m * 16) * LDF + c0;
#pragma unroll
                for (int bj = 0; bj < 2; ++bj) { f32x4 z0, z1; unpack8(zw[m][bj], z0, z1);
                    *(u32x4*)(rowp + bj * 128) = pack8(acc[ai][bj][m][0] * sc * z0, acc[ai][bj][m][1] * sc * z1); } }
            asm volatile("" ::: "memory");
        }
    }
};
template <bool FIRST> struct EpiMerge {
    bf16_t* MRG; const bf16_t* gate;
    __device__ __forceinline__ void init(AccMut acc, const Unit&, int, int, int, int) const { acc_zero(acc); }
    __device__ __forceinline__ void operator()(AccRef acc, const Unit& u, int wr, int wc, int fr, int fq) const {
        const int row0 = u.pm * 256 + wr * 64 + fr, c0 = u.pn * 256 + wc * 32 + 8 * fq;
        constexpr int NB = 4;
#pragma unroll
        for (int ai = 0; ai < 2; ++ai)
#pragma unroll
        for (int mh = 0; mh < 4; mh += NB) {
            u32x4 gw[NB][2], pw[NB][2];
#pragma unroll
            for (int mm = 0; mm < NB; ++mm)
#pragma unroll
                for (int bj = 0; bj < 2; ++bj) { const size_t row = (size_t)(row0 + ai * 128 + (mh + mm) * 16);
                    gw[mm][bj] = *(const u32x4*)(gate + row * LDG + c0 + bj * 128);
                    if constexpr (FIRST) pw[mm][bj] = (u32x4){0u, 0u, 0u, 0u}; else pw[mm][bj] = *(const u32x4*)(MRG + row * DM + c0 + bj * 128); }
#pragma unroll
            for (int mm = 0; mm < NB; ++mm) { const int m = mh + mm; bf16_t* mp = MRG + (size_t)(row0 + ai * 128 + m * 16) * DM + c0;
#pragma unroll
                for (int bj = 0; bj < 2; ++bj) { f32x4 g0, g1, p0, p1; unpack8(gw[mm][bj], g0, g1); unpack8(pw[mm][bj], p0, p1);
                    *(u32x4*)(mp + bj * 128) = pack8(g0 * acc[ai][bj][m][0] + p0, g1 * acc[ai][bj][m][1] + p1); } }
            asm volatile("" ::: "memory");
        }
    }
};
struct EpiOut {
    float* X; const float* bias; const float* lng; bf16_t* YG; float* stats;
    __device__ __forceinline__ void init(AccMut acc, const Unit& u, int wr, int wc, int fr, int fq) const { acc_bias(acc, bias + u.pn * 256 + wc * 32 + 8 * fq); }
    __device__ __forceinline__ void operator()(AccRef acc, const Unit& u, int wr, int wc, int fr, int fq) const {
        const int row0 = u.pm * 256 + wr * 64 + fr, c0 = u.pn * 256 + wc * 32 + 8 * fq;
#pragma unroll
        for (int bj = 0; bj < 2; ++bj) {
            const f32x4 gv0 = *(const f32x4*)(lng + c0 + bj * 128), gv1 = *(const f32x4*)(lng + c0 + bj * 128 + 4);
#pragma unroll
            for (int ai = 0; ai < 2; ++ai)
#pragma unroll
            for (int mh = 0; mh < 4; mh += 4) {
                f32x4 xv[4][2];
#pragma unroll
                for (int m = mh; m < mh + 4; ++m)
#pragma unroll
                    for (int n = 0; n < 2; ++n) xv[m][n] = *(const f32x4*)(X + (size_t)(row0 + ai * 128 + m * 16) * DM + c0 + bj * 128 + 4 * n);
#pragma unroll
                for (int m = mh; m < mh + 4; ++m) { const int row = row0 + ai * 128 + m * 16; float* xp = X + (size_t)row * DM + c0 + bj * 128; bf16_t* yp = YG + (size_t)row * DM + c0 + bj * 128;
                    const f32x4 y0 = xv[m][0] * DN_ALPHA + acc[ai][bj][m][0], y1 = xv[m][1] * DN_ALPHA + acc[ai][bj][m][1];
                    *(f32x4*)xp = y0; *(f32x4*)(xp + 4) = y1;
                    *(u32x4*)yp = pack8(y0 * gv0, y1 * gv1);
                    float sm = (y0[0] + y0[1]) + (y0[2] + y0[3]) + (y1[0] + y1[1]) + (y1[2] + y1[3]);
                    float sq = (y0[0] * y0[0] + y0[1] * y0[1]) + (y0[2] * y0[2] + y0[3] * y0[3]) + (y1[0] * y1[0] + y1[1] * y1[1]) + (y1[2] * y1[2] + y1[3] * y1[3]);
                    sm += __shfl_xor(sm, 16); sq += __shfl_xor(sq, 16); sm += __shfl_xor(sm, 32); sq += __shfl_xor(sq, 32);
                    if (fq == 0) { (void)__hip_atomic_fetch_add(stats + 2 * row, sm, __ATOMIC_RELAXED, __HIP_MEMORY_SCOPE_AGENT); (void)__hip_atomic_fetch_add(stats + 2 * row + 1, sq, __ATOMIC_RELAXED, __HIP_MEMORY_SCOPE_AGENT); } }
                asm volatile("" ::: "memory");
            }
        }
    }
};
struct EpiPlain {
    bf16_t* O;
    __device__ __forceinline__ void init(AccMut acc, const Unit&, int, int, int, int) const { acc_zero(acc); }
    __device__ __forceinline__ void operator()(AccRef acc, const Unit& u, int wr, int wc, int fr, int fq) const {
        const int row0 = u.pm * 256 + wr * 64 + fr, c0 = u.pn * 256 + wc * 32 + 8 * fq;
#pragma unroll
        for (int ai = 0; ai < 2; ++ai)
#pragma unroll
            for (int m = 0; m < 4; ++m) { bf16_t* op = O + (size_t)(row0 + ai * 128 + m * 16) * DM + c0;
#pragma unroll
                for (int bj = 0; bj < 2; ++bj) *(u32x4*)(op + bj * 128) = pack8(acc[ai][bj][m][0], acc[ai][bj][m][1]); }
    }
};
struct EpiGate {
    float* X; const float* cg; const float* cb; const float* lng; const float* lnb; const bf16_t* PLEB; bf16_t* XB; const float* stats;
    __device__ __forceinline__ void init(AccMut acc, const Unit&, int, int, int, int) const { acc_zero(acc); }
    __device__ __forceinline__ void operator()(AccRef acc, const Unit& u, int wr, int wc, int fr, int fq) const {
        const int row0 = u.pm * 256 + wr * 64 + fr, c0 = u.pn * 256 + wc * 32 + 8 * fq;
#pragma unroll
        for (int bj = 0; bj < 2; ++bj) {
            const f32x4 g0 = *(const f32x4*)(lng + c0 + bj * 128), g1 = *(const f32x4*)(lng + c0 + bj * 128 + 4), b0 = *(const f32x4*)(lnb + c0 + bj * 128), b1 = *(const f32x4*)(lnb + c0 + bj * 128 + 4);
            const f32x4 cg0 = *(const f32x4*)(cg + c0 + bj * 128), cg1 = *(const f32x4*)(cg + c0 + bj * 128 + 4), cb0 = *(const f32x4*)(cb + c0 + bj * 128), cb1 = *(const f32x4*)(cb + c0 + bj * 128 + 4);
#pragma unroll
            for (int ai = 0; ai < 2; ++ai)
#pragma unroll
            for (int mh = 0; mh < 4; mh += 2) {
                u32x4 pw[4]; f32x4 yv[4][2]; f32x2 st[4];
#pragma unroll
                for (int m = mh; m < mh + 2; ++m) { const int row = row0 + ai * 128 + m * 16; const size_t ro = (size_t)row * DM + c0 + bj * 128;
                    pw[m] = *(const u32x4*)(PLEB + ro); yv[m][0] = *(const f32x4*)(X + ro); yv[m][1] = *(const f32x4*)(X + ro + 4); st[m] = *(const f32x2*)(stats + 2 * row); }
#pragma unroll
                for (int m = mh; m < mh + 2; ++m) { const int row = row0 + ai * 128 + m * 16; const size_t ro = (size_t)row * DM + c0 + bj * 128;
                    const float mu = st[m].x * (1.f / DM), var = st[m].y * (1.f / DM) - mu * mu, r = 1.f / sqrtf(var + LN_EPS);
                    f32x4 p0, p1; unpack8(pw[m], p0, p1);
                    const f32x4 x0 = (yv[m][0] - mu) * r * g0 + b0, x1 = (yv[m][1] - mu) * r * g1 + b1;
                    const f32x4 o0 = x0 + sig4((acc[ai][bj][m][0] - mu * cg0) * r + cb0) * p0, o1 = x1 + sig4((acc[ai][bj][m][1] - mu * cg1) * r + cb1) * p1;
                    *(f32x4*)(X + ro) = o0; *(f32x4*)(X + ro + 4) = o1; if (XB) *(u32x4*)(XB + ro) = pack8(o0, o1); }
                asm volatile("" ::: "memory");
            }
        }
    }
};

struct Params { const float* in[25]; float* out; unsigned char* ws; int ph_lo, ph_hi; };
enum { I_XP = 0, I_XS, I_PP, I_PS, I_EG, I_EB, I_WIN, I_BIN, I_WF, I_WG, I_BG, I_PSC, I_WP, I_WDW, I_BDW, I_CG, I_CB, I_WC, I_WOUT, I_BOUT, I_LNG, I_LNB, I_WPLE, I_WPG, I_BPG };

__device__ __forceinline__ void seq_of_row(int row, int& base, int& S) {
    if (row < M_PROMPT) { S = 2048; base = row & ~2047; } else { S = 8192; base = M_PROMPT + ((row - M_PROMPT) & ~8191); }
}

__device__ __forceinline__ void ln_row(const float* src, float* dstf, bf16_t* dstb, const float* g, const float* b, int lane) {
    f32x4 v[8]; float s = 0.f;
#pragma unroll
    for (int j = 0; j < 8; ++j) { v[j] = ((const f32x4*)src)[lane + 64 * j]; s += (v[j][0] + v[j][1]) + (v[j][2] + v[j][3]); }
    const float mean = wave_sum(s) * (1.f / DM); float s2 = 0.f;
#pragma unroll
    for (int j = 0; j < 8; ++j) { v[j] = v[j] - mean; s2 += (v[j][0] * v[j][0] + v[j][1] * v[j][1]) + (v[j][2] * v[j][2] + v[j][3] * v[j][3]); }
    const float rstd = 1.f / sqrtf(wave_sum(s2) * (1.f / DM) + LN_EPS);
#pragma unroll
    for (int j = 0; j < 8; ++j) { const f32x4 gg = ((const f32x4*)g)[lane + 64 * j], bb = ((const f32x4*)b)[lane + 64 * j]; const f32x4 o = v[j] * rstd * gg + bb;
        ((f32x4*)dstf)[lane + 64 * j] = o; u32x2 w; w.x = cvt_pk_bf16(o[0], o[1]); w.y = cvt_pk_bf16(o[2], o[3]); ((u32x2*)dstb)[lane + 64 * j] = w; }
}

__device__ __forceinline__ void transpose_item(const float* W, int ldw, int col0, bf16_t* WT, int ldt, int row0, int k0, LAS float* scr, int lane) {
    { float wv[32];
#pragma unroll
    for (int i = 0; i < 32; ++i) { const int kk = 2 * i + (lane >> 5); wv[i] = W[(size_t)(k0 + kk) * ldw + col0 + (lane & 31)]; }
#pragma unroll
    for (int i = 0; i < 32; ++i) { const int kk = 2 * i + (lane >> 5); scr[kk * 33 + (lane & 31)] = wv[i]; } }
    LDS_WAIT();
    const int c = lane & 7;
#pragma unroll
    for (int j = 0; j < 4; ++j) { const int n = (lane >> 3) + 8 * j; const LAS float* s = scr + (8 * c) * 33 + n;
        u32x4 o; o.x = cvt_pk_bf16(s[0 * 33], s[1 * 33]); o.y = cvt_pk_bf16(s[2 * 33], s[3 * 33]); o.z = cvt_pk_bf16(s[4 * 33], s[5 * 33]); o.w = cvt_pk_bf16(s[6 * 33], s[7 * 33]);
        *(u32x4*)(WT + (size_t)(row0 + n) * ldt + k0 + 8 * c) = o; }
    LDS_WAIT();
}

constexpr float C32[16] = {1.000000000e+00f, 9.807852804e-01f, 9.238795325e-01f, 8.314696123e-01f, 7.071067812e-01f, 5.555702330e-01f, 3.826834324e-01f, 1.950903220e-01f, 6.123233996e-17f, -1.950903220e-01f, -3.826834324e-01f, -5.555702330e-01f, -7.071067812e-01f, -8.314696123e-01f, -9.238795325e-01f, -9.807852804e-01f};
constexpr float S32[16] = {0.000000000e+00f, 1.950903220e-01f, 3.826834324e-01f, 5.555702330e-01f, 7.071067812e-01f, 8.314696123e-01f, 9.238795325e-01f, 9.807852804e-01f, 1.000000000e+00f, 9.807852804e-01f, 9.238795325e-01f, 8.314696123e-01f, 7.071067812e-01f, 5.555702330e-01f, 3.826834324e-01f, 1.950903220e-01f};
__device__ __forceinline__ void fft_lds(LAS f32x2* X, const LAS f32x2* tw, int logR, int logCW, int tid) {
    const int CWm = (1 << logCW) - 1;
    for (int p = 0; p < logR; ++p) {
        const int lh = logR - 1 - p, half = 1 << lh;
#pragma unroll 4
        for (int it = 0; it < 16; ++it) {
            const int f = it * 512 + tid, c = f & CWm, j = f >> logCW, grp = j >> lh, pos = j & (half - 1);
            const int i0 = ((grp << (lh + 1)) + pos), i1 = i0 + half;
            const f32x2 a = X[(i0 << logCW) + c], b = X[(i1 << logCW) + c], w = tw[pos << p];
            const f32x2 d = a - b;
            X[(i0 << logCW) + c] = a + b;
            X[(i1 << logCW) + c] = (f32x2){d.x * w.x - d.y * w.y, d.x * w.y + d.y * w.x};
        }
        __syncthreads();
    }
}


#define XB_TMO      128
#define XB_XCNT(j)  (256  + 64 * (j))
#define XB_XSUB(j)  (1280 + 64 * (j))
#define XB_XGEN(j)  (2304 + 64 * (j))
#define XB_TOP      3328
#define XB_TOPGEN   3392
#define XCD_BAR_WORDS 3456
#define XB_SPIN_CAP (1u << 22)
__device__ __forceinline__ unsigned xb_ld(unsigned* p)              { return __hip_atomic_load(p, __ATOMIC_RELAXED, __HIP_MEMORY_SCOPE_AGENT); }
__device__ __forceinline__ unsigned xb_add(unsigned* p, unsigned v) { return __hip_atomic_fetch_add(p, v, __ATOMIC_RELAXED, __HIP_MEMORY_SCOPE_AGENT); }
__device__ __forceinline__ unsigned xb_xcc_id() { return (unsigned)__builtin_amdgcn_s_getreg((3 << 11) | 20) & 0xFu; }
#define XB_SPIN(cond, bar) do { unsigned _sp = 0; while (cond) { __builtin_amdgcn_s_sleep(1); \
    if ((++_sp & 255u) == 0u) { if (xb_ld(&(bar)[XB_TMO])) break; if (_sp > XB_SPIN_CAP) { atomicAdd(&(bar)[XB_TMO], 1u); break; } } } } while (0)
struct XcdBarrier { unsigned* bar; unsigned x; volatile LAS unsigned* st; };
__device__ __forceinline__ XcdBarrier xcd_barrier_post(unsigned* bar, volatile LAS unsigned* st) {
    XcdBarrier b; b.bar = bar; b.x = xb_xcc_id(); b.st = st;
    if (threadIdx.x == 0) (void)xb_add(&bar[XB_XCNT(b.x)], 1u);
    return b;
}
__device__ __forceinline__ void xcd_barrier_complete(unsigned* bar, unsigned x, unsigned& nloc, unsigned& nx) {
    const unsigned G = gridDim.x * gridDim.y * gridDim.z;
    unsigned sum, cnt, mine, sp = 0u;
    for (;;) {
        sum = 0u; cnt = 0u; mine = 0u;
#pragma unroll
        for (unsigned j = 0; j < 16; ++j) { const unsigned c = xb_ld(&bar[XB_XCNT(j)]); sum += c; cnt += (c > 0u) ? 1u : 0u; mine = (j == x) ? c : mine; }
        if (sum == G) break;
        __builtin_amdgcn_s_sleep(1);
        if ((++sp & 255u) == 0u) { if (xb_ld(&bar[XB_TMO])) break; if (sp > XB_SPIN_CAP) { atomicAdd(&bar[XB_TMO], 1u); break; } }
    }
    nloc = mine > 0u ? mine : 1u; nx = cnt > 0u ? cnt : 1u;
}
__device__ __forceinline__ void xcd_barrier(const XcdBarrier& b) {
    asm volatile("s_waitcnt vmcnt(0)" ::: "memory");
    __syncthreads();
    if (threadIdx.x == 0) {
        unsigned long long bar_ = (unsigned long long)b.bar; unsigned bx = b.x;
        asm volatile("" : "+s"(bar_), "+s"(bx));
        unsigned* bar = (unsigned*)bar_;
        __builtin_amdgcn_s_waitcnt(0);
        unsigned nloc = b.st[0], nx = b.st[1];
        if (nloc == 0u) { xcd_barrier_complete(bar, bx, nloc, nx); b.st[0] = nloc; b.st[1] = nx; }
        const unsigned old = xb_add(&bar[XB_XSUB(bx)], 1u);
        const unsigned gen = old / nloc;
        if (old + 1u == (gen + 1u) * nloc) {
            __builtin_amdgcn_fence(__ATOMIC_RELEASE, "agent");
            asm volatile("s_waitcnt vmcnt(0)" ::: "memory");
            const unsigned og = xb_add(&bar[XB_TOP], 1u);
            const unsigned tg = og / nx;
            if (og + 1u == (tg + 1u) * nx) xb_add(&bar[XB_TOPGEN], 1u);
            else XB_SPIN(xb_ld(&bar[XB_TOPGEN]) == tg, bar);
            __builtin_amdgcn_fence(__ATOMIC_ACQUIRE, "agent");
            xb_add(&bar[XB_XGEN(bx)], 1u);
            asm volatile("s_waitcnt vmcnt(0)" ::: "memory");
        } else {
            XB_SPIN(xb_ld(&bar[XB_XGEN(bx)]) == gen, bar);
            __builtin_amdgcn_fence(__ATOMIC_ACQUIRE, "agent");
            asm volatile("s_waitcnt vmcnt(0)" ::: "memory");
        }
    }
    __syncthreads();
}

typedef const __attribute__((address_space(4))) Params* KP;
__device__ __forceinline__ KP kparams() { unsigned long long k = (unsigned long long)__builtin_amdgcn_kernarg_segment_ptr(); asm volatile("" : "+s"(k)); return (KP)k; }
#define KARGS0 KP p = kparams(); unsigned char* ws = p->ws; \
    bf16_t* WT = (bf16_t*)(ws + OFF_WT); bf16_t* FC = (bf16_t*)(ws + OFF_FC); float* BIASP = (float*)(ws + OFF_BIAS); \
    bf16_t* H = (bf16_t*)(ws + OFF_H); bf16_t* MRG = (bf16_t*)(ws + OFF_MRG); bf16_t* XB = (bf16_t*)(ws + OFF_XB); f32x2* ZB = (f32x2*)(ws + OFF_XB); \
    bf16_t* XC = (bf16_t*)(ws + OFF_XC); bf16_t* PB = (bf16_t*)(ws + OFF_PB); float* PVF = (float*)(ws + OFF_PVF); \
    bf16_t* XN = (bf16_t*)(ws + OFF_XN); bf16_t* PLEB = (bf16_t*)(ws + OFF_PLEB); float* X = p->out; \
    float* CGB = (float*)(ws + OFF_CGB); float* STATS = (float*)(ws + OFF_STATS); f32x2* TWT = (f32x2*)(ws + OFF_TWT); (void)TWT; \
    (void)WT; (void)FC; (void)BIASP; (void)H; (void)MRG; (void)XB; (void)ZB; (void)XC; (void)PB; (void)PVF; (void)XN; (void)PLEB; (void)X; (void)CGB; (void)STATS;
#define KARGS KARGS0 const bf16_t* wt = WT + (size_t)l * WT_LAYER; (void)wt;
__global__ void __launch_bounds__(512, 2) fwd_megakernel(Params p_) {
    extern __shared__ __attribute__((aligned(16))) unsigned char smem[];
    cg::grid_group grid = cg::this_grid();
    LAS unsigned char* lds = (LAS unsigned char*)smem;
    const int G = gridDim.x, bid = blockIdx.x;
    const int NGW = G * 8;
    const size_t NGT = (size_t)G * 512;
    volatile LAS unsigned* xst = (volatile LAS unsigned*)(lds + 131072 + 4000);
    if (threadIdx.x < 2) xst[threadIdx.x] = 0u;
    __syncthreads();
    const XcdBarrier xbar = xcd_barrier_post((unsigned*)(kparams()->ws + OFF_BAR), xst);

    if (PHM & 1)
    {
        TID_VARS
            KARGS0
        const float* w_in = p->in[I_WIN]; const float* wg = p->in[I_WG];
        for (int task = gw; task < DEPTH * 512 * 4; task += NGW) {
            const int g = task & 3, kb = (task >> 2) & 511, l = task >> 11;
            const float* a = w_in + ((size_t)l * DM + kb * 4) * NIN + 1024 + g * 256;
            const float* b = wg + ((size_t)(l * 4 + g) * 256) * 256 + 4 * lane;
            f32x4 acc0 = {0, 0, 0, 0}, acc1 = acc0, acc2 = acc0, acc3 = acc0;
#pragma unroll 8
            for (int c = 0; c < 256; ++c) { const f32x4 bv = *(const f32x4*)(b + (size_t)c * 256);
                acc0 += a[c] * bv; acc1 += a[NIN + c] * bv; acc2 += a[2 * NIN + c] * bv; acc3 += a[3 * NIN + c] * bv; }
            float* o = PVF + ((size_t)l * DM + kb * 4) * 1024 + g * 256 + 4 * lane;
            *(f32x4*)o = acc0; *(f32x4*)(o + 1024) = acc1; *(f32x4*)(o + 2048) = acc2; *(f32x4*)(o + 3072) = acc3;
        }
        const float* b_in = p->in[I_BIN];
        for (size_t e = gt; e < (size_t)DEPTH * NIN; e += NGT) {
            const int l = (int)(e / NIN), n = (int)(e % NIN); float v;
            if (n >= 1024 && n < 2048) v = 0.f;
            else if (n >= 3072 && n < 4096) { const int j = (n - 3072) >> 8, lc = (n - 3072) & 255; v = b_in[(size_t)l * NIN + (lc < 128 ? 3072 + j * 128 + lc : 3584 + j * 128 + (lc - 128))]; }
            else v = b_in[(size_t)l * NIN + n];
            BIASP[e] = v;
        }
        for (size_t e = gt; e < (size_t)512 * 1024; e += NGT) {
            const int r = (int)(e >> 10), q = (int)(e & 1023), g = r >> 7, d = r & 127, half = q >> 9, g2 = (q >> 7) & 3, c = q & 127;
            float v = 0.f;
            if (g == g2) { const float ang = (float)((c * d) & 127) * (1.0f / 64.0f); v = half ? sinpif(ang) : cospif(ang); }
            FC[e] = (bf16_t)(cvt_pk_bf16(v, 0.f) & 0xffffu);
        }
        for (size_t e = gt; e < (size_t)DEPTH * DM * 16; e += NGT) {
            const int kc = (int)(e / ((size_t)DEPTH * DM)), le = (int)(e % ((size_t)DEPTH * DM)), l = le / DM, col = le % DM;
            const float* w = p->in[I_WPG] + ((size_t)l * DM + kc * 128) * DM + col; const float* g = p->in[I_LNG] + l * DM + kc * 128; const float* b = p->in[I_LNB] + l * DM + kc * 128;
            float sg = 0.f, sb = (kc == 0) ? p->in[I_BPG][l * DM + col] : 0.f;
#pragma unroll 8
            for (int k = 0; k < 128; ++k) { const float wv = w[(size_t)k * DM]; sg += g[k] * wv; sb += b[k] * wv; }
            (void)__hip_atomic_fetch_add(CGB + ((size_t)l * 2 + 0) * DM + col, sg, __ATOMIC_RELAXED, __HIP_MEMORY_SCOPE_AGENT);
            (void)__hip_atomic_fetch_add(CGB + ((size_t)l * 2 + 1) * DM + col, sb, __ATOMIC_RELAXED, __HIP_MEMORY_SCOPE_AGENT);
        }
        for (size_t e = gt; e < (size_t)TW_N; e += NGT) {
            float ang;
            if (e < (size_t)TW_RA) { const int big = e >= (size_t)TW_2B, ee = (int)e - (big ? TW_2B : 0), n1 = ee >> 5, i2 = ee & 31, k2 = (int)(__brev((unsigned)i2) >> 27), lS = big ? 13 : 11;
                ang = (float)((k2 * n1) & ((1 << lS) - 1)) * (2.0f / (float)(1 << lS)); }
            else if (e < (size_t)TW_RB) ang = (float)(e - TW_RA) * (2.0f / 64.f);
            else if (e < (size_t)TW_RC) ang = (float)(e - TW_RB) * (2.0f / 256.f);
            else ang = (float)(e - TW_RC) * (2.0f / 32.f);
            TWT[e] = (f32x2){cospif(ang), -sinpif(ang)};
        }
        for (int row = gw; row < M_TOK; row += NGW) {
            const float* src = row < M_PROMPT ? p->in[I_XP] + (size_t)row * DM : p->in[I_XS] + (size_t)(row - M_PROMPT) * DM;
            ln_row(src, X + (size_t)row * DM, XB + (size_t)row * DM, p->in[I_EG], p->in[I_EB], lane);
        }
    }
    if (kparams()->ph_lo < 0) CG_SYNC();
    GRID_SYNC();
    if (PHM & 2)
    {
        TID_VARS
            KARGS0
        LAS float* scr = (LAS float*)(lds + wave * 16384);
        constexpr int IT_IN = 32 * 336, IT_F = 8 * 64, IT_P = 16 * 64, IT_C = 8 * 64, IT_OUT = 32 * 64, IT_PG = 32 * 64, IT_PLE = 4 * 64;
        constexpr int IT_LAYER = IT_IN + IT_F + IT_P + IT_C + IT_OUT + IT_PG + IT_PLE;
        for (int it = gw; it < DEPTH * IT_LAYER; it += NGW) {
            const int l = it / IT_LAYER; int r = it % IT_LAYER;
            bf16_t* wt = WT + (size_t)l * WT_LAYER;
            if (r < IT_IN) {
                const int kb = r / 336, nb = r % 336, n0 = nb * 32, k0 = kb * 64;
                const float* src = p->in[I_WIN] + (size_t)l * DM * NIN; int ldw = NIN, col0 = n0;
                if (n0 >= 1024 && n0 < 2048) { src = PVF + (size_t)l * DM * 1024; ldw = 1024; col0 = n0 - 1024; }
                else if (n0 >= 3072 && n0 < 4096) { const int j = (n0 - 3072) >> 8, lc = (n0 - 3072) & 255; col0 = lc < 128 ? 3072 + j * 128 + lc : 3584 + j * 128 + (lc - 128); }
                transpose_item(src, ldw, col0, wt + WT_IN, DM, n0, k0, scr, lane); continue; }
            r -= IT_IN;
            if (r < IT_F) { transpose_item(p->in[I_WF] + (size_t)l * 512 * DM, DM, (r % 64) * 32, wt + WT_F, 512, (r % 64) * 32, (r / 64) * 64, scr, lane); continue; }
            r -= IT_F;
            if (r < IT_P) { transpose_item(p->in[I_WP] + (size_t)l * 1024 * DM, DM, (r % 64) * 32, wt + WT_P, 1024, (r % 64) * 32, (r / 64) * 64, scr, lane); continue; }
            r -= IT_P;
            if (r < IT_C) { transpose_item(p->in[I_WC] + (size_t)l * 512 * DM, DM, (r % 64) * 32, wt + WT_C, 512, (r % 64) * 32, (r / 64) * 64, scr, lane); continue; }
            r -= IT_C;
            if (r < IT_OUT) { transpose_item(p->in[I_WOUT] + (size_t)l * DM * DM, DM, (r % 64) * 32, wt + WT_OUT, DM, (r % 64) * 32, (r / 64) * 64, scr, lane); continue; }
            r -= IT_OUT;
            if (r < IT_PG) { transpose_item(p->in[I_WPG] + (size_t)l * DM * DM, DM, (r % 64) * 32, wt + WT_PG, DM, (r % 64) * 32, (r / 64) * 64, scr, lane); continue; }
            r -= IT_PG;
            transpose_item(p->in[I_WPLE] + (size_t)l * PLE * DM, DM, (r % 64) * 32, wt + WT_PLE, PLE, (r % 64) * 32, (r / 64) * 64, scr, lane);
        }
    }
    GRID_SYNC();

    LAS f32x2* FX = (LAS f32x2*)lds;
    LAS f32x2* TW = (LAS f32x2*)(lds + 131072);
    LAS f32x2* TW2 = (LAS f32x2*)(lds + 131072 + 2048);

    for (int l = 0; l < DEPTH; ++l) {
        if (PHM & 4)
        {
            TID_VARS
            KARGS
            pg8::Gemm g{XB, wt + WT_IN, M_TOK, NIN, DM, DM, DM}; pg8::StaticOrder S; S.init(M_TOK, NIN, G, bid);
            EpiIn E{H, BIASP + (size_t)l * NIN};
            pg8::gemm_phase(lds, g, S, E, tid);
        }
        GRID_SYNC();
        if (PHM & 8)
        {
            TID_VARS
            KARGS
            if (tid < 16) TW[tid] = TWT[TW_RC + tid];
            for (int t = bid; t < 1024; t += G) {
                int base, n1, S1, lS;
                if (t < 512) { base = (t >> 6) * 2048; n1 = t & 63; S1 = 64; lS = 11; } else { const int tt = t - 512; base = M_PROMPT + (tt >> 8) * 8192; n1 = tt & 255; S1 = 256; lS = 13; }
                __syncthreads();
                if (tid < 32) TW2[tid] = TWT[(t < 512 ? TW_2A : TW_2B) + n1 * 32 + tid];
                { bf16_t hv[32];
#pragma unroll
                for (int n2 = 0; n2 < 32; ++n2) hv[n2] = H[SEG_F + (size_t)(base + n1 + S1 * n2) * LDF + tid];
                __syncthreads();
                float re[32], im[32];
#pragma unroll
                for (int n2 = 0; n2 < 32; ++n2) { re[n2] = bf1(hv[n2]); im[n2] = 0.f; }
#pragma unroll
                for (int ps = 0; ps < 5; ++ps) {
#pragma unroll
                    for (int j = 0; j < 16; ++j) {
                        const int half = 16 >> ps, grp = j >> (4 - ps), pos = j & (half - 1), i0 = (grp << (5 - ps)) + pos, i1 = i0 + half, m = pos << ps;
                        const float ar = re[i0], ai = im[i0], br = re[i1], bi = im[i1], dr = ar - br, di = ai - bi;
                        re[i0] = ar + br; im[i0] = ai + bi;
                        re[i1] = dr * C32[m] + di * S32[m]; im[i1] = di * C32[m] - dr * S32[m];
                    }
                }
#pragma unroll
                for (int i2 = 0; i2 < 32; ++i2) { const int k2 = ((i2 & 1) << 4) | ((i2 & 2) << 2) | (i2 & 4) | ((i2 & 8) >> 2) | ((i2 & 16) >> 4); const f32x2 w = TW2[i2];
                    ZB[(size_t)(base + k2 * S1 + n1) * 512 + tid] = (f32x2){re[i2] * w.x - im[i2] * w.y, re[i2] * w.y + im[i2] * w.x}; } }
            }
            __syncthreads();
            {
                LAS float* WD = (LAS float*)lds;
                LAS unsigned char* VT = lds + 63488;
                const float* wdw = p->in[I_WDW] + (size_t)l * 31 * 512;
                for (int e = tid; e < 31 * 512; e += 512) WD[e] = wdw[e];
                const float* bdw = p->in[I_BDW] + l * 512 + 8 * lane; const float* cg_ = p->in[I_CG] + l * 512 + 8 * lane; const float* cb_ = p->in[I_CB] + l * 512 + 8 * lane;
                const f32x4 bd0 = *(const f32x4*)bdw, bd1 = *(const f32x4*)(bdw + 4), lg0 = *(const f32x4*)cg_, lg1 = *(const f32x4*)(cg_ + 4), lb0 = *(const f32x4*)cb_, lb1 = *(const f32x4*)(cb_ + 4);
                for (int rb = bid; rb < M_TOK / 128; rb += G)
                for (int c = 0; c < 4; ++c) {
                    const int R0 = rb * 128 + 32 * c; int base, S; seq_of_row(R0, base, S); const int t0 = R0 - base;
                    __syncthreads();
#pragma unroll
                    for (int it = 0; it < 8; ++it) { const int idx = it * 512 + tid; if (idx < 62 * 64) { const int q = idx >> 6, c16 = idx & 63, tt = t0 - 15 + q;
                        u32x4 v = {0u, 0u, 0u, 0u}; if (tt >= 0 && tt < S) v = *(const u32x4*)(H + SEG_C + (size_t)(base + tt) * LDC + c16 * 8);
                        *(LAS u32x4*)(VT + q * 1024 + c16 * 16) = v; } }
                    __syncthreads();
                    for (int i = wave; i < 32; i += 8) {
                        bf16_t* zp = H + SEG_C + (size_t)(R0 + i) * LDC + 512 + 8 * lane;
                        const u32x4 zw = *(const u32x4*)zp;
                        f32x4 a0 = bd0, a1 = bd1;
#pragma unroll 4
                        for (int j = 0; j < 31; ++j) {
                            f32x4 v0, v1; unpack8(*(const LAS u32x4*)(VT + (i + j) * 1024 + lane * 16), v0, v1);
                            const f32x4 w0 = *(const LAS f32x4*)(WD + j * 512 + 8 * lane), w1 = *(const LAS f32x4*)(WD + j * 512 + 8 * lane + 4);
                            a0 += w0 * v0; a1 += w1 * v1;
                        }
                        const float mean = wave_sum((a0[0] + a0[1]) + (a0[2] + a0[3]) + (a1[0] + a1[1]) + (a1[2] + a1[3])) * (1.f / 512.f);
                        a0 = a0 - mean; a1 = a1 - mean;
                        const float var = wave_sum((a0[0] * a0[0] + a0[1] * a0[1]) + (a0[2] * a0[2] + a0[3] * a0[3]) + (a1[0] * a1[0] + a1[1] * a1[1]) + (a1[2] * a1[2] + a1[3] * a1[3])) * (1.f / 512.f);
                        const float rstd = 1.f / sqrtf(var + LN_EPS);
                        f32x4 y0 = a0 * rstd * lg0 + lb0, y1 = a1 * rstd * lg1 + lb1;
                        f32x4 z0, z1; unpack8(zw, z0, z1);
                        *(u32x4*)zp = pack8(silu4(y0) * z0, silu4(y1) * z1);
                    }
                }
            }
            {
                const float* bg = p->in[I_BG] + l * 1024; const float* psc = p->in[I_PSC] + l * 1024;
                for (int rb = bid; rb < M_TOK / 128; rb += G) {
                const int R0 = rb * 128; int base, S; seq_of_row(R0, base, S); const int t0 = R0 - base;
                for (int g = 0; g < 4; ++g) {
                    const int hw = 1 << g, NR = 128 + 2 * hw;
                    __syncthreads();
                    for (int idx = tid; idx < NR * 32; idx += 512) { const int q = idx >> 5, c16 = idx & 31, tt = t0 - hw + q;
                        u32x4 v = {0u, 0u, 0u, 0u}; if (tt >= 0 && tt < S) v = *(const u32x4*)(H + SEG_P + (size_t)(base + tt) * LDP + g * 256 + c16 * 8);
                        *(LAS u32x4*)(lds + q * 512 + c16 * 16) = v; }
                    __syncthreads();
                    u32x4 zws[8];
#pragma unroll
                    for (int k = 0; k < 8; ++k) { const int o = k * 512 + tid, r = o >> 5, chl = o & 31, ch = g * 32 + chl; zws[k] = *(const u32x4*)(H + SEG_P + (size_t)(R0 + r) * LDP + 1024 + ch * 8); }
                    const int chl_ = tid & 31, ch_ = g * 32 + chl_;
                    const f32x4 b0 = *(const f32x4*)(bg + ch_ * 8), b1 = *(const f32x4*)(bg + ch_ * 8 + 4), q0 = *(const f32x4*)(psc + ch_ * 8), q1 = *(const f32x4*)(psc + ch_ * 8 + 4);
#pragma unroll
                    for (int k = 0; k < 8; ++k) {
                        const int o = k * 512 + tid, r = o >> 5, chl = o & 31, t = t0 + r, ch = g * 32 + chl;
                        bf16_t* zp = H + SEG_P + (size_t)(R0 + r) * LDP + 1024 + ch * 8;
                        f32x4 s0 = {0, 0, 0, 0}, s1 = s0;
                        for (int kk = 0; kk < 2 * hw; ++kk) { f32x4 v0, v1; unpack8(*(const LAS u32x4*)(lds + (r + kk) * 512 + chl * 16), v0, v1); s0 += v0; s1 += v1; }
                        f32x4 c0, c1; unpack8(*(const LAS u32x4*)(lds + (r + hw) * 512 + chl * 16), c0, c1);
                        const float inv = 1.0f / (float)(min(t + hw, S) - max(t - hw, 0));
                        f32x4 z0, z1; unpack8(zws[k], z0, z1);
                        *(u32x4*)zp = pack8(((s0 * inv - c0) + b0) * q0 * z0, ((s1 * inv - c1) + b1) * q1 * z1);
                    }
                }
                }
            }
            {
                for (size_t e = gt; e < (size_t)M_TOK * 2; e += NGT) STATS[e] = 0.f;
                const float* pp = p->in[I_PP] + (size_t)l * M_PROMPT * PLE; const float* ps = p->in[I_PS] + (size_t)l * M_PROMPT * PLE;
                constexpr size_t NE = (size_t)M_TOK * PLE / 8;
                size_t e = gt;
                for (; e + 3 * NGT < NE; e += 4 * NGT) {
                    f32x4 pv[4][2];
#pragma unroll
                    for (int q = 0; q < 4; ++q) { const size_t o = (e + q * NGT) * 8; const float* src = o < (size_t)M_PROMPT * PLE ? pp + o : ps + (o - (size_t)M_PROMPT * PLE); pv[q][0] = *(const f32x4*)src; pv[q][1] = *(const f32x4*)(src + 4); }
#pragma unroll
                    for (int q = 0; q < 4; ++q) *(u32x4*)(PB + (e + q * NGT) * 8) = pack8(pv[q][0], pv[q][1]);
                }
                for (; e < NE; e += NGT) { const size_t o = e * 8; const float* src = o < (size_t)M_PROMPT * PLE ? pp + o : ps + (o - (size_t)M_PROMPT * PLE); *(u32x4*)(PB + o) = pack8(*(const f32x4*)src, *(const f32x4*)(src + 4)); }
            }
        }
        GRID_SYNC();
        if (PHM & 16)
        {
            TID_VARS
            KARGS
            for (int t = bid; t < 1024; t += G) {
                int base, k2, cc, lR, lCW;
                if (t < 512) { base = (t >> 6) * 2048; const int rem = t & 63; k2 = rem >> 1; cc = rem & 1; lR = 6; lCW = 8; }
                else { const int tt = t - 512; base = M_PROMPT + (tt >> 8) * 8192; const int rem = tt & 255; k2 = rem >> 3; cc = rem & 7; lR = 8; lCW = 6; }
                const int R = 1 << lR, CWm = (1 << lCW) - 1;
                __syncthreads();
                if (tid < (R >> 1)) TW[tid] = TWT[(lR == 6 ? TW_RA : TW_RB) + tid];
                const f32x2* zsrc = ZB + (size_t)(base + k2 * R) * 512 + (cc << lCW);
#pragma unroll
                for (int ih = 0; ih < 32; ih += 16) { f32x2 zv[16];
#pragma unroll
                    for (int it = 0; it < 16; ++it) { const int f = (ih + it) * 512 + tid, c = f & CWm, n1 = f >> lCW; zv[it] = zsrc[(size_t)n1 * 512 + c]; }
#pragma unroll
                    for (int it = 0; it < 16; ++it) FX[(ih + it) * 512 + tid] = zv[it]; }
                __syncthreads();
                fft_lds(FX, TW, lR, lCW, tid);
#pragma unroll 8
                for (int it = 0; it < 32; ++it) { const int f = it * 512 + tid, c = f & CWm, i1 = f >> lCW; const int k1 = (int)(__brev((unsigned)i1) >> (32 - lR));
                    const f32x2 z = FX[f]; bf16_t* o = XC + (size_t)(base + k2 + 32 * k1) * 1024 + (cc << lCW) + c;
                    o[0] = (bf16_t)(cvt_pk_bf16(z.x, 0.f) & 0xffffu); o[512] = (bf16_t)(cvt_pk_bf16(z.y, 0.f) & 0xffffu); }
            }
            __syncthreads();
            { const int tid = opaque_tid(); pg8::Gemm g{H + SEG_P + 1024, wt + WT_P, M_TOK, DM, 1024, LDP, 1024}; pg8::StaticOrder S; S.init(M_TOK, DM, G, bid);
              EpiMerge<true> E{MRG, H + SEG_G + (size_t)M_TOK * LDG}; pg8::gemm_phase(lds, g, S, E, tid); }
            { const int tid = opaque_tid(); pg8::Gemm g{H + SEG_C + 512, wt + WT_C, M_TOK, DM, 512, LDC, 512}; pg8::StaticOrder S; S.init(M_TOK, DM, G, bid);
              EpiMerge<false> E{MRG, H + SEG_G + (size_t)2 * M_TOK * LDG}; pg8::gemm_phase(lds, g, S, E, tid); }
        }
        GRID_SYNC();
        if (PHM & 32)
        {
            TID_VARS
            KARGS
            pg8::Gemm g{XC, FC, M_TOK, 512, 1024, 1024, 1024}; pg8::StaticOrder S; S.init(M_TOK, 512, G, bid);
            EpiFnet E{H}; pg8::gemm_phase(lds, g, S, E, tid);
        }
        GRID_SYNC();
        if (PHM & 64)
        {
            TID_VARS
            KARGS
            pg8::Gemm g{H + SEG_F + 512, wt + WT_F, M_TOK, DM, 512, LDF, 512}; pg8::StaticOrder S; S.init(M_TOK, DM, G, bid);
            EpiMerge<false> E{MRG, H + SEG_G}; pg8::gemm_phase(lds, g, S, E, tid);
        }
        GRID_SYNC();
        if (PHM & 128)
        {
            TID_VARS
            KARGS
            { const int tid = opaque_tid(); pg8::Gemm g{MRG, wt + WT_OUT, M_TOK, DM, DM, DM, DM}; pg8::StaticOrder S; S.init(M_TOK, DM, G, bid);
              EpiOut E{X, p->in[I_BOUT] + (size_t)l * DM, p->in[I_LNG] + (size_t)l * DM, XN, STATS}; pg8::gemm_phase(lds, g, S, E, tid); }
            { const int tid = opaque_tid(); pg8::Gemm g{PB, wt + WT_PLE, M_TOK, DM, PLE, PLE, PLE}; pg8::StaticOrder S; S.init(M_TOK, DM, G, bid);
              EpiPlain E{PLEB}; pg8::gemm_phase(lds, g, S, E, tid); }
        }
        GRID_SYNC();
        if (PHM & 512)
        {
            TID_VARS
            KARGS
            pg8::Gemm g{XN, wt + WT_PG, M_TOK, DM, DM, DM, DM}; pg8::StaticOrder S; S.init(M_TOK, DM, G, bid);
            EpiGate E{X, CGB + ((size_t)l * 2 + 0) * DM, CGB + ((size_t)l * 2 + 1) * DM, p->in[I_LNG] + (size_t)l * DM, p->in[I_LNB] + (size_t)l * DM, PLEB, (l + 1 < DEPTH) ? XB : (bf16_t*)nullptr, STATS}; pg8::gemm_phase(lds, g, S, E, tid);
        }
        if (l + 1 < DEPTH) GRID_SYNC();
    }
}

extern "C" void kernel_launch(void* const* d_in, const int* in_sizes, int n_in, void* d_out, int out_size, void* d_ws, size_t ws_size, hipStream_t stream) {
    static int grid_blocks = 0;
    if (grid_blocks == 0) {
        if (n_in != 25 || out_size != M_TOK * DM || ws_size < WS_END2) { fprintf(stderr, "kernel_launch: unexpected shapes: n_in %d out %d ws %zu (need %zu)\n", n_in, out_size, ws_size, (size_t)WS_END2); grid_blocks = -1; return; }
        int dev = 0, cus = 0, per_cu = 0;
        hipGetDevice(&dev);
        hipDeviceGetAttribute(&cus, hipDeviceAttributeMultiprocessorCount, dev);
        if (hipFuncSetAttribute((const void*)fwd_megakernel, hipFuncAttributeMaxDynamicSharedMemorySize, LDS_BYTES) != hipSuccess) { fprintf(stderr, "kernel_launch: hipFuncSetAttribute failed\n"); grid_blocks = -1; return; }
        hipOccupancyMaxActiveBlocksPerMultiprocessor(&per_cu, (const void*)fwd_megakernel, 512, LDS_BYTES);
        if (per_cu < 1) { fprintf(stderr, "kernel_launch: occupancy query says %d blocks per CU\n", per_cu); per_cu = 1; }
        (void)hipGetLastError();
        grid_blocks = cus;
    }
    if (grid_blocks < 0) return;
    if (hipMemsetAsync((char*)d_ws + OFF_BAR, 0, 16384 + (size_t)DEPTH * 2 * DM * 4, stream) != hipSuccess) { fprintf(stderr, "kernel_launch: memset failed\n"); return; }
    Params p{};
    for (int i = 0; i < 25; ++i) p.in[i] = (const float*)d_in[i];
    p.out = (float*)d_out; p.ws = (unsigned char*)d_ws; p.ph_lo = 0; p.ph_hi = 1000;
    void* args[] = {&p};
    hipError_t e = hipLaunchCooperativeKernel((const void*)fwd_megakernel, dim3(grid_blocks), dim3(512), args, LDS_BYTES, stream);
    if (e != hipSuccess) fprintf(stderr, "cooperative launch failed: %s (grid %d)\n", hipGetErrorString(e), grid_blocks);
}
```
